# Optimizing an MI355X kernel written in HIP

```python
import jax, jax.numpy as jnp
from jax import lax
import numpy as np

D_MODEL = 1024
BATCH = 16
SEQ = 2048
DEPTH = 4

N_META = 16
HEAD_DIM = 64
A_Q_HEADS = D_MODEL // HEAD_DIM
A_KV_HEADS = A_Q_HEADS // 4
IDX_HEADS = 8
IDX_DIM = 64
B_HEADS = D_MODEL // HEAD_DIM
D_FF = 4 * D_MODEL
BLOCK = 128
TOPK_MAX = 256
ROPE_THETA = 10000.0
EPS = 1e-6
N_A = DEPTH // 2
N_B = DEPTH - N_A

A_Q_W = A_Q_HEADS * HEAD_DIM
A_KV_W = A_KV_HEADS * HEAD_DIM
IDX_Q_W = IDX_HEADS * IDX_DIM
A_SPLITS = (A_Q_W, A_Q_W + A_KV_W, A_Q_W + 2 * A_KV_W,
            A_Q_W + 2 * A_KV_W + IDX_Q_W, A_Q_W + 2 * A_KV_W + IDX_Q_W + IDX_DIM)
A_IN_W = A_SPLITS[-1] + IDX_HEADS
B_W = B_HEADS * HEAD_DIM
KV_IN_W = 2 * B_W + B_HEADS

kernel_name = "yoco_dsa_fox_hybrid"


def rms_norm(x, g):
    xf = x.astype(jnp.float32)
    y = xf * lax.rsqrt(jnp.mean(xf * xf, axis=-1, keepdims=True) + EPS)
    return (y * g.astype(jnp.float32)).astype(x.dtype)


def rope_tables(T, dim):
    inv = 1.0 / (ROPE_THETA ** (jnp.arange(0, dim, 2, dtype=jnp.float32) / dim))
    ang = jnp.arange(T, dtype=jnp.float32)[:, None] * inv[None, :]
    return jnp.cos(ang), jnp.sin(ang)


def rope(x, cos, sin):
    x1, x2 = jnp.split(x, 2, axis=-1)
    c = cos[None, :, None, :]
    s = sin[None, :, None, :]
    return jnp.concatenate([x1 * c - x2 * s, x1 * s + x2 * c], axis=-1).astype(x.dtype)


def sq_relu_mlp(x, w1, w2):
    h = jax.nn.relu(x @ w1)
    return (h * h) @ w2


def dsa_attention(h, w_in, q_gain, k_gain, w_out, cos, sin, topk):
    B, T, _ = h.shape
    R = A_Q_HEADS // A_KV_HEADS
    nblk = T // BLOCK
    q, k, v, qi, ki, wi = jnp.split(h @ w_in, list(A_SPLITS), axis=-1)
    q = rope(rms_norm(q.reshape(B, T, A_Q_HEADS, HEAD_DIM), q_gain), cos, sin)
    k = rope(rms_norm(k.reshape(B, T, A_KV_HEADS, HEAD_DIM), k_gain), cos, sin)
    v = v.reshape(B, T, A_KV_HEADS, HEAD_DIM)
    qi = rope(qi.reshape(B, T, IDX_HEADS, IDX_DIM), cos, sin)
    ki = rope(ki[:, :, None, :], cos, sin)[:, :, 0, :]
    wi = wi.astype(jnp.float32) * (IDX_HEADS ** -0.5 * IDX_DIM ** -0.5)
    qb = q.reshape(B, nblk, BLOCK, A_KV_HEADS, R, HEAD_DIM)
    qib = qi.reshape(B, nblk, BLOCK, IDX_HEADS, IDX_DIM)
    wib = wi.reshape(B, nblk, BLOCK, IDX_HEADS)
    key_pos = jnp.arange(T)
    scale = HEAD_DIM ** -0.5

    def per_seq(args):
        qb_s, qib_s, wib_s, k_s, v_s, ki_s = args

        def per_block(bargs):
            blk, q_blk, qi_blk, w_blk = bargs
            qpos = blk * BLOCK + jnp.arange(BLOCK)
            causal = key_pos[None, :] <= qpos[:, None]
            logits = jnp.einsum('qhd,sd->qhs', qi_blk, ki_s,
                                preferred_element_type=jnp.float32)
            score = jnp.einsum('qh,qhs->qs', w_blk, jax.nn.relu(logits))
            score = jnp.where(causal, score, -jnp.inf)
            _, idx = lax.top_k(score, topk)
            valid = idx <= qpos[:, None]
            k_sel = k_s[idx]
            v_sel = v_s[idx]
            s = jnp.einsum('qgrd,qkgd->qgrk', q_blk, k_sel,
                           preferred_element_type=jnp.float32) * scale
            s = jnp.where(valid[:, None, None, :], s, -jnp.inf)
            p = jax.nn.softmax(s, axis=-1).astype(v_s.dtype)
            return jnp.einsum('qgrk,qkgd->qgrd', p, v_sel)

        return lax.map(per_block, (jnp.arange(nblk), qb_s, qib_s, wib_s))

    o = lax.map(per_seq, (qb, qib, wib, k, v, ki))
    return o.reshape(B, T, A_Q_W) @ w_out


def shared_kv(h, w_kv, f_bias, k_gain):
    B, T, _ = h.shape
    k, v, fl = jnp.split(h @ w_kv, [B_W, 2 * B_W], axis=-1)
    k = rms_norm(k.reshape(B, T, B_HEADS, HEAD_DIM), k_gain)
    v = v.reshape(B, T, B_HEADS, HEAD_DIM)
    log_f = jax.nn.log_sigmoid(fl.astype(jnp.float32) + f_bias.astype(jnp.float32))
    c = jnp.cumsum(log_f, axis=1).transpose(0, 2, 1)
    return k, v, c


def fox_attention(h, w_q, q_gain, w_out, k, v, c):
    B, T, _ = h.shape
    q = rms_norm((h @ w_q).reshape(B, T, B_HEADS, HEAD_DIM), q_gain)
    scale = HEAD_DIM ** -0.5
    outs = []
    for blk in range(T // BLOCK):
        q0, q1 = blk * BLOCK, (blk + 1) * BLOCK
        s = jnp.einsum('bqhd,bshd->bhqs', q[:, q0:q1], k[:, :q1],
                       preferred_element_type=jnp.float32) * scale
        decay = c[:, :, q0:q1, None] - c[:, :, None, :q1]
        causal = jnp.arange(q0, q1)[:, None] >= jnp.arange(q1)[None, :]
        s = jnp.where(causal, s + decay, -jnp.inf)
        p = jax.nn.softmax(s, axis=-1).astype(v.dtype)
        outs.append(jnp.einsum('bhqs,bshd->bqhd', p, v[:, :q1]))
    o = jnp.concatenate(outs, axis=1)
    return o.reshape(B, T, B_W) @ w_out


def setup_inputs(seed: int = 0) -> dict:
    key = jax.random.key(seed)
    ks = jax.random.split(key, 18)

    def dense(k, shape, fan_in, scale=1.0):
        return jax.random.normal(k, shape, jnp.float32) * (scale * fan_in ** -0.5)

    def gain(k, shape):
        return 1.0 + 0.02 * jax.random.normal(k, shape, jnp.float32)

    kv_kv = dense(ks[11], (D_MODEL, 2 * B_W), D_MODEL)
    kv_f = dense(ks[17], (D_MODEL, B_HEADS), D_MODEL, 0.25)
    return {
        "x": jax.random.normal(ks[0], (BATCH, SEQ, D_MODEL), jnp.float32),
        "meta_tokens": jax.random.normal(ks[1], (N_META, D_MODEL), jnp.float32),
        "attn_norm": gain(ks[2], (DEPTH, D_MODEL)),
        "mlp_norm": gain(ks[3], (DEPTH, D_MODEL)),
        "mlp_w1": dense(ks[4], (DEPTH, D_MODEL, D_FF), D_MODEL),
        "mlp_w2": dense(ks[5], (DEPTH, D_FF, D_MODEL), D_FF),
        "a_w_in": dense(ks[6], (N_A, D_MODEL, A_IN_W), D_MODEL),
        "a_q_gain": gain(ks[7], (N_A, HEAD_DIM)),
        "a_k_gain": gain(ks[8], (N_A, HEAD_DIM)),
        "a_w_out": dense(ks[9], (N_A, A_Q_W, D_MODEL), A_Q_W),
        "kv_norm": gain(ks[10], (D_MODEL,)),
        "kv_w": jnp.concatenate([kv_kv, kv_f], axis=1),
        "kv_f_bias": jax.random.uniform(ks[12], (B_HEADS,), jnp.float32, 1.0, 4.0),
        "kv_k_gain": gain(ks[13], (HEAD_DIM,)),
        "b_w_q": dense(ks[14], (N_B, D_MODEL, B_W), D_MODEL),
        "b_q_gain": gain(ks[15], (N_B, HEAD_DIM)),
        "b_w_out": dense(ks[16], (N_B, B_W, D_MODEL), B_W),
    }


def reference(x, meta_tokens, attn_norm, mlp_norm, mlp_w1, mlp_w2,
              a_w_in, a_q_gain, a_k_gain, a_w_out,
              kv_norm, kv_w, kv_f_bias, kv_k_gain,
              b_w_q, b_q_gain, b_w_out):
    B, S, D = x.shape
    T = S + N_META
    Tp = -(-T // BLOCK) * BLOCK
    meta = jnp.broadcast_to(meta_tokens.astype(x.dtype)[None], (B, N_META, D))
    h = jnp.concatenate([meta, x], axis=1)
    h = jnp.pad(h, ((0, 0), (0, Tp - T), (0, 0)))
    cos, sin = rope_tables(Tp, HEAD_DIM)
    topk = min(TOPK_MAX, S // 4)
    shared = None
    for i in range(DEPTH):
        hn = rms_norm(h, attn_norm[i])
        if i < N_A:
            h = h + dsa_attention(hn, a_w_in[i], a_q_gain[i], a_k_gain[i], a_w_out[i],
                                  cos, sin, topk)
        else:
            if i == N_A:
                shared = shared_kv(rms_norm(h, kv_norm), kv_w, kv_f_bias, kv_k_gain)
            j = i - N_A
            h = h + fox_attention(hn, b_w_q[j], b_q_gain[j], b_w_out[j],
                                  shared[0], shared[1], shared[2])
        h = h + sq_relu_mlp(rms_norm(h, mlp_norm[i]), mlp_w1[i], mlp_w2[i])
    return h[:, N_META:N_META + S]
```

```cpp
#include <hip/hip_runtime.h>
#include <cstdint>
#include <cstdio>

typedef unsigned short bf16;
typedef short bf16x8 __attribute__((ext_vector_type(8)));
typedef float f32x4 __attribute__((ext_vector_type(4)));
typedef float f32x16 __attribute__((ext_vector_type(16)));
typedef unsigned u32x4 __attribute__((ext_vector_type(4)));

constexpr int NB = 16, S = 2048, D = 1024, NMETA = 16, HD = 64, FF = 4096;
constexpr int M = NB * S, MR = M + NMETA;
constexpr int PRE = 64, KROWS = PRE + S;
constexpr int NWORDS = KROWS / 32;
constexpr int NPOS = S + NMETA;
constexpr int WIN_ROWS = 2048 + 96, WKV_ROWS = 2048 + 32;
constexpr float EPS = 1e-6f;
constexpr float LOG2E = 1.4426950408889634f;
constexpr float C2 = 0.125f * LOG2E;
constexpr int TOPK = 256;

constexpr size_t al4k(size_t x) { return (x + 4095) & ~size_t(4095); }
constexpr size_t OFF_CTL = 0, SZ_CTL = size_t(4) << 20;
constexpr size_t OFF_ROPE = OFF_CTL + SZ_CTL, SZ_ROPE = al4k(size_t(2) * NPOS * 32 * 4);
constexpr size_t OFF_SSQ = OFF_ROPE + SZ_ROPE, SZ_SSQ1 = al4k(size_t(MR) * 16 * 4);
constexpr size_t OFF_W1B = OFF_SSQ + 2 * SZ_SSQ1;
constexpr size_t SZ_W1 = size_t(FF) * D * 2, SZ_W2 = SZ_W1, SZ_SQ = size_t(D) * D * 2;
constexpr size_t OFF_W2B = OFF_W1B + 2 * SZ_W1;
constexpr size_t OFF_WQB = OFF_W2B + 2 * SZ_W2;
constexpr size_t OFF_WOB = OFF_WQB + 2 * SZ_SQ;
constexpr size_t OFF_WKV = OFF_WOB + 2 * SZ_SQ, SZ_WKV = al4k(size_t(WKV_ROWS) * D * 2);
constexpr size_t OFF_H = OFF_WKV + SZ_WKV, SZ_H = al4k(size_t(MR) * D * 2);
constexpr size_t OFF_SCR = OFF_H + SZ_H;
constexpr size_t OFF_U = OFF_SCR, SZ_U = al4k(size_t(MR) * FF * 2);
constexpr size_t OFF_QO = OFF_SCR, SZ_QO = al4k(size_t(MR) * D * 2);
constexpr size_t OFF_KA = OFF_QO + SZ_QO, SZ_KA = al4k(size_t(NB) * KROWS * 256 * 2 + 65536);
constexpr size_t OFF_VA = OFF_KA + SZ_KA;
constexpr size_t OFF_KI = OFF_VA + SZ_KA, SZ_KI = al4k(size_t(NB) * KROWS * 64 * 2 + 65536);
constexpr size_t OFF_QI = OFF_KI + SZ_KI, SZ_QI = al4k(size_t(MR) * 512 * 2);
constexpr size_t OFF_WI = OFF_QI + SZ_QI, SZ_WI = al4k(size_t(MR) * 8 * 4);
constexpr size_t OFF_MASK = OFF_WI + SZ_WI, SZ_MASK = al4k(size_t(M) * NWORDS * 4);
constexpr size_t OFF_LF = OFF_MASK + SZ_MASK, SZ_LF = al4k(size_t(MR) * 16 * 4);
static_assert(OFF_LF + SZ_LF <= OFF_U + SZ_U, "mixer scratch fits under U");
constexpr size_t OFF_X = OFF_SCR + SZ_U;
constexpr size_t SZ_WIN = al4k(size_t(WIN_ROWS) * D * 2);
constexpr size_t OFF_WIN = OFF_X;
constexpr size_t OFF_WOA = OFF_WIN + 2 * SZ_WIN;
constexpr size_t OFF_W1A = OFF_WOA + 2 * SZ_SQ;
constexpr size_t OFF_W2A = OFF_W1A + 2 * SZ_W1;
constexpr size_t OFF_KB = OFF_X, SZ_KB = al4k(size_t(NB) * KROWS * D * 2 + 262144);
constexpr size_t OFF_VB = OFF_KB + SZ_KB;
constexpr size_t OFF_NB = OFF_VB + SZ_KB, SZ_NB = al4k(size_t(NB) * 16 * KROWS * 4);
constexpr size_t WS_END = OFF_NB + SZ_NB;
static_assert(OFF_W2A + 2 * SZ_W2 <= WS_END, "A weights fit in region X");
static_assert(WS_END <= (size_t(512) << 20), "d_ws map fits 512 MiB");

__device__ __forceinline__ unsigned f2bf(float f) { unsigned u = __builtin_bit_cast(unsigned, f); return (u + 0x7fffu + ((u >> 16) & 1u)) >> 16; }
__device__ __forceinline__ float bf2f(unsigned h) { return __builtin_bit_cast(float, h << 16); }
__device__ __forceinline__ unsigned pk2(float lo, float hi) { return f2bf(lo) | (f2bf(hi) << 16); }
__device__ __forceinline__ float red16(float v) { v += __shfl_xor(v, 1); v += __shfl_xor(v, 2); v += __shfl_xor(v, 4); v += __shfl_xor(v, 8); return v; }
__device__ __forceinline__ float wave_sum(float v) {
#pragma unroll
    for (int o = 1; o < 64; o <<= 1) v += __shfl_xor(v, o);
    return v;
}
__device__ __forceinline__ float wave_max(float v) {
#pragma unroll
    for (int o = 1; o < 64; o <<= 1) v = fmaxf(v, __shfl_xor(v, o));
    return v;
}

struct Ptrs {
    const float* in[17]; float* out; unsigned char* ws;
};
#define WSP(T, off) ((T*)(P.ws + (off)))
__device__ __forceinline__ bf16* w1_t(const Ptrs& P, int l) { return l < 2 ? WSP(bf16, OFF_W1A + l * SZ_W1) : WSP(bf16, OFF_W1B + (l - 2) * SZ_W1); }
__device__ __forceinline__ bf16* w2_t(const Ptrs& P, int l) { return l < 2 ? WSP(bf16, OFF_W2A + l * SZ_W2) : WSP(bf16, OFF_W2B + (l - 2) * SZ_W2); }
__device__ __forceinline__ bf16* wo_t(const Ptrs& P, int l) { return l < 2 ? WSP(bf16, OFF_WOA + l * SZ_SQ) : WSP(bf16, OFF_WOB + (l - 2) * SZ_SQ); }
__device__ __forceinline__ float* ssq_p(const Ptrs& P, int k) { return WSP(float, OFF_SSQ + (size_t)(k & 1) * SZ_SSQ1); }

struct MatDesc { const float* W; int pitch, K, col0, ncols, nblk; const float* gain; bf16* WT; int dst0, perm; };
__device__ __forceinline__ bool get_mat(const Ptrs& P, int id, MatDesc& d) {
    d.gain = nullptr; d.perm = 0; d.dst0 = 0; d.col0 = 0;
    if (id < 2) { d.W = P.in[6] + (size_t)id * D * 2120; d.pitch = 2120; d.K = D; d.ncols = 2048; d.nblk = 64; d.gain = P.in[2] + id * D; d.WT = WSP(bf16, OFF_WIN + id * SZ_WIN); d.perm = 1; return true; }
    if (id < 4) { const int l = id - 2; d.W = P.in[6] + (size_t)l * D * 2120; d.pitch = 2120; d.K = D; d.col0 = 2048; d.ncols = 72; d.nblk = 3; d.gain = P.in[2] + l * D; d.WT = WSP(bf16, OFF_WIN + l * SZ_WIN); d.dst0 = 2048; return true; }
    if (id < 6) { const int l = id - 4; d.W = P.in[9] + (size_t)l * D * D; d.pitch = D; d.K = D; d.ncols = D; d.nblk = 32; d.WT = WSP(bf16, OFF_WOA + l * SZ_SQ); return true; }
    if (id < 10) { const int l = id - 6; d.W = P.in[4] + (size_t)l * D * FF; d.pitch = FF; d.K = D; d.ncols = FF; d.nblk = 128; d.gain = P.in[3] + l * D; d.WT = w1_t(P, l); return true; }
    if (id < 14) { const int l = id - 10; d.W = P.in[5] + (size_t)l * FF * D; d.pitch = D; d.K = FF; d.ncols = D; d.nblk = 32; d.WT = w2_t(P, l); return true; }
    if (id == 14) { d.W = P.in[11]; d.pitch = 2064; d.K = D; d.col0 = 0; d.ncols = 1024; d.nblk = 32; d.gain = P.in[10]; d.WT = WSP(bf16, OFF_WKV); d.perm = 1; return true; }
    if (id == 15) { d.W = P.in[11]; d.pitch = 2064; d.K = D; d.col0 = 1024; d.ncols = 1024; d.nblk = 32; d.gain = P.in[10]; d.WT = WSP(bf16, OFF_WKV); d.perm = 1; d.dst0 = 1024; return true; }
    if (id == 16) { d.W = P.in[11]; d.pitch = 2064; d.K = D; d.col0 = 2048; d.ncols = 16; d.nblk = 1; d.gain = P.in[10]; d.WT = WSP(bf16, OFF_WKV); d.dst0 = 2048; return true; }
    if (id < 19) { const int j = id - 17; d.W = P.in[14] + (size_t)j * D * D; d.pitch = D; d.K = D; d.ncols = D; d.nblk = 32; d.gain = P.in[2] + (2 + j) * D; d.WT = WSP(bf16, OFF_WQB + j * SZ_SQ); d.perm = 1; return true; }
    if (id < 21) { const int j = id - 19; d.W = P.in[16] + (size_t)j * D * D; d.pitch = D; d.K = D; d.ncols = D; d.nblk = 32; d.WT = WSP(bf16, OFF_WOB + j * SZ_SQ); return true; }
    return false;
}
constexpr int NMAT = 21;
__device__ __forceinline__ void transpose_block(const MatDesc& d, int item, float* scr, int lane) {
    const int kb = item / d.nblk, nb = item % d.nblk, k0 = 64 * kb, n0 = 32 * nb;
    int drow0;
    if (d.perm) { const int L0 = n0, pn = L0 >> 8, wc = (L0 & 255) >> 6, bj = (L0 & 63) >> 5; drow0 = d.dst0 + 256 * pn + 128 * bj + 32 * wc; }
    else drow0 = d.dst0 + n0;
    const int nn = lane & 31; const bool okc = (n0 + nn) < d.ncols;
#pragma unroll 8
    for (int i = 0; i < 32; ++i) { const int kk = 2 * i + (lane >> 5);
        float v = okc ? d.W[(size_t)(k0 + kk) * d.pitch + d.col0 + n0 + nn] : 0.f;
        if (d.gain) v *= d.gain[k0 + kk];
        scr[kk * 33 + nn] = v; }
    __builtin_amdgcn_s_waitcnt(0xc07f); asm volatile("" ::: "memory");
    const int c = lane & 7;
#pragma unroll
    for (int j = 0; j < 4; ++j) { const int n = (lane >> 3) + 8 * j; const float* s = scr + (8 * c) * 33 + n;
        u32x4 o; o.x = pk2(s[0 * 33], s[1 * 33]); o.y = pk2(s[2 * 33], s[3 * 33]); o.z = pk2(s[4 * 33], s[5 * 33]); o.w = pk2(s[6 * 33], s[7 * 33]);
        *(u32x4*)(d.WT + (size_t)(drow0 + n) * d.K + k0 + 8 * c) = o; }
    __builtin_amdgcn_s_waitcnt(0xc07f); asm volatile("" ::: "memory");
}
__device__ __forceinline__ void prologue_work(const Ptrs& P, int gw, int ngw, float* scr, int lane) {
    int base = 0;
    for (int id = 0; id < NMAT; ++id) {
        MatDesc d; get_mat(P, id, d);
        const int nit = (d.K / 64) * d.nblk;
        int first = (gw - base % ngw + ngw) % ngw;
        for (int it = first; it < nit; it += ngw) transpose_block(d, it, scr, lane);
        base += nit;
    }
    bf16* H = WSP(bf16, OFF_H); float* ssq0 = ssq_p(P, 0);
    for (int r = gw; r < MR; r += ngw) {
        const float* src = r < M ? P.in[0] + (size_t)r * D : P.in[1] + (size_t)(r - M) * D;
        float s = 0.f;
#pragma unroll
        for (int j = 0; j < 4; ++j) { const f32x4 v = *(const f32x4*)(src + 256 * j + 4 * lane); s += v.x * v.x + v.y * v.y + v.z * v.z + v.w * v.w;
            uint2 o; o.x = pk2(v.x, v.y); o.y = pk2(v.z, v.w); *(uint2*)(H + (size_t)r * D + 256 * j + 4 * lane) = o; }
        s = wave_sum(s); if (lane < 16) ssq0[(size_t)r * 16 + lane] = lane == 0 ? s : 0.f;
    }
    float* COS = WSP(float, OFF_ROPE); float* SIN = COS + NPOS * 32;
    for (int e = gw * 64 + lane; e < NPOS * 32; e += ngw * 64) { const int pos = e >> 5, i = e & 31;
        const float inv = 1.0f / powf(10000.0f, (float)(2 * i) / 64.0f); const float ang = (float)pos * inv;
        COS[e] = (float)cos((double)ang); SIN[e] = (float)sin((double)ang); }
    bf16* KA = WSP(bf16, OFF_KA); bf16* VA = WSP(bf16, OFF_VA); bf16* KI = WSP(bf16, OFF_KI);
    for (int e = gw * 64 + lane; e < NB * 48 * 32; e += ngw * 64) { const int b = e / (48 * 32), r = (e / 32) % 48 + 16, c = e % 32;
        const u32x4 z = {0u, 0u, 0u, 0u};
        *(u32x4*)(KA + ((size_t)b * KROWS + r) * 256 + c * 8) = z; *(u32x4*)(VA + ((size_t)b * KROWS + r) * 256 + c * 8) = z;
        if (c < 8) *(u32x4*)(KI + ((size_t)b * KROWS + r) * 64 + c * 8) = z; }
}
__global__ void __launch_bounds__(256) prologue_kernel(Ptrs P) {
    __shared__ float scr_all[4][64 * 33];
    const int lane = threadIdx.x & 63, w = threadIdx.x >> 6;
    prologue_work(P, blockIdx.x * 4 + w, gridDim.x * 4, scr_all[w], lane);
}

template <int NCT>
__device__ __forceinline__ void strip_mma(const bf16* A, int lda, const bf16* Bt, const int* brow, int K, f32x4 (&acc)[NCT], int lane) {
    const int fr = lane & 15, fq = lane >> 4;
    const bf16* ap = A + (size_t)fr * lda + 8 * fq;
    const bf16* bp[NCT];
#pragma unroll
    for (int j = 0; j < NCT; ++j) { bp[j] = Bt + (size_t)(brow[j] + fr) * K + 8 * fq; acc[j] = (f32x4){0.f, 0.f, 0.f, 0.f}; }
#pragma unroll 4
    for (int k0 = 0; k0 < K; k0 += 32) {
        const bf16x8 a = *(const bf16x8*)(ap + k0);
#pragma unroll
        for (int j = 0; j < NCT; ++j) { const bf16x8 b = *(const bf16x8*)(bp[j] + k0); acc[j] = __builtin_amdgcn_mfma_f32_16x16x32_bf16(a, b, acc[j], 0, 0, 0); }
    }
}
__device__ __forceinline__ int row_pos(int R) { return R < M ? (R & (S - 1)) + NMETA : R - M; }
__device__ __forceinline__ float row_scale(const float* ssq, int R) {
    const f32x4* p = (const f32x4*)(ssq + (size_t)R * 16); const f32x4 a = p[0], b = p[1], c = p[2], d = p[3];
    const float t = ((a.x + a.y) + (a.z + a.w)) + ((b.x + b.y) + (b.z + b.w)) + ((c.x + c.y) + (c.z + c.w)) + ((d.x + d.y) + (d.z + d.w));
    return rsqrtf(t * (1.0f / D) + EPS);
}

struct HeadEpi { bf16* dst; int ldd, col0; const float* gain; int norm, rope, kvmap; float scale; const float* ssq; };
__device__ __forceinline__ void store_mapped(bf16* dst, int ldd, int R, int col, unsigned v, int kvmap) {
    if (!kvmap) { dst[(size_t)R * ldd + col] = (bf16)v; return; }
    if (R < M) { const int b = R >> 11, i = R & (S - 1); dst[((size_t)b * KROWS + PRE + i) * ldd + col] = (bf16)v; }
    else { const int j = R - M;
#pragma unroll 4
        for (int b = 0; b < NB; ++b) dst[((size_t)b * KROWS + j) * ldd + col] = (bf16)v; }
}
__device__ __forceinline__ void epi_head(const Ptrs& P, const HeadEpi& E, const f32x4 (&acc)[4], int R0, int lane) {
    const int fr = lane & 15, fq = lane >> 4;
    const float* COS = WSP(float, OFF_ROPE); const float* SIN = COS + NPOS * 32;
#pragma unroll
    for (int reg = 0; reg < 4; ++reg) {
        const int R = R0 + 4 * fq + reg; const float rr = row_scale(E.ssq, R);
        float x[4];
#pragma unroll
        for (int j = 0; j < 4; ++j) x[j] = acc[j][reg] * rr;
        if (E.norm) { float ss = x[0] * x[0] + x[1] * x[1] + x[2] * x[2] + x[3] * x[3]; ss = red16(ss); const float rn = rsqrtf(ss * (1.0f / 64.0f) + EPS);
#pragma unroll
            for (int j = 0; j < 4; ++j) x[j] *= rn * E.gain[16 * j + fr]; }
        if (E.rope) { const int pos = row_pos(R);
#pragma unroll
            for (int j = 0; j < 2; ++j) { const float c = COS[pos * 32 + 16 * j + fr], s = SIN[pos * 32 + 16 * j + fr]; const float a = x[j], b = x[j + 2]; x[j] = a * c - b * s; x[j + 2] = a * s + b * c; } }
#pragma unroll
        for (int j = 0; j < 4; ++j) store_mapped(E.dst, E.ldd, R, E.col0 + 16 * j + fr, f2bf(x[j] * E.scale), E.kvmap);
    }
}
enum { SP_INA = 0, SP_RES_O = 1, SP_MLP1 = 2, SP_RES_M = 3, SP_QKVB = 4, SP_QB = 5 };
__device__ __forceinline__ int strips_of(int ph) { return ph == SP_INA ? 33 : ph == SP_RES_O ? 16 : ph == SP_MLP1 ? 64 : ph == SP_RES_M ? 16 : ph == SP_QKVB ? 49 : 16; }
__device__ __forceinline__ void perm_rows(int base, int pn, int wc, int* brow) { const int b0 = base + 256 * pn + 32 * wc; brow[0] = b0; brow[1] = b0 + 16; brow[2] = b0 + 128; brow[3] = b0 + 144; }

__device__ __forceinline__ void strip_job(const Ptrs& P, int ph, int l, int rg, int s, int lane) {
    const int R0 = rg * 16; const int fr = lane & 15, fq = lane >> 4;
    bf16* H = WSP(bf16, OFF_H); bf16* QO = WSP(bf16, OFF_QO); bf16* U = WSP(bf16, OFF_U);
    int brow[5];
    if (ph == SP_INA) {
        const bf16* Bt = WSP(bf16, OFF_WIN + l * SZ_WIN); const float* ssq = ssq_p(P, 2 * l);
        if (s < 32) {
            f32x4 acc[4]; HeadEpi E; E.ssq = ssq; E.kvmap = 0; E.norm = 1; E.rope = 1; E.scale = 1.f; E.gain = nullptr;
            if (s < 16) { perm_rows(0, s >> 2, s & 3, brow); E.dst = QO; E.ldd = D; E.col0 = 64 * s; E.gain = P.in[7] + l * 64; E.scale = C2; }
            else if (s < 20) { const int kh = s - 16; perm_rows(0, 4, kh, brow); E.dst = WSP(bf16, OFF_KA); E.ldd = 256; E.col0 = 64 * kh; E.gain = P.in[8] + l * 64; E.kvmap = 1; }
            else if (s < 24) { const int vh = s - 20; perm_rows(0, 5, vh, brow); E.dst = WSP(bf16, OFF_VA); E.ldd = 256; E.col0 = 64 * vh; E.norm = 0; E.rope = 0; E.kvmap = 1; }
            else { const int qh = s - 24; perm_rows(0, 6 + (qh >> 2), qh & 3, brow); E.dst = WSP(bf16, OFF_QI); E.ldd = 512; E.col0 = 64 * qh; E.norm = 0; }
            strip_mma<4>(H + (size_t)R0 * D, D, Bt, brow, D, acc, lane);
            epi_head(P, E, acc, R0, lane);
        } else {
            f32x4 acc[5];
#pragma unroll
            for (int j = 0; j < 5; ++j) brow[j] = 2048 + 16 * j;
            strip_mma<5>(H + (size_t)R0 * D, D, Bt, brow, D, acc, lane);
            const float* COS = WSP(float, OFF_ROPE); const float* SIN = COS + NPOS * 32; bf16* KI = WSP(bf16, OFF_KI); float* WI = WSP(float, OFF_WI);
#pragma unroll
            for (int reg = 0; reg < 4; ++reg) { const int R = R0 + 4 * fq + reg; const float rr = row_scale(ssq, R); const int pos = row_pos(R);
                float x[4];
#pragma unroll
                for (int j = 0; j < 4; ++j) x[j] = acc[j][reg] * rr;
#pragma unroll
                for (int j = 0; j < 2; ++j) { const float c = COS[pos * 32 + 16 * j + fr], sn = SIN[pos * 32 + 16 * j + fr]; const float a = x[j], b = x[j + 2]; x[j] = a * c - b * sn; x[j + 2] = a * sn + b * c; }
#pragma unroll
                for (int j = 0; j < 4; ++j) store_mapped(KI, 64, R, 16 * j + fr, f2bf(x[j]), 1);
                if (fr < 8) WI[(size_t)R * 8 + fr] = acc[4][reg] * rr * 0.044194173824159216f; }
        }
    } else if (ph == SP_RES_O || ph == SP_RES_M) {
        const bool mlp = ph == SP_RES_M; const int K = mlp ? FF : D;
        const bf16* A = mlp ? U + (size_t)R0 * FF : QO + (size_t)R0 * D; const bf16* Bt = mlp ? w2_t(P, l) : wo_t(P, l);
        float* ssqn = ssq_p(P, 2 * l + (mlp ? 2 : 1)); const bool last = mlp && l == 3;
        f32x4 acc[4];
#pragma unroll
        for (int j = 0; j < 4; ++j) brow[j] = 64 * s + 16 * j;
        strip_mma<4>(A, K, Bt, brow, K, acc, lane);
#pragma unroll
        for (int reg = 0; reg < 4; ++reg) { const int R = R0 + 4 * fq + reg; float sq = 0.f;
#pragma unroll
            for (int j = 0; j < 4; ++j) { const int col = 64 * s + 16 * j + fr; const float hv = bf2f(H[(size_t)R * D + col]) + acc[j][reg]; H[(size_t)R * D + col] = (bf16)f2bf(hv); sq += hv * hv;
                if (last && R < M) P.out[(size_t)R * D + col] = hv; }
            sq = red16(sq); if (fr == 0) ssqn[(size_t)R * 16 + s] = sq; }
    } else if (ph == SP_MLP1) {
        const float* ssq = ssq_p(P, 2 * l + 1); f32x4 acc[4];
#pragma unroll
        for (int j = 0; j < 4; ++j) brow[j] = 64 * s + 16 * j;
        strip_mma<4>(H + (size_t)R0 * D, D, w1_t(P, l), brow, D, acc, lane);
#pragma unroll
        for (int reg = 0; reg < 4; ++reg) { const int R = R0 + 4 * fq + reg; const float rr = row_scale(ssq, R);
#pragma unroll
            for (int j = 0; j < 4; ++j) { const float v = fmaxf(acc[j][reg] * rr, 0.f); U[(size_t)R * FF + 64 * s + 16 * j + fr] = (bf16)f2bf(v * v); } }
    } else {
        const int jb = l - 2; const float* ssq = ssq_p(P, 2 * l);
        if (s < 48) {
            f32x4 acc[4]; HeadEpi E; E.ssq = ssq; E.rope = 0; E.norm = 1; E.kvmap = 0; E.scale = 1.f; const bf16* Bt;
            if (s < 16) { Bt = WSP(bf16, OFF_WQB + jb * SZ_SQ); perm_rows(0, s >> 2, s & 3, brow); E.dst = QO; E.ldd = D; E.col0 = 64 * s; E.gain = P.in[15] + jb * 64; E.scale = C2; }
            else if (s < 32) { const int kh = s - 16; Bt = WSP(bf16, OFF_WKV); perm_rows(0, kh >> 2, kh & 3, brow); E.dst = WSP(bf16, OFF_KB); E.ldd = D; E.col0 = 64 * kh; E.gain = P.in[13]; E.kvmap = 1; }
            else { const int vh = s - 32; Bt = WSP(bf16, OFF_WKV); perm_rows(1024, vh >> 2, vh & 3, brow); E.dst = WSP(bf16, OFF_VB); E.ldd = D; E.col0 = 64 * vh; E.norm = 0; E.gain = nullptr; E.kvmap = 1; }
            strip_mma<4>(H + (size_t)R0 * D, D, Bt, brow, D, acc, lane);
            epi_head(P, E, acc, R0, lane);
        } else {
            f32x4 acc[1]; brow[0] = 2048;
            strip_mma<1>(H + (size_t)R0 * D, D, WSP(bf16, OFF_WKV), brow, D, acc, lane);
            float* LF = WSP(float, OFF_LF); const float bias = P.in[12][fr];
#pragma unroll
            for (int reg = 0; reg < 4; ++reg) { const int R = R0 + 4 * fq + reg; const float z = acc[0][reg] * row_scale(ssq, R) + bias;
                LF[(size_t)R * 16 + fr] = fminf(z, 0.f) - log1pf(expf(-fabsf(z))); }
        }
    }
}
__global__ void __launch_bounds__(256) strip_kernel(Ptrs P, int ph, int l) {
    const int lane = threadIdx.x & 63, gw = blockIdx.x * 4 + (threadIdx.x >> 6), ngw = gridDim.x * 4;
    const int ns = strips_of(ph), njobs = (MR / 16) * ns;
    for (int j = gw; j < njobs; j += ngw) strip_job(P, ph, l, j / ns, j % ns, lane);
}

__device__ __forceinline__ unsigned okey(float f) { const unsigned u = __builtin_bit_cast(unsigned, f); return (u & 0x80000000u) ? ~u : (u | 0x80000000u); }
__device__ __forceinline__ unsigned half_sum(unsigned v) {
    v += __shfl_xor(v, 1); v += __shfl_xor(v, 2); v += __shfl_xor(v, 4); v += __shfl_xor(v, 8); v += __shfl_xor(v, 16); return v;
}
constexpr int NKT = 65;
__device__ __forceinline__ void indexer_pass(const Ptrs& P, int b, int g, int lane) {
    const bf16* QI = WSP(bf16, OFF_QI); const bf16* KI = WSP(bf16, OFF_KI) + (size_t)b * KROWS * 64; const float* WI = WSP(float, OFF_WI);
    unsigned* MASK = WSP(unsigned, OFF_MASK);
    const int i0 = 4 * g, n = lane & 31, gg = lane >> 5;
    const size_t row0 = (size_t)b * S + i0;
    bf16x8 af[4];
    { const int m = n, jj = m >> 3, g2 = (m >> 2) & 1, rr = m & 3, q = 2 * (jj >> 1) + g2, h = 4 * (jj & 1) + rr;
      const bf16* qp = QI + (row0 + q) * 512 + h * 64 + 8 * gg;
#pragma unroll
      for (int d0 = 0; d0 < 4; ++d0) af[d0] = *(const bf16x8*)(qp + 16 * d0); }
    const int trmax = (i0 + 3) >> 5;
    const unsigned lt = (1u << n) - 1u;
    const unsigned loff = (unsigned)(n * 128 + 16 * gg);
    const __amdgpu_buffer_rsrc_t krs = __builtin_amdgcn_make_buffer_rsrc((void*)KI, 0, KROWS * 128, 0x00020000);
#pragma unroll 1
    for (int sub = 0; sub < 2; ++sub) {
        const int iq = i0 + 2 * sub + gg;
        float w[8];
#pragma unroll
        for (int a = 0; a < 8; ++a) w[a] = WI[(row0 + 2 * sub + gg) * 8 + a];
        unsigned k[NKT];
#pragma unroll
        for (int T = 0; T < NKT; ++T) {
            unsigned kk = 0x007FFFFFu;
            if (T == 0 || T - 1 <= trmax) {
                const int tboff = (T == 0 ? 0 : PRE + 32 * (T - 1)) * 128;
                f32x16 acc = {};
#pragma unroll
                for (int d0 = 0; d0 < 4; ++d0) { const bf16x8 bfr = __builtin_bit_cast(bf16x8, __builtin_amdgcn_raw_buffer_load_b128(krs, loff + 32 * d0, tboff, 0)); acc = __builtin_amdgcn_mfma_f32_32x32x16_bf16(af[d0], bfr, acc, 0, 0, 0); }
                float s = 0.f;
                if (sub == 0) {
#pragma unroll
                    for (int a = 0; a < 8; ++a) s += w[a] * fmaxf(acc[a], 0.f);
                } else {
#pragma unroll
                    for (int a = 0; a < 8; ++a) s += w[a] * fmaxf(acc[8 + a], 0.f);
                }
                bool v;
                if (T == 0) v = n < NMETA; else v = (32 * (T - 1) + n) <= iq;
                if (v) kk = okey(s);
            }
            k[T] = kk;
            __builtin_amdgcn_sched_barrier(0);
        }
        unsigned thr = 0u; bool done = (NMETA + iq + 1) <= TOPK;
        if (done) thr = 0x00800000u;
        for (int bit = 31; bit >= 0; --bit) {
            if (__all(done)) break;
            const unsigned c = thr | (1u << bit);
            unsigned cnt = 0;
#pragma unroll
            for (int T = 0; T < NKT; ++T) cnt += (k[T] >= c) ? 1u : 0u;
            cnt = half_sum(cnt);
            if (!done && cnt >= (unsigned)TOPK) { thr = c; if (cnt == (unsigned)TOPK) done = true; }
        }
        unsigned need = 0x7fffffffu;
        const bool slow = !__all(done);
        if (slow) {
            unsigned gcnt = 0;
#pragma unroll
            for (int T = 0; T < NKT; ++T) gcnt += (k[T] > thr) ? 1u : 0u;
            gcnt = half_sum(gcnt);
            if (!done) need = (unsigned)TOPK - gcnt;
        }
        unsigned base = 0;
        unsigned mq0 = 0u, mq1 = 0u;
        unsigned mr0 = 0u, mr1 = 0u;
#pragma unroll
        for (int T = 0; T < NKT; ++T) {
            bool sel = k[T] > thr; const bool eq = k[T] == thr;
            if (slow) {
                const unsigned long long be = __ballot(eq);
                const unsigned hh = gg ? (unsigned)(be >> 32) : (unsigned)be;
                sel = sel || (eq && (base + (unsigned)__builtin_popcount(hh & lt)) < need);
                base += (unsigned)__builtin_popcount(hh);
            } else sel = sel || eq;
            const unsigned long long bs = __ballot(sel);
            const int widx = T == 0 ? 0 : T + 1;
            const bool mine = lane == (widx & 63);
            if ((widx >> 6) == 0) { mq0 = mine ? (unsigned)bs : mq0; mr0 = mine ? (unsigned)(bs >> 32) : mr0; }
            else { mq1 = mine ? (unsigned)bs : mq1; mr1 = mine ? (unsigned)(bs >> 32) : mr1; }
        }
        unsigned* mp = MASK + (row0 + 2 * sub) * NWORDS;
        mp[lane] = mq0; if (lane < NWORDS - 64) mp[64 + lane] = mq1;
        mp[NWORDS + lane] = mr0; if (lane < NWORDS - 64) mp[NWORDS + 64 + lane] = mr1;
    }
}
__global__ void __launch_bounds__(256) indexer_kernel(Ptrs P) {
    const int lane = threadIdx.x & 63, gw = blockIdx.x * 4 + __builtin_amdgcn_readfirstlane(threadIdx.x >> 6);
    const int b = gw >> 7, w = gw & 127;
#pragma unroll 1
    for (int j = 0; j < 4; ++j) { const int g = j == 0 ? w : j == 1 ? 255 - w : j == 2 ? 256 + w : 511 - w; indexer_pass(P, b, g, lane); }
}

template <int MODE>
__global__ void __launch_bounds__(256) attn_naive_kernel(Ptrs P) {
    __shared__ float sc_all[4][KROWS];
    const int lane = threadIdx.x & 63, w = threadIdx.x >> 6; float* sc = sc_all[w];
    const int gw = blockIdx.x * 4 + w, ngw = gridDim.x * 4;
    bf16* QO = WSP(bf16, OFF_QO);
    const int nrows = MODE == 0 ? MR : M;
    for (int job = gw; job < nrows * 16; job += ngw) {
        const int R = job >> 4, h = job & 15;
        const bool meta = R >= M; const int b = meta ? 0 : R >> 11, i = R & (S - 1);
        const int kmax = meta ? (R - M) : PRE + i;
        const bf16* Kb; const bf16* Vb; int ldk;
        if (MODE == 0) { Kb = WSP(bf16, OFF_KA) + (size_t)b * KROWS * 256 + 64 * (h >> 2); Vb = WSP(bf16, OFF_VA) + (size_t)b * KROWS * 256 + 64 * (h >> 2); ldk = 256; }
        else { Kb = WSP(bf16, OFF_KB) + (size_t)b * KROWS * D + 64 * h; Vb = WSP(bf16, OFF_VB) + (size_t)b * KROWS * D + 64 * h; ldk = D; }
        const unsigned* mrow = WSP(unsigned, OFF_MASK) + (size_t)(meta ? 0 : R) * NWORDS;
        const float* nb = WSP(float, OFF_NB) + ((size_t)b * 16 + h) * KROWS;
        float q[64];
        { const bf16* qp = QO + (size_t)R * D + 64 * h;
#pragma unroll
          for (int c = 0; c < 8; ++c) { const u32x4 v = *(const u32x4*)(qp + 8 * c);
              q[8 * c + 0] = bf2f(v.x & 0xffffu); q[8 * c + 1] = bf2f(v.x >> 16); q[8 * c + 2] = bf2f(v.y & 0xffffu); q[8 * c + 3] = bf2f(v.y >> 16);
              q[8 * c + 4] = bf2f(v.z & 0xffffu); q[8 * c + 5] = bf2f(v.z >> 16); q[8 * c + 6] = bf2f(v.w & 0xffffu); q[8 * c + 7] = bf2f(v.w >> 16); } }
        float mx = -INFINITY;
        for (int kr = lane; kr <= kmax; kr += 64) {
            bool sel;
            if (MODE == 0) sel = meta ? true : ((mrow[kr >> 5] >> (kr & 31)) & 1u) != 0u;
            else sel = (kr < NMETA) || (kr >= PRE);
            float s = -INFINITY;
            if (sel) { const bf16* kp = Kb + (size_t)kr * ldk; float a = 0.f;
#pragma unroll
                for (int c = 0; c < 8; ++c) { const u32x4 v = *(const u32x4*)(kp + 8 * c);
                    a += q[8 * c + 0] * bf2f(v.x & 0xffffu) + q[8 * c + 1] * bf2f(v.x >> 16) + q[8 * c + 2] * bf2f(v.y & 0xffffu) + q[8 * c + 3] * bf2f(v.y >> 16)
                       + q[8 * c + 4] * bf2f(v.z & 0xffffu) + q[8 * c + 5] * bf2f(v.z >> 16) + q[8 * c + 6] * bf2f(v.w & 0xffffu) + q[8 * c + 7] * bf2f(v.w >> 16); }
                s = a; if (MODE == 1) s += nb[kr]; }
            sc[kr] = s; mx = fmaxf(mx, s);
        }
        mx = wave_max(mx);
        float ls = 0.f;
        for (int kr = lane; kr <= kmax; kr += 64) { const float p = exp2f(sc[kr] - mx); sc[kr] = p; ls += p; }
        ls = wave_sum(ls);
        __builtin_amdgcn_s_waitcnt(0xc07f); asm volatile("" ::: "memory");
        float o = 0.f;
        for (int kr = 0; kr <= kmax; ++kr) { const float p = sc[kr]; if (p != 0.f) o += p * bf2f(Vb[(size_t)kr * ldk + lane]); }
        QO[(size_t)R * D + 64 * h + lane] = (bf16)f2bf(o / ls);
        __builtin_amdgcn_s_waitcnt(0xc07f); asm volatile("" ::: "memory");
    }
}

__global__ void __launch_bounds__(256) scan_kernel(Ptrs P) {
    __shared__ float part[256];
    const int b = blockIdx.x >> 4, h = blockIdx.x & 15, t = threadIdx.x;
    const float* LF = WSP(float, OFF_LF); float* NBp = WSP(float, OFF_NB) + ((size_t)b * 16 + h) * KROWS;
    float cm = 0.f;
    for (int j = 0; j < NMETA; ++j) { cm += LF[(size_t)(M + j) * 16 + h]; if (t == 0) NBp[j] = -cm * LOG2E; }
    if (t >= NMETA && t < PRE) NBp[t] = -INFINITY;
    float v[8]; float run = 0.f;
#pragma unroll
    for (int e = 0; e < 8; ++e) { run += LF[((size_t)b * S + 8 * t + e) * 16 + h]; v[e] = run; }
    part[t] = run; __syncthreads();
    for (int o = 1; o < 256; o <<= 1) { const float x = t >= o ? part[t - o] : 0.f; __syncthreads(); part[t] += x; __syncthreads(); }
    const float off = cm + (t ? part[t - 1] : 0.f);
#pragma unroll
    for (int e = 0; e < 8; ++e) NBp[PRE + 8 * t + e] = -(off + v[e]) * LOG2E;
    bf16* KB = WSP(bf16, OFF_KB); bf16* VB = WSP(bf16, OFF_VB);
    for (int e = t; e < 48 * 8; e += 256) { const int r = 16 + e / 8, c = e % 8; const u32x4 z = {0u, 0u, 0u, 0u};
        *(u32x4*)(KB + ((size_t)b * KROWS + r) * D + 64 * h + 8 * c) = z; *(u32x4*)(VB + ((size_t)b * KROWS + r) * D + 64 * h + 8 * c) = z; }
}

extern "C" void kernel_launch(void* const* d_in, const int* in_sizes, int n_in, void* d_out, int out_size, void* d_ws, size_t ws_size, hipStream_t stream) {
    if (n_in != 17 || in_sizes[0] != M * D || out_size != M * D || ws_size < WS_END) {
        fprintf(stderr, "kernel_launch: unexpected shapes (n_in %d, in0 %d, out %d, ws %zu, need %zu)\n", n_in, n_in > 0 ? in_sizes[0] : -1, out_size, ws_size, (size_t)WS_END); return; }
    Ptrs P{};
    for (int i = 0; i < 17; ++i) P.in[i] = (const float*)d_in[i];
    P.out = (float*)d_out; P.ws = (unsigned char*)d_ws;
    (void)hipMemsetAsync((char*)d_ws + OFF_CTL, 0, SZ_CTL, stream);
    prologue_kernel<<<2048, 256, 0, stream>>>(P);
    const int SG = 4096;
    for (int l = 0; l < 4; ++l) {
        if (l < 2) {
            strip_kernel<<<SG, 256, 0, stream>>>(P, SP_INA, l);
            indexer_kernel<<<512, 256, 0, stream>>>(P);
            attn_naive_kernel<0><<<4096, 256, 0, stream>>>(P);
        } else {
            strip_kernel<<<SG, 256, 0, stream>>>(P, l == 2 ? SP_QKVB : SP_QB, l);
            if (l == 2) scan_kernel<<<256, 256, 0, stream>>>(P);
            attn_naive_kernel<1><<<4096, 256, 0, stream>>>(P);
        }
        strip_kernel<<<SG, 256, 0, stream>>>(P, SP_RES_O, l);
        strip_kernel<<<SG, 256, 0, stream>>>(P, SP_MLP1, l);
        strip_kernel<<<SG, 256, 0, stream>>>(P, SP_RES_M, l);
    }
}
```

```cpp
#include <hip/hip_runtime.h>
#include <cstdint>
#include <cstdio>

typedef unsigned short bf16;
typedef short bf16x8 __attribute__((ext_vector_type(8)));
typedef float f32x4 __attribute__((ext_vector_type(4)));
typedef float f32x16 __attribute__((ext_vector_type(16)));
typedef unsigned u32x4 __attribute__((ext_vector_type(4)));

constexpr int NB = 16, S = 2048, D = 1024, NMETA = 16, HD = 64, FF = 4096;
constexpr int M = NB * S, MR = M + NMETA;
constexpr int PRE = 64, KROWS = PRE + S;
constexpr int NWORDS = KROWS / 32;
constexpr int NPOS = S + NMETA;
constexpr int WIN_ROWS = 2048 + 96, WKV_ROWS = 2048 + 32;
constexpr float EPS = 1e-6f;
constexpr float LOG2E = 1.4426950408889634f;
constexpr float C2 = 0.125f * LOG2E;
constexpr int TOPK = 256;

constexpr size_t al4k(size_t x) { return (x + 4095) & ~size_t(4095); }
constexpr size_t OFF_CTL = 0, SZ_CTL = size_t(4) << 20;
constexpr size_t OFF_ROPE = OFF_CTL + SZ_CTL, SZ_ROPE = al4k(size_t(2) * NPOS * 32 * 4);
constexpr size_t OFF_SSQ = OFF_ROPE + SZ_ROPE, SZ_SSQ1 = al4k(size_t(MR) * 16 * 4);
constexpr size_t OFF_GT = OFF_SSQ + 2 * SZ_SSQ1, SZ_GT = 4096;
constexpr int GT_AQG = 0, GT_AKG = 128, GT_KFB = 256, GT_KKG = 272, GT_BQG = 336, GT_N = 464, GT_SKIP = 464;
constexpr size_t OFF_W1B = OFF_GT + SZ_GT;
constexpr size_t SZ_W1 = size_t(FF) * D * 2, SZ_W2 = SZ_W1, SZ_SQ = size_t(D) * D * 2;
constexpr size_t OFF_W2B = OFF_W1B + 2 * SZ_W1;
constexpr size_t OFF_WOB = OFF_W2B + 2 * SZ_W2;
constexpr size_t OFF_WQ1 = OFF_WOB + 2 * SZ_SQ;
constexpr size_t OFF_WQ0 = OFF_WQ1 + SZ_SQ;
constexpr size_t OFF_WKV = OFF_WQ0 + SZ_SQ, SZ_WKV = al4k(size_t(WKV_ROWS) * D * 2);
constexpr size_t OFF_H = OFF_WKV + SZ_WKV, SZ_H = al4k(size_t(MR) * D * 2);
constexpr size_t OFF_SCR = OFF_H + SZ_H;
constexpr size_t OFF_U = OFF_SCR, SZ_U = al4k(size_t(MR) * FF * 2);
constexpr size_t OFF_QO = OFF_SCR, SZ_QO = al4k(size_t(MR) * D * 2);
constexpr size_t OFF_KA = OFF_QO + SZ_QO, SZ_KA = al4k(size_t(NB) * KROWS * 256 * 2 + 65536);
constexpr size_t OFF_VA = OFF_KA + SZ_KA;
constexpr size_t OFF_KI = OFF_VA + SZ_KA, SZ_KI = al4k(size_t(NB) * KROWS * 64 * 2 + 65536);
constexpr size_t OFF_QI = OFF_KI + SZ_KI, SZ_QI = al4k(size_t(MR) * 512 * 2);
constexpr size_t OFF_WI = OFF_QI + SZ_QI, SZ_WI = al4k(size_t(MR) * 8 * 4);
constexpr size_t OFF_MASK = OFF_WI + SZ_WI, SZ_MASK = al4k(size_t(M) * NWORDS * 4);
constexpr size_t OFF_LF = OFF_MASK + SZ_MASK, SZ_LF = al4k(size_t(MR) * 16 * 4);
constexpr size_t OFF_UM = OFF_U + size_t(M) * FF * 2;
constexpr size_t OFF_W28 = OFF_W2B, SZ_W28 = size_t(D) * FF;
constexpr size_t OFF_W18 = OFF_W1B;
static_assert(OFF_LF + SZ_LF <= OFF_U + SZ_U && OFF_UM + size_t(16) * FF * 2 <= OFF_U + SZ_U && 4 * SZ_W28 <= 2 * SZ_W2, "mixer scratch / hidden / fp8 W2 fit");
constexpr size_t OFF_X = OFF_SCR + SZ_U;
constexpr size_t SZ_WIN = al4k(size_t(WIN_ROWS) * D * 2);
constexpr size_t OFF_WIN = OFF_X;
constexpr size_t OFF_WOA = OFF_WIN + 2 * SZ_WIN;
constexpr size_t OFF_W1A = OFF_WOA + 2 * SZ_SQ;
constexpr size_t OFF_W2A = OFF_W1A + 2 * SZ_W1;
constexpr size_t OFF_KB = OFF_X, SZ_KB = al4k(size_t(NB) * KROWS * D * 2 + 262144);
constexpr size_t OFF_VB = OFF_KB + SZ_KB;
constexpr size_t OFF_NB = OFF_VB + SZ_KB, SZ_NB = al4k(size_t(NB) * 16 * KROWS * 4);
constexpr size_t WS_END = OFF_NB + SZ_NB;
constexpr size_t SZ_H8 = size_t(M) * D, OFF_H8A = OFF_X + (size_t(48) << 20), OFF_H8B = OFF_SCR + (size_t(160) << 20);
constexpr size_t SZ_WIN8 = size_t(2048) * D, OFF_WIN8 = OFF_H8A + SZ_H8;
constexpr size_t OFF_WQKV8 = WS_END;
constexpr size_t OFF_HQ = OFF_SCR + (size_t(192) << 20);
constexpr int EPI_RS_OFF = 132 * 1024;
constexpr int CW_CS = 12288;
constexpr float QA = 127.f / 5.f, QW1 = 127.f * 32.f / 4.5f, QU = 255.f / 24.f, QW2 = 127.f * 64.f / 4.f, SQRT_QU = 3.2596012026f;
constexpr float IN_F8S = 32.f;
static_assert(OFF_W2A + 2 * SZ_W2 <= OFF_H8A && OFF_WIN8 + 2 * SZ_WIN8 <= WS_END && OFF_LF + SZ_LF <= OFF_H8B && size_t(M) * FF <= (size_t(160) << 20) && OFF_H8B + SZ_H8 <= OFF_HQ && OFF_HQ + SZ_H8 <= OFF_UM && OFF_WQKV8 + size_t(4096) * D <= (size_t(512) << 20), "8-bit buffers fit");
static_assert(OFF_W2A + 2 * SZ_W2 <= WS_END, "A weights fit in region X");
static_assert(WS_END <= (size_t(512) << 20), "d_ws map fits 512 MiB");

#define GAS __attribute__((address_space(1)))
#define LAS __attribute__((address_space(3)))
__device__ __forceinline__ unsigned f2bf(float f) { unsigned u = __builtin_bit_cast(unsigned, f); return (u + 0x7fffu + ((u >> 16) & 1u)) >> 16; }
__device__ __forceinline__ float bf2f(unsigned h) { return __builtin_bit_cast(float, h << 16); }
__device__ __forceinline__ unsigned pk2(float lo, float hi) { return f2bf(lo) | (f2bf(hi) << 16); }
typedef unsigned u32x2 __attribute__((ext_vector_type(2)));
__device__ __forceinline__ size_t blk8(int R, int c, int rowlen) { return ((size_t)(R >> 4) * (rowlen / 32) + (c >> 5)) * 512 + (R & 15) * 32 + (c & 31); }
typedef int i32x4v __attribute__((ext_vector_type(4)));
__device__ __forceinline__ unsigned pk4_fp8(float a, float b, float c, float d) {
    a = fminf(fmaxf(a, -448.f), 448.f); b = fminf(fmaxf(b, -448.f), 448.f); c = fminf(fmaxf(c, -448.f), 448.f); d = fminf(fmaxf(d, -448.f), 448.f);
    int p = __builtin_amdgcn_cvt_pk_fp8_f32(a, b, 0, false); p = __builtin_amdgcn_cvt_pk_fp8_f32(c, d, p, true); return (unsigned)p; }
__device__ __forceinline__ unsigned pk4_i8(float a, float b, float c, float d) {
    a = __builtin_rintf(a) + 128.f; b = __builtin_rintf(b) + 128.f; c = __builtin_rintf(c) + 128.f; d = __builtin_rintf(d) + 128.f;
    int p = __builtin_amdgcn_cvt_pk_u8_f32(a, 0, 0); p = __builtin_amdgcn_cvt_pk_u8_f32(b, 1, p); p = __builtin_amdgcn_cvt_pk_u8_f32(c, 2, p); p = __builtin_amdgcn_cvt_pk_u8_f32(d, 3, p);
    return (unsigned)p ^ 0x80808080u; }
__device__ __forceinline__ float red16(float v) { v += __shfl_xor(v, 1); v += __shfl_xor(v, 2); v += __shfl_xor(v, 4); v += __shfl_xor(v, 8); return v; }
__device__ __forceinline__ float wave_sum(float v) {
#pragma unroll
    for (int o = 1; o < 64; o <<= 1) v += __shfl_xor(v, o);
    return v;
}
__device__ __forceinline__ float wave_max(float v) {
#pragma unroll
    for (int o = 1; o < 64; o <<= 1) v = fmaxf(v, __shfl_xor(v, o));
    return v;
}

struct Ptrs {
    const float* in[17]; float* out; unsigned char* ws;
};
#define WSP(T, off) ((T*)(P.ws + (off)))
__device__ __forceinline__ bf16* w1_t(const Ptrs& P, int l) { return l < 2 ? WSP(bf16, OFF_W1A + l * SZ_W1) : WSP(bf16, OFF_W1B + (l - 2) * SZ_W1); }
__device__ __forceinline__ bf16* w2_t(const Ptrs& P, int l) { return l < 2 ? WSP(bf16, OFF_W2A + l * SZ_W2) : WSP(bf16, OFF_W2B + (l - 2) * SZ_W2); }
__device__ __forceinline__ bf16* wo_t(const Ptrs& P, int l) { return l < 2 ? WSP(bf16, OFF_WOA + l * SZ_SQ) : WSP(bf16, OFF_WOB + (l - 2) * SZ_SQ); }
__device__ __forceinline__ float* ssq_p(const Ptrs& P, int k) { return WSP(float, OFF_SSQ + (size_t)(k & 1) * SZ_SSQ1); }

struct MatDesc { const float* W; int pitch, K, col0, ncols, nblk; const float* gain; bf16* WT; int dst0, perm; unsigned char* WT8; float s8; int q8; int* cs; };
__device__ __forceinline__ bool get_mat(const Ptrs& P, int id, MatDesc& d) {
    d.gain = nullptr; d.perm = 0; d.dst0 = 0; d.col0 = 0; d.WT8 = nullptr; d.s8 = IN_F8S; d.q8 = 0; d.cs = nullptr;
    if (id < 2) { d.W = P.in[6] + (size_t)id * D * 2120; d.pitch = 2120; d.K = D; d.ncols = 2048; d.nblk = 64; d.gain = P.in[2] + id * D; d.WT = WSP(bf16, OFF_WIN + id * SZ_WIN); d.perm = 1; d.WT8 = WSP(unsigned char, OFF_WIN8 + id * SZ_WIN8); return true; }
    if (id < 4) { const int l = id - 2; d.W = P.in[6] + (size_t)l * D * 2120; d.pitch = 2120; d.K = D; d.col0 = 2048; d.ncols = 72; d.nblk = 3; d.gain = P.in[2] + l * D; d.WT = WSP(bf16, OFF_WIN + l * SZ_WIN); d.dst0 = 2048; return true; }
    if (id < 6) { const int l = id - 4; d.W = P.in[9] + (size_t)l * D * D; d.pitch = D; d.K = D; d.ncols = D; d.nblk = 32; d.WT = WSP(bf16, OFF_WOA + l * SZ_SQ); return true; }
    if (id < 10) { const int l = id - 6; d.W = P.in[4] + (size_t)l * D * FF; d.pitch = FF; d.K = D; d.ncols = FF; d.nblk = 128; d.gain = P.in[3] + l * D; d.WT = l < 2 ? w1_t(P, l) : nullptr; d.WT8 = WSP(unsigned char, OFF_W18 + l * SZ_W28); d.s8 = QW1; d.q8 = 1; return true; }
    if (id < 14) { const int l = id - 10; d.W = P.in[5] + (size_t)l * FF * D; d.pitch = D; d.K = FF; d.ncols = D; d.nblk = 32; d.WT = l < 2 ? w2_t(P, l) : nullptr; d.WT8 = WSP(unsigned char, OFF_W28 + l * SZ_W28); d.s8 = QW2; d.q8 = 1; return true; }
    if (id == 14) { d.W = P.in[11]; d.pitch = 2064; d.K = D; d.col0 = 0; d.ncols = 1024; d.nblk = 32; d.gain = P.in[10]; d.WT = WSP(bf16, OFF_WKV); d.perm = 1; d.WT8 = WSP(unsigned char, OFF_WQKV8 + size_t(1024) * D); return true; }
    if (id == 15) { d.W = P.in[11]; d.pitch = 2064; d.K = D; d.col0 = 1024; d.ncols = 1024; d.nblk = 32; d.gain = P.in[10]; d.WT = WSP(bf16, OFF_WKV); d.perm = 1; d.dst0 = 1024; d.WT8 = WSP(unsigned char, OFF_WQKV8 + size_t(1024) * D); return true; }
    if (id == 16) { d.W = P.in[11]; d.pitch = 2064; d.K = D; d.col0 = 2048; d.ncols = 16; d.nblk = 1; d.gain = P.in[10]; d.WT = WSP(bf16, OFF_WKV); d.dst0 = 2048; return true; }
    if (id < 19) { const int j = id - 17; d.W = P.in[14] + (size_t)j * D * D; d.pitch = D; d.K = D; d.ncols = D; d.nblk = 32; d.gain = P.in[2] + (2 + j) * D; d.WT = WSP(bf16, j == 0 ? OFF_WQ0 : OFF_WQ1); d.perm = 1; d.WT8 = WSP(unsigned char, OFF_WQKV8 + (j == 0 ? 0 : size_t(3072) * D)); return true; }
    if (id < 21) { const int j = id - 19; d.W = P.in[16] + (size_t)j * D * D; d.pitch = D; d.K = D; d.ncols = D; d.nblk = 32; d.WT = WSP(bf16, OFF_WOB + j * SZ_SQ); return true; }
    return false;
}
constexpr int NMAT = 21;
__device__ __forceinline__ void transpose_block(const MatDesc& d, int item, float* scr, int lane) {
    const int nb64 = (d.nblk + 1) >> 1, kb = item / nb64, nb = item % nb64, k0 = 64 * kb, n0 = 64 * nb;
    const int c4 = lane & 15; const bool okc = (n0 + 4 * c4) < d.ncols;
#pragma unroll 8
    for (int i = 0; i < 16; ++i) { const int kk = 4 * i + (lane >> 4);
        f32x4 v = okc ? *(const f32x4*)(d.W + (size_t)(k0 + kk) * d.pitch + d.col0 + n0 + 4 * c4) : (f32x4){0.f, 0.f, 0.f, 0.f};
        if (d.gain) v = v * d.gain[k0 + kk];
        float* sp = scr + kk * 65 + 4 * c4; sp[0] = v[0]; sp[1] = v[1]; sp[2] = v[2]; sp[3] = v[3]; }
    __builtin_amdgcn_s_waitcnt(0xc07f); asm volatile("" ::: "memory");
    const int c = lane & 7;
#pragma unroll
    for (int hb = 0; hb < 2; ++hb) {
        const int nn0 = n0 + 32 * hb; if (nn0 >= 32 * d.nblk) break;
        int drow0;
        if (d.perm) { const int pn = nn0 >> 8, wc = (nn0 & 255) >> 6, bj = (nn0 & 63) >> 5; drow0 = d.dst0 + 256 * pn + 128 * bj + 32 * wc; }
        else drow0 = d.dst0 + nn0;
#pragma unroll
        for (int j = 0; j < 4; ++j) { const int n = (lane >> 3) + 8 * j; const float* sq = scr + (8 * c) * 65 + 32 * hb + n;
            u32x4 o; o.x = pk2(sq[0 * 65], sq[1 * 65]); o.y = pk2(sq[2 * 65], sq[3 * 65]); o.z = pk2(sq[4 * 65], sq[5 * 65]); o.w = pk2(sq[6 * 65], sq[7 * 65]);
            if (d.WT) *(u32x4*)(d.WT + (size_t)(drow0 + n) * d.K + k0 + 8 * c) = o;
            if (d.WT8) { u32x2 o8;
                if (d.q8) { o8.x = pk4_i8(sq[0 * 65] * d.s8, sq[1 * 65] * d.s8, sq[2 * 65] * d.s8, sq[3 * 65] * d.s8); o8.y = pk4_i8(sq[4 * 65] * d.s8, sq[5 * 65] * d.s8, sq[6 * 65] * d.s8, sq[7 * 65] * d.s8); }
                else { o8.x = pk4_fp8(sq[0 * 65] * d.s8, sq[1 * 65] * d.s8, sq[2 * 65] * d.s8, sq[3 * 65] * d.s8); o8.y = pk4_fp8(sq[4 * 65] * d.s8, sq[5 * 65] * d.s8, sq[6 * 65] * d.s8, sq[7 * 65] * d.s8); }
                *(u32x2*)(d.WT8 + (size_t)(drow0 + n) * d.K + k0 + 8 * c) = o8; } }
    }
    __builtin_amdgcn_s_waitcnt(0xc07f); asm volatile("" ::: "memory");
}
__device__ __forceinline__ void prologue_work(const Ptrs& P, int gw, int ngw, float* scr, int lane) {
    int base = 0;
    for (int id = 0; id < NMAT; ++id) {
        MatDesc d; get_mat(P, id, d);
        const int nit = (d.K / 64) * ((d.nblk + 1) >> 1);
        int first = (gw - base % ngw + ngw) % ngw;
        for (int it = first; it < nit; it += ngw) transpose_block(d, it, scr, lane);
        base += nit;
    }
    bf16* H = WSP(bf16, OFF_H); float* ssq0 = ssq_p(P, 0);
    for (int r = gw; r < MR; r += ngw) {
        const float* src = r < M ? P.in[0] + (size_t)r * D : P.in[1] + (size_t)(r - M) * D;
        float s = 0.f;
#pragma unroll
        for (int j = 0; j < 4; ++j) { const f32x4 v = *(const f32x4*)(src + 256 * j + 4 * lane); s += v.x * v.x + v.y * v.y + v.z * v.z + v.w * v.w;
            uint2 o; o.x = pk2(v.x, v.y); o.y = pk2(v.z, v.w); *(uint2*)(H + (size_t)r * D + 256 * j + 4 * lane) = o;
            if (r < M) *(unsigned*)(WSP(unsigned char, OFF_H8A) + blk8(r, 256 * j + 4 * lane, D)) = pk4_fp8(v.x, v.y, v.z, v.w); }
        s = wave_sum(s); if (lane < 16) ssq0[(size_t)r * 16 + lane] = lane == 0 ? s : 0.f;
    }
    if (gw == 0) { float* GT = WSP(float, OFF_GT);
        for (int e = lane; e < GT_N; e += 64) { float v;
            if (e < GT_AKG) v = P.in[7][e]; else if (e < GT_KFB) v = P.in[8][e - GT_AKG]; else if (e < GT_KKG) v = P.in[12][e - GT_KFB]; else if (e < GT_BQG) v = P.in[13][e - GT_KKG]; else v = P.in[15][e - GT_BQG];
            GT[e] = v; }
        { float gq = 0.f, gk = 0.f;
          for (int e = lane; e < 128; e += 64) gq = fmaxf(gq, fabsf(P.in[15][e]));
          gk = fabsf(P.in[13][lane]);
          gq = wave_max(gq); gk = wave_max(gk);
          if (lane == 0) GT[GT_SKIP] = 2.0f * 64.0f * C2 * gq * gk + 24.0f; } }
    float* COS = WSP(float, OFF_ROPE); float* SIN = COS + NPOS * 32;
    for (int e = gw * 64 + lane; e < NPOS * 32; e += ngw * 64) { const int pos = e >> 5, i = e & 31;
        const float inv = 1.0f / powf(10000.0f, (float)(2 * i) / 64.0f); const float ang = (float)pos * inv;
        COS[e] = (float)cos((double)ang); SIN[e] = (float)sin((double)ang); }
}
__device__ __forceinline__ void zero_pads(const Ptrs& P, int gw, int ngw, int lane) {
    bf16* KA = WSP(bf16, OFF_KA); bf16* VA = WSP(bf16, OFF_VA); bf16* KI = WSP(bf16, OFF_KI);
    unsigned zz = 0u; asm volatile("" : "+v"(zz));
    for (int e = gw * 64 + lane; e < NB * 48 * 32; e += ngw * 64) { const int b = e / (48 * 32), r = (e / 32) % 48 + 16, c = e % 32;
        const u32x4 z = {zz, zz, zz, zz};
        *(u32x4*)(KA + ((size_t)b * KROWS + r) * 256 + c * 8) = z; *(u32x4*)(VA + ((size_t)b * KROWS + r) * 256 + c * 8) = z;
        if (c < 8) *(u32x4*)(KI + ((size_t)b * KROWS + r) * 64 + c * 8) = z; }
}
__device__ __forceinline__ void colsum_job(const Ptrs& P, int j, int lane) {
    const u32x4* src = (const u32x4*)(WSP(unsigned char, OFF_W28) + (size_t)j * FF); int t = 0;
#pragma unroll
    for (int i = 0; i < 4; ++i) { const u32x4 v = src[i * 64 + lane];
        t = __builtin_amdgcn_sdot4((int)v.x, 0x01010101, t, false); t = __builtin_amdgcn_sdot4((int)v.y, 0x01010101, t, false); t = __builtin_amdgcn_sdot4((int)v.z, 0x01010101, t, false); t = __builtin_amdgcn_sdot4((int)v.w, 0x01010101, t, false); }
#pragma unroll
    for (int o = 1; o < 64; o <<= 1) t += __shfl_xor(t, o);
    if (lane == 0) ((int*)(P.ws + OFF_CTL) + CW_CS)[j] = t;
}
template <int NCT>
__device__ __forceinline__ bool strip_mma(const bf16* A, int lda, const bf16* Bt, const int* brow, int K, f32x4 (&acc)[NCT], int lane, int ks = 1, int wave = 0, float* red = nullptr) {
    const int fr = lane & 15, fq = lane >> 4;
    const int kb = ks == 1 ? 0 : wave * (K / 8), ke = ks == 1 ? K : kb + K / 8;
    const bf16* ap = A + (size_t)fr * lda + 8 * fq;
    const bf16* bp[NCT];
#pragma unroll
    for (int j = 0; j < NCT; ++j) { bp[j] = Bt + (size_t)(brow[j] + fr) * K + 8 * fq; acc[j] = (f32x4){0.f, 0.f, 0.f, 0.f}; }
    bf16x8 ca[2], cb[2][NCT], na[2], nb[2][NCT];
#define SM_LOAD(da, db, k0_) do { _Pragma("unroll") for (int h_ = 0; h_ < 2; ++h_) { da[h_] = *(const bf16x8*)(ap + (k0_) + 32 * h_); \
        _Pragma("unroll") for (int j_ = 0; j_ < NCT; ++j_) db[h_][j_] = *(const bf16x8*)(bp[j_] + (k0_) + 32 * h_); } } while (0)
    SM_LOAD(ca, cb, kb);
#pragma unroll 1
    for (int k0 = kb; k0 < ke; k0 += 64) {
        const int kn = k0 + 64 < ke ? k0 + 64 : k0;
        SM_LOAD(na, nb, kn);
#pragma unroll
        for (int h = 0; h < 2; ++h)
#pragma unroll
            for (int j = 0; j < NCT; ++j) acc[j] = __builtin_amdgcn_mfma_f32_16x16x32_bf16(ca[h], cb[h][j], acc[j], 0, 0, 0);
#pragma unroll
        for (int h = 0; h < 2; ++h) { ca[h] = na[h];
#pragma unroll
            for (int j = 0; j < NCT; ++j) cb[h][j] = nb[h][j]; }
    }
#undef SM_LOAD
    if (ks == 1) return true;
#pragma unroll
    for (int j = 0; j < NCT; ++j)
#pragma unroll
        for (int r = 0; r < 4; ++r) red[(wave * NCT * 4 + j * 4 + r) * 64 + lane] = acc[j][r];
    __syncthreads();
    if (wave == 0) {
#pragma unroll
        for (int j = 0; j < NCT; ++j)
#pragma unroll
            for (int r = 0; r < 4; ++r) { float t = 0.f;
#pragma unroll
                for (int w = 0; w < 8; ++w) t += red[(w * NCT * 4 + j * 4 + r) * 64 + lane];
                acc[j][r] = t; }
    }
    __syncthreads();
    return wave == 0;
}
__device__ __forceinline__ int row_pos(int R) { return R < M ? (R & (S - 1)) + NMETA : R - M; }
__device__ __forceinline__ float row_scale(const float* ssq, int R) {
    const f32x4* p = (const f32x4*)(ssq + (size_t)R * 16); const f32x4 a = p[0], b = p[1], c = p[2], d = p[3];
    const float t = ((a.x + a.y) + (a.z + a.w)) + ((b.x + b.y) + (b.z + b.w)) + ((c.x + c.y) + (c.z + c.w)) + ((d.x + d.y) + (d.z + d.w));
    return rsqrtf(t * (1.0f / D) + EPS);
}

__device__ __forceinline__ size_t ki_off(size_t grow, int d) { return (grow >> 4) * 1024 + (size_t)((d >> 5) * 512 + ((d >> 3) & 3) * 128 + (int)(grow & 15) * 8 + (d & 7)); }
__device__ __forceinline__ void store_ki(bf16* KI, int R, int d, unsigned v) {
    if (R < M) { const int b = R >> 11, i = R & (S - 1); KI[ki_off((size_t)b * KROWS + PRE + i, d)] = (bf16)v; }
    else { const int j = R - M;
#pragma unroll 4
        for (int b = 0; b < NB; ++b) KI[ki_off((size_t)b * KROWS + j, d)] = (bf16)v; }
}
struct HeadEpi { bf16* dst; int ldd, col0; const float* gain; int norm, rope, kvmap; float scale; const float* ssq; };
__device__ __forceinline__ void store_mapped(bf16* dst, int ldd, int R, int col, unsigned v, int kvmap) {
    if (!kvmap) { dst[(size_t)R * ldd + col] = (bf16)v; return; }
    if (R < M) { const int b = R >> 11, i = R & (S - 1); dst[((size_t)b * KROWS + PRE + i) * ldd + col] = (bf16)v; }
    else { const int j = R - M;
#pragma unroll 4
        for (int b = 0; b < NB; ++b) dst[((size_t)b * KROWS + j) * ldd + col] = (bf16)v; }
}
__device__ __forceinline__ void epi_head(const Ptrs& P, const HeadEpi& E, const f32x4 (&acc)[4], int R0, int lane) {
    const int fr = lane & 15, fq = lane >> 4;
    const float* COS = WSP(float, OFF_ROPE); const float* SIN = COS + NPOS * 32;
#pragma unroll
    for (int reg = 0; reg < 4; ++reg) {
        const int R = R0 + 4 * fq + reg; const float rr = row_scale(E.ssq, R);
        float x[4];
#pragma unroll
        for (int j = 0; j < 4; ++j) x[j] = acc[j][reg] * rr;
        if (E.norm) { float ss = x[0] * x[0] + x[1] * x[1] + x[2] * x[2] + x[3] * x[3]; ss = red16(ss); const float rn = rsqrtf(ss * (1.0f / 64.0f) + EPS);
#pragma unroll
            for (int j = 0; j < 4; ++j) x[j] *= rn * E.gain[16 * j + fr]; }
        if (E.rope) { const int pos = row_pos(R);
#pragma unroll
            for (int j = 0; j < 2; ++j) { const float c = COS[pos * 32 + 16 * j + fr], s = SIN[pos * 32 + 16 * j + fr]; const float a = x[j], b = x[j + 2]; x[j] = a * c - b * s; x[j + 2] = a * s + b * c; } }
#pragma unroll
        for (int j = 0; j < 4; ++j) store_mapped(E.dst, E.ldd, R, E.col0 + 16 * j + fr, f2bf(x[j] * E.scale), E.kvmap);
    }
}
enum { SP_INA = 0, SP_RES_O = 1, SP_MLP1 = 2, SP_RES_M = 3, SP_QKVB = 4, SP_QB = 5 };
__device__ __forceinline__ int strips_of(int ph) { return ph == SP_INA ? 33 : ph == SP_RES_O ? 16 : ph == SP_MLP1 ? 64 : ph == SP_RES_M ? 16 : ph == SP_QKVB ? 49 : 16; }
__device__ __forceinline__ void perm_rows(int base, int pn, int wc, int* brow) { const int b0 = base + 256 * pn + 32 * wc; brow[0] = b0; brow[1] = b0 + 16; brow[2] = b0 + 128; brow[3] = b0 + 144; }

__device__ __forceinline__ void strip_job(const Ptrs& P, int ph, int l, int rg, int s, int lane, int ks = 1, int wave = 0, float* red = nullptr) {
    asm volatile("" : "+s"(rg), "+s"(s), "+v"(lane));
    const int R0 = rg * 16; const int fr = lane & 15, fq = lane >> 4;
    bf16* H = WSP(bf16, OFF_H); bf16* QO = WSP(bf16, OFF_QO); bf16* UM = WSP(bf16, OFF_UM);
    int brow[5];
    if (ph == SP_INA) {
        const bf16* Bt = WSP(bf16, OFF_WIN + l * SZ_WIN); const float* ssq = ssq_p(P, 2 * l);
        if (s < 32) {
            f32x4 acc[4]; HeadEpi E; E.ssq = ssq; E.kvmap = 0; E.norm = 1; E.rope = 1; E.scale = 1.f; E.gain = nullptr;
            if (s < 16) { perm_rows(0, s >> 2, s & 3, brow); E.dst = QO; E.ldd = D; E.col0 = 64 * s; E.gain = WSP(float, OFF_GT) + GT_AQG + l * 64; E.scale = C2; }
            else if (s < 20) { const int kh = s - 16; perm_rows(0, 4, kh, brow); E.dst = WSP(bf16, OFF_KA); E.ldd = 256; E.col0 = 64 * kh; E.gain = WSP(float, OFF_GT) + GT_AKG + l * 64; E.kvmap = 1; }
            else if (s < 24) { const int vh = s - 20; perm_rows(0, 5, vh, brow); E.dst = WSP(bf16, OFF_VA); E.ldd = 256; E.col0 = 64 * vh; E.norm = 0; E.rope = 0; E.kvmap = 1; }
            else { const int qh = s - 24; perm_rows(0, 6 + (qh >> 2), qh & 3, brow); E.dst = WSP(bf16, OFF_QI); E.ldd = 512; E.col0 = 64 * qh; E.norm = 0; }
            if (strip_mma<4>(H + (size_t)R0 * D, D, Bt, brow, D, acc, lane, ks, wave, red))
            epi_head(P, E, acc, R0, lane);
        } else {
            f32x4 acc[5];
#pragma unroll
            for (int j = 0; j < 5; ++j) brow[j] = 2048 + 16 * j;
            if (!strip_mma<5>(H + (size_t)R0 * D, D, Bt, brow, D, acc, lane, ks, wave, red)) return;
            const float* COS = WSP(float, OFF_ROPE); const float* SIN = COS + NPOS * 32; bf16* KI = WSP(bf16, OFF_KI); float* WI = WSP(float, OFF_WI);
#pragma unroll
            for (int reg = 0; reg < 4; ++reg) { const int R = R0 + 4 * fq + reg; const float rr = row_scale(ssq, R); const int pos = row_pos(R);
                float x[4];
#pragma unroll
                for (int j = 0; j < 4; ++j) x[j] = acc[j][reg] * rr;
#pragma unroll
                for (int j = 0; j < 2; ++j) { const float c = COS[pos * 32 + 16 * j + fr], sn = SIN[pos * 32 + 16 * j + fr]; const float a = x[j], b = x[j + 2]; x[j] = a * c - b * sn; x[j + 2] = a * sn + b * c; }
#pragma unroll
                for (int j = 0; j < 4; ++j) store_ki(KI, R, 16 * j + fr, f2bf(x[j]));
                if (fr < 8) WI[(size_t)R * 8 + fr] = acc[4][reg] * rr * 0.044194173824159216f; }
        }
    } else if (ph == SP_RES_O || ph == SP_RES_M) {
        const bool mlp = ph == SP_RES_M; const int K = mlp ? FF : D;
        const bf16* A = mlp ? UM + (size_t)(R0 - M) * FF : QO + (size_t)R0 * D; const bf16* Bt = mlp ? w2_t(P, l) : wo_t(P, l);
        float* ssqn = ssq_p(P, 2 * l + (mlp ? 2 : 1)); const bool last = mlp && l == 3; const float* ssqm = ssq_p(P, 2 * l + 1);
        f32x4 acc[4];
#pragma unroll
        for (int j = 0; j < 4; ++j) brow[j] = 64 * s + 16 * j;
        if (!strip_mma<4>(A, K, Bt, brow, K, acc, lane, ks, wave, red)) return;
#pragma unroll
        for (int reg = 0; reg < 4; ++reg) { const int R = R0 + 4 * fq + reg; float sq = 0.f; float r2 = 1.f; if (mlp) { const float rr = row_scale(ssqm, R); r2 = rr * rr; }
#pragma unroll
            for (int j = 0; j < 4; ++j) { const int col = 64 * s + 16 * j + fr; const float hv = bf2f(H[(size_t)R * D + col]) + acc[j][reg] * r2; H[(size_t)R * D + col] = (bf16)f2bf(hv); sq += hv * hv;
                if (last && R < M) P.out[(size_t)R * D + col] = hv; }
            sq = red16(sq); if (fr == 0) ssqn[(size_t)R * 16 + s] = sq; }
    } else if (ph == SP_MLP1) {
        f32x4 acc[4];
#pragma unroll
        for (int j = 0; j < 4; ++j) brow[j] = 64 * s + 16 * j;
        if (!strip_mma<4>(H + (size_t)R0 * D, D, w1_t(P, l), brow, D, acc, lane, ks, wave, red)) return;
#pragma unroll
        for (int reg = 0; reg < 4; ++reg) { const int R = R0 + 4 * fq + reg;
#pragma unroll
            for (int j = 0; j < 4; ++j) { const float v = fmaxf(acc[j][reg], 0.f); UM[(size_t)(R - M) * FF + 64 * s + 16 * j + fr] = (bf16)f2bf(v * v); } }
    } else {
        const int jb = l - 2; const float* ssq = ssq_p(P, 2 * l);
        if (s < 48) {
            f32x4 acc[4]; HeadEpi E; E.ssq = ssq; E.rope = 0; E.norm = 1; E.kvmap = 0; E.scale = 1.f; const bf16* Bt;
            if (s < 16) { Bt = WSP(bf16, jb == 0 ? OFF_WQ0 : OFF_WQ1); perm_rows(0, s >> 2, s & 3, brow); E.dst = QO; E.ldd = D; E.col0 = 64 * s; E.gain = WSP(float, OFF_GT) + GT_BQG + jb * 64; E.scale = C2; }
            else if (s < 32) { const int kh = s - 16; Bt = WSP(bf16, OFF_WKV); perm_rows(0, kh >> 2, kh & 3, brow); E.dst = WSP(bf16, OFF_KB); E.ldd = D; E.col0 = 64 * kh; E.gain = WSP(float, OFF_GT) + GT_KKG; E.kvmap = 1; }
            else { const int vh = s - 32; Bt = WSP(bf16, OFF_WKV); perm_rows(1024, vh >> 2, vh & 3, brow); E.dst = WSP(bf16, OFF_VB); E.ldd = D; E.col0 = 64 * vh; E.norm = 0; E.gain = nullptr; E.kvmap = 1; }
            if (strip_mma<4>(H + (size_t)R0 * D, D, Bt, brow, D, acc, lane, ks, wave, red))
            epi_head(P, E, acc, R0, lane);
        } else {
            f32x4 acc[1]; brow[0] = 2048;
            if (!strip_mma<1>(H + (size_t)R0 * D, D, WSP(bf16, OFF_WKV), brow, D, acc, lane, ks, wave, red)) return;
            float* LF = WSP(float, OFF_LF); const float bias = WSP(float, OFF_GT)[GT_KFB + fr];
#pragma unroll
            for (int reg = 0; reg < 4; ++reg) { const int R = R0 + 4 * fq + reg; const float z = acc[0][reg] * row_scale(ssq, R) + bias;
                LF[(size_t)R * 16 + fr] = fminf(z, 0.f) - log1pf(expf(-fabsf(z))); }
        }
    }
}
__device__ __forceinline__ unsigned okey(float f) { const unsigned u = __builtin_bit_cast(unsigned, f); return (u & 0x80000000u) ? ~u : (u | 0x80000000u); }
__device__ __forceinline__ unsigned half_sum(unsigned v) {
    v += __shfl_xor(v, 1); v += __shfl_xor(v, 2); v += __shfl_xor(v, 4); v += __shfl_xor(v, 8); v += __shfl_xor(v, 16); return v;
}
constexpr int NKT = 65;
constexpr int IDX_LDS_PER_WAVE = NKT * 64 * 4;
__device__ __forceinline__ float swap16_sum(float x) {
    auto s2 = __builtin_amdgcn_permlane16_swap(__float_as_uint(x), __float_as_uint(x), false, false);
    return __uint_as_float(s2[0]) + __uint_as_float(s2[1]);
}
template <int CTRL> __device__ __forceinline__ unsigned dppu(unsigned x) { return (unsigned)__builtin_amdgcn_mov_dpp((int)x, CTRL, 0xf, 0xf, true); }
__device__ __forceinline__ unsigned half_sum_dpp(unsigned v) {
    v += dppu<0xB1>(v); v += dppu<0x4E>(v); v += dppu<0x141>(v); v += dppu<0x128>(v);
    auto s2 = __builtin_amdgcn_permlane16_swap(v, v, false, false);
    return s2[0] + s2[1];
}
__device__ __forceinline__ void count4_ge(unsigned& cnt, unsigned a, unsigned b, unsigned c4, unsigned d, unsigned c) {
    asm volatile("v_cmp_ge_u32_e64 s[20:21], %1, %5\n\tv_cmp_ge_u32_e64 s[22:23], %2, %5\n\tv_cmp_ge_u32_e64 s[24:25], %3, %5\n\tv_cmp_ge_u32_e64 s[26:27], %4, %5\n\t"
                 "v_addc_co_u32_e64 %0, s[20:21], %0, 0, s[20:21]\n\tv_addc_co_u32_e64 %0, s[22:23], %0, 0, s[22:23]\n\tv_addc_co_u32_e64 %0, s[24:25], %0, 0, s[24:25]\n\tv_addc_co_u32_e64 %0, s[26:27], %0, 0, s[26:27]"
                 : "+v"(cnt) : "v"(a), "v"(b), "v"(c4), "v"(d), "v"(c) : "s20", "s21", "s22", "s23", "s24", "s25", "s26", "s27");
}
__device__ __forceinline__ void indexer_pass(const Ptrs& P, int b, int g2, int lane, LAS unsigned* stg  , int dry = 0  ) {
    const bf16* QI = WSP(bf16, OFF_QI); const bf16* KI = WSP(bf16, OFF_KI) + (size_t)b * KROWS * 64; const float* WI = WSP(float, OFF_WI);
    unsigned* MASK = WSP(unsigned, OFF_MASK);
    const int i0 = 2 * g2, n = lane & 31, gg = lane >> 5, fr = lane & 15, fq = lane >> 4;
    const size_t row0 = (size_t)b * S + i0;
    const int ntile = 2 + ((i0 + 1) >> 5);
    const unsigned lt = (1u << n) - 1u;
    const __amdgpu_buffer_rsrc_t krs = __builtin_amdgcn_make_buffer_rsrc((void*)KI, 0, KROWS * 128, 0x00020000);
    const int iq = i0 + gg;
    bf16x8 af[2];
    { const bf16* qp = QI + (row0 + (fr >> 3)) * 512 + (fr & 7) * 64 + 8 * fq;
      af[0] = *(const bf16x8*)(qp); af[1] = *(const bf16x8*)(qp + 32); }
    const f32x4 w4 = *(const f32x4*)(WI + (row0 + (fq >> 1)) * 8 + 4 * (fq & 1));
    const unsigned loff = (unsigned)(16 * lane);
    bf16x8 b0[2][2], b1[2][2], b2[2][2], b3[2][2];
#define IDX_TBASE(t_) (((t_) == 0 ? 0 : PRE + 32 * ((t_) - 1)) * 128)
#define IDX_LOADB(dst, t_) do { const int tt_ = (t_) < ntile ? (t_) : ntile - 1; const int bo_ = IDX_TBASE(tt_); _Pragma("unroll") for (int u_ = 0; u_ < 2; ++u_) _Pragma("unroll") for (int ks_ = 0; ks_ < 2; ++ks_) \
        dst[u_][ks_] = __builtin_bit_cast(bf16x8, __builtin_amdgcn_raw_buffer_load_b128(krs, loff + 2048 * u_ + 1024 * ks_, bo_, 0)); } while (0)
#define IDX_TILE(bb, t_) do { float pu_[2]; \
        _Pragma("unroll") for (int u_ = 0; u_ < 2; ++u_) { f32x4 acc_ = {0.f, 0.f, 0.f, 0.f}; \
            acc_ = __builtin_amdgcn_mfma_f32_16x16x32_bf16(af[0], bb[u_][0], acc_, 0, 0, 0); acc_ = __builtin_amdgcn_mfma_f32_16x16x32_bf16(af[1], bb[u_][1], acc_, 0, 0, 0); \
            float x_ = w4[0] * __builtin_amdgcn_fmed3f(acc_[0], 0.f, 3.0e38f); x_ += w4[1] * __builtin_amdgcn_fmed3f(acc_[1], 0.f, 3.0e38f); \
            x_ += w4[2] * __builtin_amdgcn_fmed3f(acc_[2], 0.f, 3.0e38f); x_ += w4[3] * __builtin_amdgcn_fmed3f(acc_[3], 0.f, 3.0e38f); pu_[u_] = swap16_sum(x_); } \
        const float sc_ = (fq & 1) ? pu_[1] : pu_[0]; \
        const bool v_ = (t_) == 0 ? (n < NMETA) : ((32 * ((t_) - 1) + n) <= iq); \
        stg[(t_) * 64 + lane] = v_ ? okey(sc_) : 0x007FFFFFu; } while (0)
    IDX_LOADB(b0, 0); IDX_LOADB(b1, 1); IDX_LOADB(b2, 2); IDX_LOADB(b3, 3);
#pragma unroll 1
    for (int t = 0; t < ntile; t += 4) {
        const int t1 = t + 1 < ntile ? t + 1 : ntile - 1, t2 = t + 2 < ntile ? t + 2 : ntile - 1, t3 = t + 3 < ntile ? t + 3 : ntile - 1;
        IDX_TILE(b0, t); IDX_LOADB(b0, t + 4);
        IDX_TILE(b1, t1); IDX_LOADB(b1, t + 5);
        IDX_TILE(b2, t2); IDX_LOADB(b2, t + 6);
        IDX_TILE(b3, t3); IDX_LOADB(b3, t + 7);
    }
#undef IDX_LOADB
#undef IDX_TILE
#undef IDX_TBASE
    if (dry) return;
#pragma unroll 1
    for (int t = ntile; t < NKT; ++t) stg[t * 64 + lane] = 0x007FFFFFu;
    unsigned k[NKT];
#pragma unroll
    for (int T = 0; T < NKT; ++T) k[T] = stg[T * 64 + lane];
    unsigned thr = 0u; bool done = (NMETA + iq + 1) <= TOPK;
    if (done) thr = 0x00800000u;
#pragma unroll 1
    for (int bit = 31; bit >= 0; --bit) {
        if (__all(done)) break;
        const unsigned c = thr | (1u << bit);
        unsigned cnt = (k[NKT - 1] >= c) ? 1u : 0u;
#pragma unroll
        for (int T = 0; T + 3 < NKT; T += 4) count4_ge(cnt, k[T], k[T + 1], k[T + 2], k[T + 3], c);
        cnt = half_sum_dpp(cnt);
        if (!done && cnt >= (unsigned)TOPK) { thr = c; if (cnt == (unsigned)TOPK) done = true; }
    }
    const bool slow = !__all(done);
    unsigned* mp = MASK + row0 * NWORDS;
    unsigned m0 = 0u, m1 = 0u, m2 = 0u, m3 = 0u;
#define IDX_PUT(bs_, widx_) do { const unsigned lo_ = (unsigned)(bs_), hi_ = (unsigned)((bs_) >> 32);   \
        if ((widx_) < 64) asm volatile("s_nop 1\n\tv_writelane_b32 %0, %2, %4\n\tv_writelane_b32 %1, %3, %4" : "+v"(m0), "+v"(m2) : "s"(lo_), "s"(hi_), "n"((widx_) & 63)); \
        else asm volatile("s_nop 1\n\tv_writelane_b32 %0, %2, %4\n\tv_writelane_b32 %1, %3, %4" : "+v"(m1), "+v"(m3) : "s"(lo_), "s"(hi_), "n"((widx_) & 63)); } while (0)
    if (!slow) {
#pragma unroll
        for (int T = 0; T < NKT; ++T) { const unsigned long long bs = __ballot(k[T] >= thr); IDX_PUT(bs, T == 0 ? 0 : T + 1); }
    } else {
        unsigned gcnt = 0;
#pragma unroll
        for (int T = 0; T < NKT; ++T) gcnt += (k[T] > thr) ? 1u : 0u;
        gcnt = half_sum_dpp(gcnt);
        const unsigned need = done ? 0x7fffffffu : (unsigned)TOPK - gcnt;
        unsigned base = 0;
#pragma unroll
        for (int T = 0; T < NKT; ++T) {
            const bool eq = k[T] == thr;
            const unsigned long long be = __ballot(eq);
            const unsigned hh = gg ? (unsigned)(be >> 32) : (unsigned)be;
            const bool sel = (k[T] > thr) || (eq && (base + (unsigned)__builtin_popcount(hh & lt)) < need);
            base += (unsigned)__builtin_popcount(hh);
            const unsigned long long bs = __ballot(sel); IDX_PUT(bs, T == 0 ? 0 : T + 1);
            __builtin_amdgcn_sched_barrier(0);
        }
    }
#undef IDX_PUT
    mp[lane] = m0; mp[NWORDS + lane] = m2;
    if (lane < NWORDS - 64) { mp[64 + lane] = m1; mp[NWORDS + 64 + lane] = m3; }
}

template <int MODE>
__device__ __forceinline__ void attn_naive_work(const Ptrs& P, int gw, int ngw, float* sc, int lane, int row_lo, int row_hi) {
    bf16* QO = WSP(bf16, OFF_QO);
    for (int job = gw; job < (row_hi - row_lo) * 16; job += ngw) {
        const int R = row_lo + (job >> 4), h = job & 15;
        const bool meta = R >= M; const int b = meta ? 0 : R >> 11, i = R & (S - 1);
        const int kmax = meta ? (R - M) : PRE + i;
        const bf16* Kb; const bf16* Vb; int ldk;
        if (MODE == 0) { Kb = WSP(bf16, OFF_KA) + (size_t)b * KROWS * 256 + 64 * (h >> 2); Vb = WSP(bf16, OFF_VA) + (size_t)b * KROWS * 256 + 64 * (h >> 2); ldk = 256; }
        else { Kb = WSP(bf16, OFF_KB) + (size_t)b * KROWS * D + 64 * h; Vb = WSP(bf16, OFF_VB) + (size_t)b * KROWS * D + 64 * h; ldk = D; }
        const unsigned* mrow = WSP(unsigned, OFF_MASK) + (size_t)(meta ? 0 : R) * NWORDS;
        const float* nb = WSP(float, OFF_NB) + ((size_t)b * 16 + h) * KROWS;
        float q[64];
        { const bf16* qp = QO + (size_t)R * D + 64 * h;
#pragma unroll
          for (int c = 0; c < 8; ++c) { const u32x4 v = *(const u32x4*)(qp + 8 * c);
              q[8 * c + 0] = bf2f(v.x & 0xffffu); q[8 * c + 1] = bf2f(v.x >> 16); q[8 * c + 2] = bf2f(v.y & 0xffffu); q[8 * c + 3] = bf2f(v.y >> 16);
              q[8 * c + 4] = bf2f(v.z & 0xffffu); q[8 * c + 5] = bf2f(v.z >> 16); q[8 * c + 6] = bf2f(v.w & 0xffffu); q[8 * c + 7] = bf2f(v.w >> 16); } }
        float mx = -INFINITY;
        for (int kr = lane; kr <= kmax; kr += 64) {
            bool sel;
            if (MODE == 0) sel = meta ? true : ((mrow[kr >> 5] >> (kr & 31)) & 1u) != 0u;
            else sel = (kr < NMETA) || (kr >= PRE);
            float s = -INFINITY;
            if (sel) { const bf16* kp = Kb + (size_t)kr * ldk; float a = 0.f;
#pragma unroll
                for (int c = 0; c < 8; ++c) { const u32x4 v = *(const u32x4*)(kp + 8 * c);
                    a += q[8 * c + 0] * bf2f(v.x & 0xffffu) + q[8 * c + 1] * bf2f(v.x >> 16) + q[8 * c + 2] * bf2f(v.y & 0xffffu) + q[8 * c + 3] * bf2f(v.y >> 16)
                       + q[8 * c + 4] * bf2f(v.z & 0xffffu) + q[8 * c + 5] * bf2f(v.z >> 16) + q[8 * c + 6] * bf2f(v.w & 0xffffu) + q[8 * c + 7] * bf2f(v.w >> 16); }
                s = a; if (MODE == 1) s += nb[kr]; }
            sc[kr] = s; mx = fmaxf(mx, s);
        }
        mx = wave_max(mx);
        float ls = 0.f;
        for (int kr = lane; kr <= kmax; kr += 64) { const float p = exp2f(sc[kr] - mx); sc[kr] = p; ls += p; }
        ls = wave_sum(ls);
        __builtin_amdgcn_s_waitcnt(0xc07f); asm volatile("" ::: "memory");
        float o = 0.f;
        for (int kr = 0; kr <= kmax; ++kr) { const float p = sc[kr]; if (p != 0.f) o += p * bf2f(Vb[(size_t)kr * ldk + lane]); }
        QO[(size_t)R * D + 64 * h + lane] = (bf16)f2bf(o / ls);
        __builtin_amdgcn_s_waitcnt(0xc07f); asm volatile("" ::: "memory");
    }
}

__device__ __forceinline__ void scan_work(const Ptrs& P, int bh, float* part  , int t) {
    const int b = bh >> 4, h = bh & 15; const bool act = t < 256;
    const float* LF = WSP(float, OFF_LF); float* NBp = WSP(float, OFF_NB) + ((size_t)b * 16 + h) * KROWS;
    float cm = 0.f;
    for (int j = 0; j < NMETA; ++j) { cm += LF[(size_t)(M + j) * 16 + h]; if (t == 0) NBp[j] = -cm * LOG2E; }
    if (t >= NMETA && t < PRE) NBp[t] = -INFINITY;
    float v[8]; float run = 0.f;
    if (act) {
#pragma unroll
        for (int e = 0; e < 8; ++e) { run += LF[((size_t)b * S + 8 * t + e) * 16 + h]; v[e] = run; }
        part[t] = run; }
    __syncthreads();
    for (int o = 1; o < 256; o <<= 1) { float x = 0.f; if (act && t >= o) x = part[t - o]; __syncthreads(); if (act) part[t] += x; __syncthreads(); }
    if (act) { const float off = cm + (t ? part[t - 1] : 0.f);
#pragma unroll
        for (int e = 0; e < 8; ++e) NBp[PRE + 8 * t + e] = -(off + v[e]) * LOG2E; }
    bf16* KB = WSP(bf16, OFF_KB); bf16* VB = WSP(bf16, OFF_VB);
    for (int e = t; e < 48 * 8; e += 512) { const int r = 16 + e / 8, c = e % 8; const u32x4 z = {0u, 0u, 0u, 0u};
        *(u32x4*)(KB + ((size_t)b * KROWS + r) * D + 64 * h + 8 * c) = z; *(u32x4*)(VB + ((size_t)b * KROWS + r) * D + 64 * h + 8 * c) = z; }
    __syncthreads();
}


namespace pg8 {
#define PG8_LAS __attribute__((address_space(3)))
typedef unsigned short bf16_t;
typedef short bf16x8 __attribute__((ext_vector_type(8)));
typedef float f32x4 __attribute__((ext_vector_type(4)));
typedef unsigned u32x4 __attribute__((ext_vector_type(4)));
constexpr int BM = 256, BK = 64, HALF = 128, HTB = HALF * BK * 2  , STAGE_BYTES = 8 * HTB, NXCD = 8, WGM = 4;

__host__ __device__ __forceinline__ int lds_byte(int r, int c) { const int st = (r >> 4) * 2 + (c >> 5), rr = r & 15, cc = c & 31, ob = rr * 64 + cc * 2; return st * 1024 + (ob ^ (((ob >> 9) & 1) << 5)); }
__host__ __device__ __forceinline__ void stage_rc(int b, int& R, int& C) { const int st = b / 1024, sb = b % 1024, swz = sb ^ (((sb >> 9) & 1) << 5); R = (st >> 1) * 16 + swz / 64; C = (st & 1) * 32 + (swz % 64) / 2; }
__host__ __device__ __forceinline__ int perm32(int rho) { const int n = rho >> 4, i = rho & 15; return 8 * (i >> 2) + 4 * n + (i & 3); }

struct Unit { int pm, pn; };
struct Gemm { const bf16_t* A; const bf16_t* Bt; int M, N, K; };

struct StaticOrder {
    int nM, nN, nwg, G, c;
    __host__ __device__ void init(int M, int N, int G_, int c_) { nM = M / BM; nN = N / BM; nwg = nM * nN; G = G_; c = c_; }
    __host__ __device__ bool next(int i, Unit& u) const {
        const long L = (long)i * G + c; if (L >= nwg) return false;
        int wgid = (int)L; { const int q = nwg / NXCD, r = nwg % NXCD, xcd = wgid % NXCD, off = wgid / NXCD; wgid = (xcd < r ? xcd * (q + 1) : r * (q + 1) + (xcd - r) * q) + off; }
        const int nig = WGM * nN, gid = wgid / nig, fm = gid * WGM, gsz = (nM - fm) < WGM ? (nM - fm) : WGM;
        u.pm = fm + ((wgid % nig) % gsz); u.pn = (wgid % nig) / gsz; return true;
    }
    __device__ __forceinline__ void a_ready(const Unit&) const {}
    __device__ __forceinline__ void done(const Unit&) const {}
};

__device__ __forceinline__ unsigned cvt_pk_bf16(float lo, float hi) { unsigned r; asm volatile("v_cvt_pk_bf16_f32 %0, %1, %2" : "=v"(r) : "v"(lo), "v"(hi)); return r; }
typedef float f32x2 __attribute__((ext_vector_type(2)));
typedef int i32x4 __attribute__((ext_vector_type(4)));
template <class Epi, class Sched, bool ALIGN_EPI = false, bool SP2 = false, int QM = 0, bool ABLK = false>
__device__ __forceinline__ void gemm_phase(PG8_LAS unsigned char* lds, const Gemm g, const Sched& S, const Epi& E) {
    int tid = threadIdx.x; asm volatile("" : "+v"(tid));
    const int wid = __builtin_amdgcn_readfirstlane(tid >> 6), lane = tid & 63, wr = wid >> 2, wc = wid & 3, fr = lane & 15, fq = lane >> 4;
    constexpr bool F8 = QM == 1, I8 = QM == 2;
    const int K = g.K, nt = K / BK;
    unsigned voffA[2], voffB[2];
#pragma unroll
    for (int i = 0; i < 2; ++i) { int R, C; stage_rc(tid * 16 + i * 8192, R, C); const int Rb = Epi::PERM ? ((R & ~31) + perm32(R & 31)) : R;
        voffA[i] = ABLK ? (unsigned)(((R >> 4) * (K * 2 / 32) + (C * 2 >> 5)) * 512 + (R & 15) * 32 + (C * 2 & 31)) : (unsigned)(R * K + C) * 2u; voffB[i] = (unsigned)(Rb * K + C) * 2u; }
    const size_t kstepA = ABLK ? (size_t)2048 : (size_t)(BK * 2);
    const size_t kstep = (size_t)(BK * 2);
    const size_t hstep = (size_t)HALF * K * 2;
    const size_t tstep = 2 * hstep;
    const unsigned ldsw = (unsigned)wid * 1024u;
    const int aoff = lds_byte(wr * 64 + fr, fq * 8), boff = lds_byte(wc * 32 + fr, fq * 8);
#define PG8_SA(b, h) (((b) * 2 + (h)) * HTB)
#define PG8_SB(b, h) ((4 + (b) * 2 + (h)) * HTB)
#define PG8_STAGE(bufoff, gbase, voff) do { _Pragma("unroll") for (int _i = 0; _i < 2; ++_i) \
        __builtin_amdgcn_global_load_lds((const unsigned*)((const char*)(gbase) + (voff)[_i]), (PG8_LAS unsigned*)(lds + (bufoff) + ldsw + _i * 8192), 16, 0, 0); } while (0)
#define PG8_LDA(dst, b, h) do { _Pragma("unroll") for (int m = 0; m < 4; ++m) _Pragma("unroll") for (int k = 0; k < 2; ++k) dst[m][k] = *(const PG8_LAS bf16x8*)(lds + PG8_SA(b, h) + aoff + m * 2048 + k * 1024); } while (0)
#define PG8_LDB(dst, b, h) do { _Pragma("unroll") for (int n = 0; n < 2; ++n) _Pragma("unroll") for (int k = 0; k < 2; ++k) dst[n][k] = *(const PG8_LAS bf16x8*)(lds + PG8_SB(b, h) + boff + n * 2048 + k * 1024); } while (0)
#define PG8_CAT8(x) __builtin_shufflevector(__builtin_bit_cast(i32x4, (x)[0]), __builtin_bit_cast(i32x4, (x)[1]), 0, 1, 2, 3, 4, 5, 6, 7)
#define PG8_MMA(ai, bj, At, Bt) do { __builtin_amdgcn_s_setprio(1); _Pragma("unroll") for (int m = 0; m < 4; ++m) _Pragma("unroll") for (int n = 0; n < 2; ++n) { \
        if constexpr (F8) asm volatile("v_mfma_f32_16x16x128_f8f6f4 %0, %1, %2, %0" : "+v"(acc[ai][bj][m][n]) : "v"(PG8_CAT8(Bt[n])), "v"(PG8_CAT8(At[m])));   \
        else if constexpr (I8) { _Pragma("unroll") for (int k = 0; k < 2; ++k) acc[ai][bj][m][n] = __builtin_bit_cast(f32x4, __builtin_amdgcn_mfma_i32_16x16x64_i8(__builtin_bit_cast(i32x4, Bt[n][k]), __builtin_bit_cast(i32x4, At[m][k]), __builtin_bit_cast(i32x4, acc[ai][bj][m][n]), 0, 0, 0)); } \
        else { _Pragma("unroll") for (int k = 0; k < 2; ++k) acc[ai][bj][m][n] = __builtin_amdgcn_mfma_f32_16x16x32_bf16(Bt[n][k], At[m][k], acc[ai][bj][m][n], 0, 0, 0); } } __builtin_amdgcn_s_setprio(0); } while (0)
#define PG8_WAIT_V(n) asm volatile("s_waitcnt vmcnt(" #n ")" ::: "memory")
#define PG8_WAIT_L(n) asm volatile("s_waitcnt lgkmcnt(" #n ")" ::: "memory")
#define PG8_BAR __builtin_amdgcn_s_barrier()
#define PG8_SCHED __builtin_amdgcn_sched_barrier(0)
    Unit cur, nxt; int ui = 0;
    if (!S.next(0, cur)) return;
    f32x4 acc[2][2][4][2];
    float zf = 0.f; asm volatile("" : "+v"(zf));
#pragma unroll
    for (int a = 0; a < 2; ++a)
#pragma unroll
        for (int b = 0; b < 2; ++b)
#pragma unroll
            for (int m = 0; m < 4; ++m)
#pragma unroll
                for (int n = 0; n < 2; ++n) acc[a][b][m][n] = (f32x4){zf, zf, zf, zf};
    bf16x8 At[4][2], B0[2][2], B1[2][2];
    const char* cA = (const char*)g.A + (size_t)cur.pm * tstep; const char* cB = (const char*)g.Bt + (size_t)cur.pn * tstep;
    S.a_ready(cur);
    if constexpr (SP2) {
        PG8_STAGE(PG8_SB(0, 0), cB, voffB); PG8_STAGE(PG8_SB(0, 1), cB + hstep, voffB); PG8_STAGE(PG8_SA(0, 0), cA, voffA); PG8_STAGE(PG8_SA(0, 1), cA + hstep, voffA);
        if (wr == 1) PG8_BAR;
        PG8_WAIT_V(2); PG8_BAR;
        PG8_STAGE(PG8_SB(1, 0), cB + kstep, voffB); PG8_STAGE(PG8_SA(1, 0), cA + kstepA, voffA); PG8_STAGE(PG8_SB(1, 1), cB + hstep + kstep, voffB);
        PG8_WAIT_V(6); PG8_BAR;
    } else {
        PG8_STAGE(PG8_SB(0, 0), cB, voffB); PG8_STAGE(PG8_SA(0, 0), cA, voffA); PG8_STAGE(PG8_SB(0, 1), cB + hstep, voffB); PG8_STAGE(PG8_SA(0, 1), cA + hstep, voffA);
        if (wr == 1) PG8_BAR;
        PG8_WAIT_V(4); PG8_BAR;
        PG8_STAGE(PG8_SB(1, 0), cB + kstep, voffB); PG8_STAGE(PG8_SA(1, 0), cA + kstepA, voffA); PG8_STAGE(PG8_SB(1, 1), cB + hstep + kstep, voffB);
        PG8_WAIT_V(6); PG8_BAR;
    }
    for (;;) {
        const bool has_next = S.next(ui + 1, nxt);
        const char* nA = has_next ? (const char*)g.A + (size_t)nxt.pm * tstep : cA; const char* nB = has_next ? (const char*)g.Bt + (size_t)nxt.pn * tstep : cB;
        for (int t = 0; t < nt; t += 2) {
            const bool last = (t == nt - 2);
            const char* a1 = cA + (size_t)(t + 1) * kstepA;
            const char* a2 = last ? nA : cA + (size_t)(t + 2) * kstepA; const char* b2 = last ? nB : cB + (size_t)(t + 2) * kstep;
            const char* a3 = a2 + kstepA; const char* b3 = b2 + kstep;
            if (last && has_next) S.a_ready(nxt);
            if constexpr (SP2) {
            PG8_LDB(B0, 0, 0); PG8_LDB(B1, 0, 1); PG8_SCHED; PG8_LDA(At, 0, 0); PG8_STAGE(PG8_SA(1, 1), a1 + hstep, voffA);
            PG8_WAIT_V(8); PG8_WAIT_L(0); PG8_BAR; PG8_MMA(0, 0, At, B0); PG8_MMA(0, 1, At, B1); PG8_BAR; PG8_SCHED;
            PG8_LDA(At, 0, 1); PG8_STAGE(PG8_SB(0, 0), b2, voffB); PG8_STAGE(PG8_SB(0, 1), b2 + hstep, voffB); PG8_STAGE(PG8_SA(0, 0), a2, voffA);
            PG8_WAIT_V(8); PG8_WAIT_L(0); PG8_BAR; PG8_MMA(1, 0, At, B0); PG8_MMA(1, 1, At, B1); PG8_BAR; PG8_SCHED;
            PG8_LDB(B0, 1, 0); PG8_LDB(B1, 1, 1); PG8_SCHED; PG8_LDA(At, 1, 0); PG8_STAGE(PG8_SA(0, 1), a2 + hstep, voffA);
            PG8_WAIT_V(8); PG8_WAIT_L(0); PG8_BAR; PG8_MMA(0, 0, At, B0); PG8_MMA(0, 1, At, B1); PG8_BAR; PG8_SCHED;
            PG8_LDA(At, 1, 1); PG8_STAGE(PG8_SB(1, 0), b3, voffB); PG8_STAGE(PG8_SB(1, 1), b3 + hstep, voffB); PG8_STAGE(PG8_SA(1, 0), a3, voffA);
            PG8_WAIT_V(8); PG8_WAIT_L(0); PG8_BAR; PG8_MMA(1, 0, At, B0); PG8_MMA(1, 1, At, B1); PG8_BAR; PG8_SCHED;
            } else {
            PG8_LDB(B0, 0, 0); PG8_SCHED; PG8_LDA(At, 0, 0); PG8_STAGE(PG8_SA(1, 1), a1 + hstep, voffA);
            PG8_WAIT_L(8); PG8_BAR; PG8_WAIT_L(0); PG8_MMA(0, 0, At, B0); PG8_BAR; PG8_SCHED;
            PG8_LDB(B1, 0, 1); PG8_STAGE(PG8_SB(0, 0), b2, voffB);
            PG8_BAR; PG8_WAIT_L(0); PG8_MMA(0, 1, At, B1); PG8_BAR;
            PG8_LDA(At, 0, 1); PG8_STAGE(PG8_SA(0, 0), a2, voffA);
            PG8_BAR; PG8_WAIT_L(0); PG8_MMA(1, 0, At, B0); PG8_BAR; PG8_SCHED;
            PG8_STAGE(PG8_SB(0, 1), b2 + hstep, voffB);
            PG8_WAIT_V(6); PG8_BAR; PG8_MMA(1, 1, At, B1); PG8_BAR;
            PG8_LDB(B0, 1, 0); PG8_SCHED; PG8_LDA(At, 1, 0); PG8_STAGE(PG8_SA(0, 1), a2 + hstep, voffA);
            PG8_WAIT_L(8); PG8_BAR; PG8_WAIT_L(0); PG8_MMA(0, 0, At, B0); PG8_BAR; PG8_SCHED;
            PG8_LDB(B1, 1, 1); PG8_STAGE(PG8_SB(1, 0), b3, voffB);
            PG8_BAR; PG8_WAIT_L(0); PG8_MMA(0, 1, At, B1); PG8_BAR;
            PG8_LDA(At, 1, 1); PG8_STAGE(PG8_SA(1, 0), a3, voffA);
            PG8_BAR; PG8_WAIT_L(0); PG8_MMA(1, 0, At, B0); PG8_BAR; PG8_SCHED;
            PG8_STAGE(PG8_SB(1, 1), b3 + hstep, voffB);
            PG8_WAIT_V(6); PG8_BAR; PG8_MMA(1, 1, At, B1); PG8_BAR;
            }
        }
        if constexpr (ALIGN_EPI) { if (wr == 0) PG8_BAR; }
        if constexpr (F8) asm volatile("s_nop 15\n\ts_nop 7" ::: "memory");
        if constexpr (!Epi::AFTER_DRAIN) { E(acc, cur, wr, wc, fr, fq); S.done(cur); }
        if (!has_next) break;
#pragma unroll
        for (int a = 0; a < 2; ++a)
#pragma unroll
            for (int b = 0; b < 2; ++b)
#pragma unroll
                for (int m = 0; m < 4; ++m)
#pragma unroll
                    for (int n = 0; n < 2; ++n) acc[a][b][m][n] = (f32x4){0.f, 0.f, 0.f, 0.f};
        cur = nxt; cA = nA; cB = nB; ++ui;
        if constexpr (ALIGN_EPI) { if (wr == 1) PG8_BAR; }
    }
    PG8_WAIT_V(0);
    if constexpr (!ALIGN_EPI) { if (wr == 0) PG8_BAR; }
    PG8_BAR;
    if constexpr (Epi::AFTER_DRAIN) { E.fused(acc, cur, wr, wc, fr, fq, lds, wid, lane); S.done(cur); }
#undef PG8_SA
#undef PG8_SB
#undef PG8_STAGE
#undef PG8_LDA
#undef PG8_LDB
#undef PG8_MMA
#undef PG8_WAIT_V
#undef PG8_WAIT_L
#undef PG8_BAR
#undef PG8_SCHED
}
}

__device__ __forceinline__ u32x4 pack8(const f32x4& a, const f32x4& b) { u32x4 w; w.x = pg8::cvt_pk_bf16(a[0], a[1]); w.y = pg8::cvt_pk_bf16(a[2], a[3]); w.z = pg8::cvt_pk_bf16(b[0], b[1]); w.w = pg8::cvt_pk_bf16(b[2], b[3]); return w; }
__device__ __forceinline__ float hsum4(const f32x4& a) { return (a[0] + a[1]) + (a[2] + a[3]); }

struct HeadTile { bf16* dst; int ldd, col0, mode; const float* gain; float scale, ascale; };
__device__ __forceinline__ void epi_heads(const Ptrs& P, const HeadTile& T, const float* ssq, const f32x4 (&acc)[2][2][4][2], const pg8::Unit& u, int wr, int wc, int fr, int fq) {
    const float* COS = WSP(float, OFF_ROPE); const float* SIN = COS + NPOS * 32;
    f32x4 g[2][2];
#pragma unroll
    for (int bj = 0; bj < 2; ++bj)
#pragma unroll
        for (int n = 0; n < 2; ++n) g[bj][n] = (T.mode & 1) ? *(const f32x4*)(T.gain + 32 * bj + 8 * fq + 4 * n) : (f32x4){1.f, 1.f, 1.f, 1.f};
    extern __shared__ __attribute__((aligned(16))) unsigned char dyn_lds_epi[];
    float* rs = (float*)(dyn_lds_epi + EPI_RS_OFF) + (wr * 4 + wc) * 128;
    { const int lane = fq * 16 + fr;
#pragma unroll
      for (int h = 0; h < 2; ++h) { const int j = lane + 64 * h; rs[j] = row_scale(ssq, u.pm * 256 + (j >> 6) * 128 + wr * 64 + (j & 63)) * T.ascale; } }
    f32x4 cN[2], sN[2];
    { const int pos0 = ((u.pm * 256 + wr * 64 + fr) & (S - 1)) + NMETA;
#pragma unroll
      for (int n = 0; n < 2; ++n) { cN[n] = *(const f32x4*)(COS + pos0 * 32 + 8 * fq + 4 * n); sN[n] = *(const f32x4*)(SIN + pos0 * 32 + 8 * fq + 4 * n); } }
#pragma unroll
    for (int ai = 0; ai < 2; ++ai)
#pragma unroll
        for (int m = 0; m < 4; ++m) {
            const int R = u.pm * 256 + ai * 128 + wr * 64 + m * 16 + fr;
            const float rr = rs[ai * 64 + m * 16 + fr];
            const f32x4 cC[2] = {cN[0], cN[1]}, sC[2] = {sN[0], sN[1]};
            if (ai * 4 + m < 7) { const int in = ai * 4 + m + 1, posn = ((u.pm * 256 + (in >> 2) * 128 + wr * 64 + (in & 3) * 16 + fr) & (S - 1)) + NMETA;
#pragma unroll
                for (int n = 0; n < 2; ++n) { cN[n] = *(const f32x4*)(COS + posn * 32 + 8 * fq + 4 * n); sN[n] = *(const f32x4*)(SIN + posn * 32 + 8 * fq + 4 * n); } }
            f32x4 x[2][2];
#pragma unroll
            for (int bj = 0; bj < 2; ++bj)
#pragma unroll
                for (int n = 0; n < 2; ++n) x[bj][n] = acc[ai][bj][m][n] * rr;
            if (T.mode & 1) {
                float ss = (hsum4(x[0][0] * x[0][0]) + hsum4(x[0][1] * x[0][1])) + (hsum4(x[1][0] * x[1][0]) + hsum4(x[1][1] * x[1][1]));
                ss += __shfl_xor(ss, 16); ss += __shfl_xor(ss, 32);
                const float rn = rsqrtf(ss * (1.0f / 64.0f) + EPS);
#pragma unroll
                for (int bj = 0; bj < 2; ++bj)
#pragma unroll
                    for (int n = 0; n < 2; ++n) x[bj][n] = x[bj][n] * (g[bj][n] * rn);
            }
            if (T.mode & 2) {
#pragma unroll
                for (int n = 0; n < 2; ++n) { const f32x4 c = cC[n], sn = sC[n];
                    const f32x4 lo = x[0][n], hi = x[1][n]; x[0][n] = lo * c - hi * sn; x[1][n] = lo * sn + hi * c; }
            }
            const size_t drow = (T.mode & 4) ? (size_t)(R >> 11) * KROWS + PRE + (R & (S - 1)) : (size_t)R;
            bf16* dp = T.dst + drow * T.ldd + T.col0 + 8 * fq;
            *(u32x4*)(dp) = pack8(x[0][0] * T.scale, x[0][1] * T.scale);
            *(u32x4*)(dp + 32) = pack8(x[1][0] * T.scale, x[1][1] * T.scale);
        }
}
struct EpiInA {
    static constexpr bool PERM = true, AFTER_DRAIN = false;
    const Ptrs& P; int l; int f8, pn0;
    __device__ __forceinline__ void operator()(const f32x4 (&acc)[2][2][4][2], const pg8::Unit& u, int wr, int wc, int fr, int fq) const {
        HeadTile T; const int pn = u.pn + pn0; T.ascale = f8 ? 1.0f / IN_F8S : 1.0f;
        if (pn < 4) { T.dst = WSP(bf16, OFF_QO); T.ldd = D; T.col0 = 64 * (4 * pn + wc); T.mode = 3; T.gain = WSP(float, OFF_GT) + GT_AQG + l * 64; T.scale = C2; }
        else if (pn == 4) { T.dst = WSP(bf16, OFF_KA); T.ldd = 256; T.col0 = 64 * wc; T.mode = 7; T.gain = WSP(float, OFF_GT) + GT_AKG + l * 64; T.scale = 1.f; }
        else if (pn == 5) { T.dst = WSP(bf16, OFF_VA); T.ldd = 256; T.col0 = 64 * wc; T.mode = 4; T.gain = nullptr; T.scale = 1.f; }
        else { T.dst = WSP(bf16, OFF_QI); T.ldd = 512; T.col0 = 64 * (4 * (pn - 6) + wc); T.mode = 2; T.gain = nullptr; T.scale = 1.f; }
        epi_heads(P, T, ssq_p(P, 2 * l), acc, u, wr, wc, fr, fq);
    }
};
struct EpiInB {
    static constexpr bool PERM = true, AFTER_DRAIN = false;
    const Ptrs& P; int l;
    __device__ __forceinline__ void operator()(const f32x4 (&acc)[2][2][4][2], const pg8::Unit& u, int wr, int wc, int fr, int fq) const {
        HeadTile T; const int pn = u.pn; T.ascale = 1.0f / IN_F8S;
        if (pn < 4) { T.dst = WSP(bf16, OFF_QO); T.ldd = D; T.col0 = 64 * (4 * pn + wc); T.mode = 1; T.gain = WSP(float, OFF_GT) + GT_BQG + (l - 2) * 64; T.scale = C2; }
        else if (pn < 8) { T.dst = WSP(bf16, OFF_KB); T.ldd = D; T.col0 = 64 * (4 * (pn - 4) + wc); T.mode = 5; T.gain = WSP(float, OFF_GT) + GT_KKG; T.scale = 1.f; }
        else { T.dst = WSP(bf16, OFF_VB); T.ldd = D; T.col0 = 64 * (4 * (pn - 8) + wc); T.mode = 4; T.gain = nullptr; T.scale = 1.f; }
        epi_heads(P, T, ssq_p(P, 2 * l), acc, u, wr, wc, fr, fq);
    }
};
__device__ __forceinline__ f32x4 i2f4(const f32x4& v) { f32x4 r; r[0] = (float)__float_as_int(v[0]); r[1] = (float)__float_as_int(v[1]); r[2] = (float)__float_as_int(v[2]); r[3] = (float)__float_as_int(v[3]); return r; }
template <bool MLP>
struct EpiRes {
    static constexpr bool PERM = true, AFTER_DRAIN = false;
    const Ptrs& P; int l, dry;
    __device__ __forceinline__ void operator()(const f32x4 (&acc)[2][2][4][2], const pg8::Unit& u, int wr, int wc, int fr, int fq) const {
        constexpr int mlp = MLP ? 1 : 0;
        const bf16* H = WSP(bf16, OFF_H); bf16* Hw = dry ? (bf16*)P.out : WSP(bf16, OFF_H); float* ssqn = dry ? P.out + (size_t)20 * 1024 * 1024 : ssq_p(P, 2 * l + (mlp ? 2 : 1)); const bool last = mlp && l == 3 && !dry;
        f32x4 csa[2], csb[2];
        if constexpr (MLP) { const int* cs = (const int*)(P.ws + OFF_CTL) + CW_CS + l * D;
#pragma unroll
            for (int bj = 0; bj < 2; ++bj) { const int col = u.pn * 256 + bj * 128 + wc * 32 + 8 * fq; const i32x4v c0 = *(const i32x4v*)(cs + col), c1 = *(const i32x4v*)(cs + col + 4);
#pragma unroll
                for (int j = 0; j < 4; ++j) { csa[bj][j] = 128.f * (float)c0[j]; csb[bj][j] = 128.f * (float)c1[j]; } } }
        u32x4 hvv[2][4][2];
#pragma unroll
        for (int ai = 0; ai < 2; ++ai)
#pragma unroll
            for (int m = 0; m < 4; ++m)
#pragma unroll
                for (int bj = 0; bj < 2; ++bj) hvv[ai][m][bj] = *(const u32x4*)(H + (size_t)(u.pm * 256 + ai * 128 + wr * 64 + m * 16 + fr) * D + u.pn * 256 + bj * 128 + wc * 32 + 8 * fq);
        extern __shared__ __attribute__((aligned(16))) unsigned char dyn_lds_epi[];
        float* rs = (float*)(dyn_lds_epi + EPI_RS_OFF) + (wr * 4 + wc) * 128;
        if constexpr (!MLP) { const int lane = fq * 16 + fr;
#pragma unroll
            for (int h = 0; h < 2; ++h) { const int j = lane + 64 * h; rs[j] = row_scale(ssq_p(P, 2 * l), u.pm * 256 + (j >> 6) * 128 + wr * 64 + (j & 63)) * QA; } }
#pragma unroll
        for (int ai = 0; ai < 2; ++ai)
#pragma unroll
            for (int m = 0; m < 4; ++m) {
                const int R = u.pm * 256 + ai * 128 + wr * 64 + m * 16 + fr; float sq = 0.f;
                float qs = 0.f; if constexpr (!MLP) qs = rs[ai * 64 + m * 16 + fr];
#pragma unroll
                for (int bj = 0; bj < 2; ++bj) {
                    const int col = u.pn * 256 + bj * 128 + wc * 32 + 8 * fq;
                    const u32x4 hv = hvv[ai][m][bj];
                    f32x4 a, b;
                    if constexpr (MLP) { a = (i2f4(acc[ai][bj][m][0]) + csa[bj]) * (1.0f / (QU * QW2)); b = (i2f4(acc[ai][bj][m][1]) + csb[bj]) * (1.0f / (QU * QW2)); }
                    else { a = acc[ai][bj][m][0]; b = acc[ai][bj][m][1]; }
                    a[0] += bf2f(hv.x & 0xffffu); a[1] += bf2f(hv.x >> 16); a[2] += bf2f(hv.y & 0xffffu); a[3] += bf2f(hv.y >> 16);
                    b[0] += bf2f(hv.z & 0xffffu); b[1] += bf2f(hv.z >> 16); b[2] += bf2f(hv.w & 0xffffu); b[3] += bf2f(hv.w >> 16);
                    sq += hsum4(a * a) + hsum4(b * b);
                    if (!last) *(u32x4*)(Hw + (size_t)R * D + col) = pack8(a, b);
                    if constexpr (MLP) { if (!last && !dry) { u32x2 o8; o8.x = pk4_fp8(a[0], a[1], a[2], a[3]); o8.y = pk4_fp8(b[0], b[1], b[2], b[3]);
                        *(u32x2*)(WSP(unsigned char, l == 0 ? OFF_H8A : OFF_H8B) + blk8(R, col, D)) = o8; } }
                    else { if (!dry) { u32x2 o8; o8.x = pk4_i8(a[0] * qs, a[1] * qs, a[2] * qs, a[3] * qs); o8.y = pk4_i8(b[0] * qs, b[1] * qs, b[2] * qs, b[3] * qs);
                        *(u32x2*)(WSP(unsigned char, OFF_HQ) + blk8(R, col, D)) = o8; } }
                    if (last) { float* op = P.out + (size_t)R * D + col; *(f32x4*)op = a; *(f32x4*)(op + 4) = b; }
                }
                sq += __shfl_xor(sq, 16); sq += __shfl_xor(sq, 32);
                if (fq == 0 && !last) ssqn[(size_t)R * 16 + 4 * u.pn + wc] = sq;
            }
    }
};
struct EpiRelu2 {
    static constexpr bool PERM = true, AFTER_DRAIN = false;
    const Ptrs& P; int l, blk;
    __device__ __forceinline__ void operator()(const f32x4 (&acc)[2][2][4][2], const pg8::Unit& u, int wr, int wc, int fr, int fq) const {
        unsigned char* U8 = WSP(unsigned char, OFF_U);
        extern __shared__ __attribute__((aligned(16))) unsigned char dyn_lds_epi[];
        float* rs = (float*)(dyn_lds_epi + EPI_RS_OFF) + (wr * 4 + wc) * 128;
        { const int lane = fq * 16 + fr; float v[2];
#pragma unroll
          for (int h = 0; h < 2; ++h) { const int j = lane + 64 * h, Rj = u.pm * 256 + (j >> 6) * 128 + wr * 64 + (j & 63);
              v[h] = row_scale(ssq_p(P, 2 * l + 1), Rj) * SQRT_QU / (row_scale(ssq_p(P, 2 * l), Rj) * (QA * QW1)); }
          rs[lane] = v[0]; rs[lane + 64] = v[1]; }
#pragma unroll
        for (int ai = 0; ai < 2; ++ai)
#pragma unroll
            for (int m = 0; m < 4; ++m) {
                const int R = u.pm * 256 + ai * 128 + wr * 64 + m * 16 + fr;
                const float sc = rs[ai * 64 + m * 16 + fr];
#pragma unroll
                for (int bj = 0; bj < 2; ++bj) {
                    const f32x4 sc4 = {sc, sc, sc, sc};
                    f32x4 a = i2f4(acc[ai][bj][m][0]) * sc4, b = i2f4(acc[ai][bj][m][1]) * sc4;
#pragma unroll
                    for (int j = 0; j < 4; ++j) { a[j] = fmaxf(a[j], 0.f); b[j] = fmaxf(b[j], 0.f); }
                    a = a * a; b = b * b;
#pragma unroll
                    for (int j = 0; j < 4; ++j) { a[j] = __builtin_rintf(a[j]); b[j] = __builtin_rintf(b[j]); }
                    const int col = u.pn * 256 + bj * 128 + wc * 32 + 8 * fq;
                    int p0 = __builtin_amdgcn_cvt_pk_u8_f32(a[0], 0, 0); p0 = __builtin_amdgcn_cvt_pk_u8_f32(a[1], 1, p0); p0 = __builtin_amdgcn_cvt_pk_u8_f32(a[2], 2, p0); p0 = __builtin_amdgcn_cvt_pk_u8_f32(a[3], 3, p0);
                    int p1 = __builtin_amdgcn_cvt_pk_u8_f32(b[0], 0, 0); p1 = __builtin_amdgcn_cvt_pk_u8_f32(b[1], 1, p1); p1 = __builtin_amdgcn_cvt_pk_u8_f32(b[2], 2, p1); p1 = __builtin_amdgcn_cvt_pk_u8_f32(b[3], 3, p1);
                    u32x2 o; o.x = (unsigned)p0 ^ 0x80808080u; o.y = (unsigned)p1 ^ 0x80808080u;
                    __builtin_nontemporal_store(o, (u32x2*)(U8 + ((size_t)(R >> 4) * (FF / 32) + (col >> 5)) * 512 + (R & 15) * 32 + (col & 31)));
                }
            }
    }
};

#include <hip/hip_bf16.h>
#include <cmath>
namespace attn_body {
typedef unsigned u32x2_t __attribute__((ext_vector_type(2)));
constexpr int KVROWS=64+2048;
constexpr int LDS_AUX_BYTES=33*32*8;
using bf16=__hip_bfloat16;
using bf16x8=__attribute__((ext_vector_type(8)))short;
using s16x4=__attribute__((ext_vector_type(4)))short;
using f32x16=__attribute__((ext_vector_type(16)))float;
using u32x4=__attribute__((ext_vector_type(4)))unsigned;
constexpr int BATCH=16,NHEAD=16,SEQ=2048,D=64,DM=NHEAD*D;
constexpr int NW=8,QBLK=32,QB=QBLK*NW,KVBLK=64,NQB=SEQ/QB;
constexpr int ATTN_PITCH=DM, ATTN_UNIT_ROWS=QB;
__device__ __forceinline__ int crow(int r,int hi){return (r&3)+8*(r>>2)+4*hi;}
#define SBAR() __builtin_amdgcn_sched_barrier(0)
__device__ __forceinline__ void cmask(f32x16&p0,f32x16&p1,int jb,int qrel,int hi){
  const float NEG=-INFINITY; int kb=64*jb+4*hi;
  #pragma unroll
  for(int r=0;r<16;++r){int kv=kb+(r&3)+8*(r>>2); if(kv>qrel)p0[r]=NEG; if(kv+32>qrel)p1[r]=NEG;}
}

constexpr int NSLOT=3, SLOTB=8192;
constexpr int LDS_K=0, LDS_V=NSLOT*SLOTB, LDS_WS=2*NSLOT*SLOTB, LDS_OST=LDS_WS+NW*64*4, LDS_CORE=LDS_OST+NW*4096, LDS_AUX=LDS_CORE, LDS_BYTES=LDS_AUX+NW*LDS_AUX_BYTES;
constexpr float C2=0.125f*1.4426950408889634f;
__device__ __forceinline__ void glds16(const void*gsrc,unsigned lds_dst){unsigned keep;
  asm volatile("s_mov_b32 %0, m0\n\ts_mov_b32 m0, %2\n\ts_nop 0\n\tglobal_load_lds_dwordx4 %1, off\n\ts_mov_b32 m0, %0":"=&s"(keep):"v"(gsrc),"s"(lds_dst):"memory");}
__device__ __forceinline__ float max3f(float a,float b,float c){float r;asm("v_max3_f32 %0, %1, %2, %3":"=v"(r):"v"(a),"v"(b),"v"(c));return r;}
__device__ __forceinline__ float max2f(float a,float b){float r;asm("v_max_f32_e32 %0, %1, %2":"=v"(r):"v"(a),"v"(b));return r;}
__device__ __forceinline__ float fadd_s(float a,float b){float r;asm("v_add_f32_e32 %0, %1, %2":"=v"(r):"v"(a),"v"(b));return r;}
__device__ __forceinline__ float fsub_s(float a,float b){float r;asm("v_sub_f32_e32 %0, %1, %2":"=v"(r):"v"(a),"v"(b));return r;}
typedef float f32x2_t __attribute__((ext_vector_type(2))); typedef float f32x4_t __attribute__((ext_vector_type(4))); typedef __bf16 bf16x2_t __attribute__((ext_vector_type(2)));
__device__ __forceinline__ unsigned cvtpk_s(float lo,float hi){f32x2_t v={lo,hi};bf16x2_t b=__builtin_convertvector(v,bf16x2_t);return __builtin_bit_cast(unsigned,b);}
#define WAIT_BAR(N) asm volatile("s_waitcnt vmcnt(" #N ") lgkmcnt(0)\n\ts_barrier":::"memory")

__device__ __forceinline__ void qkt(f32x16&p0,f32x16&p1,const char*Kslot,const bf16x8*qr,const f32x16&negm,int r32,int hi){
  const char*kb=Kslot+hi*1024+r32*16;
  #pragma unroll
  for(int d0=0;d0<4;++d0){
    const bf16x8 b0=*reinterpret_cast<const bf16x8*>(kb+d0*2048);
    const bf16x8 b1=*reinterpret_cast<const bf16x8*>(kb+d0*2048+512);
    if(d0==0){p0=__builtin_amdgcn_mfma_f32_32x32x16_bf16(b0,qr[0],negm,0,0,0);p1=__builtin_amdgcn_mfma_f32_32x32x16_bf16(b1,qr[0],negm,0,0,0);}
    else{p0=__builtin_amdgcn_mfma_f32_32x32x16_bf16(b0,qr[d0],p0,0,0,0);p1=__builtin_amdgcn_mfma_f32_32x32x16_bf16(b1,qr[d0],p1,0,0,0);}}
}
typedef __attribute__((address_space(3))) const char* lds_cptr;
typedef __attribute__((address_space(3))) char* lds_cptr_w;
typedef short v4i16_t __attribute__((ext_vector_type(4)));
__device__ __forceinline__ void kload8(bf16x8*kf,lds_cptr kp){
  kf[0]=*(const __attribute__((address_space(3))) bf16x8*)(kp);      kf[1]=*(const __attribute__((address_space(3))) bf16x8*)(kp+512);
  kf[2]=*(const __attribute__((address_space(3))) bf16x8*)(kp+2048); kf[3]=*(const __attribute__((address_space(3))) bf16x8*)(kp+2560);
  kf[4]=*(const __attribute__((address_space(3))) bf16x8*)(kp+4096); kf[5]=*(const __attribute__((address_space(3))) bf16x8*)(kp+4608);
  kf[6]=*(const __attribute__((address_space(3))) bf16x8*)(kp+6144); kf[7]=*(const __attribute__((address_space(3))) bf16x8*)(kp+6656);
}
__device__ __forceinline__ void kload2(bf16x8*kf,lds_cptr kp,int j){ kf[2*j]=*(const __attribute__((address_space(3))) bf16x8*)(kp+j*2048); kf[2*j+1]=*(const __attribute__((address_space(3))) bf16x8*)(kp+j*2048+512); }
__device__ __forceinline__ s16x4 vtr(lds_cptr p){ return __builtin_bit_cast(s16x4,__builtin_amdgcn_ds_read_tr16_b64_v4i16((__attribute__((address_space(3))) v4i16_t*)p)); }
__device__ __forceinline__ float rowmax(const f32x16&p0,const f32x16&p1){
  float a=max3f(p0[0],p0[1],p1[0]),b=max3f(p0[2],p0[3],p1[1]);a=max3f(a,p1[2],p1[3]);
  #pragma unroll
  for(int r=4;r<16;r+=4){a=max3f(a,p0[r],p0[r+1]);b=max3f(b,p0[r+2],p0[r+3]);a=max3f(a,p1[r],p1[r+1]);b=max3f(b,p1[r+2],p1[r+3]);}
  const float m=max2f(a,b);
  auto rr=__builtin_amdgcn_permlane32_swap(__float_as_uint(m),__float_as_uint(m),false,false);
  return max2f(__uint_as_float(rr[0]),__uint_as_float(rr[1]));
}
__device__ __forceinline__ void pv(f32x16*o,int vb,bf16x8 pa0,bf16x8 pa1,bf16x8 pa2,bf16x8 pa3){
  #pragma unroll
  for(int d0=0;d0<2;++d0){s16x4 lo[4],hi[4];
    #pragma unroll
    for(int ks=0;ks<4;++ks){
      asm volatile("ds_read_b64_tr_b16 %0,%1 offset:%c2":"=&v"(lo[ks]):"v"(vb),"i"(d0*4096+ks*1024):"memory");
      asm volatile("ds_read_b64_tr_b16 %0,%1 offset:%c2":"=&v"(hi[ks]):"v"(vb),"i"(d0*4096+ks*1024+512):"memory");}
    asm volatile("s_waitcnt lgkmcnt(0)":::"memory");SBAR();
    #define PK(k) (bf16x8){lo[k][0],lo[k][1],lo[k][2],lo[k][3],hi[k][0],hi[k][1],hi[k][2],hi[k][3]}
    o[d0]=__builtin_amdgcn_mfma_f32_32x32x16_bf16(pa0,PK(0),o[d0],0,0,0);
    o[d0]=__builtin_amdgcn_mfma_f32_32x32x16_bf16(pa1,PK(1),o[d0],0,0,0);
    o[d0]=__builtin_amdgcn_mfma_f32_32x32x16_bf16(pa2,PK(2),o[d0],0,0,0);
    o[d0]=__builtin_amdgcn_mfma_f32_32x32x16_bf16(pa3,PK(3),o[d0],0,0,0);
    #undef PK
  }
}

#ifndef ATTN_STORE16
#define ATTN_STORE16(p,v) (*(u32x4*)(p)=(v))
#endif
template<int THRL,int MODE,int KVP> __device__ __forceinline__ void attn_unit(int b,int h,int hk,int qb,const bf16*Q,const bf16*__restrict__ K,const bf16*__restrict__ V,bf16*O,char*shm,const unsigned*maskg,const float*biasg,int t0  ){
  int tid_=threadIdx.x; asm volatile("":"+v"(tid_));
  const int tid=tid_,lane=tid&63,r32=lane&31,hi=lane>>5; const int wid=__builtin_amdgcn_readfirstlane(tid>>6);
  const long rowbase=(long)b*SEQ; const int q0=qb*QB;
  const bf16*Qw=Q+(rowbase+q0+wid*QBLK)*DM+h*D;
  const long kvbase=(long)b*KVROWS+(long)t0*64;
  const bf16*Kh=K+kvbase*KVP+hk*D,*Vh=V+kvbase*KVP+hk*D;
  const unsigned lds0=(unsigned)(uintptr_t)shm;
  float*wsf=(float*)(shm+LDS_WS)+wid*64;
  const bf16*ksrc=Kh+(long)lane*KVP+wid*8;
  const bf16*vsrc=Vh+(long)(16*(wid&3)+(lane>>2))*KVP+(wid>>2)*32+(lane&3)*8;
  const unsigned kdst=lds0+LDS_K+wid*1024, vdst=lds0+LDS_V+wid*1024;
  #define DMA_K(t,slot) glds16(ksrc+(long)(t)*KVBLK*KVP,(unsigned)__builtin_amdgcn_readfirstlane(kdst+(slot)))
  #define DMA_V(t,slot) glds16(vsrc+(long)(t)*KVBLK*KVP,(unsigned)__builtin_amdgcn_readfirstlane(vdst+(slot)))
  const int vb0=(int)(lds0+LDS_V)+((lane>>4)&1)*32+(lane&3)*8+(4*hi+((lane&15)>>2))*64;
  const char*Kbase=shm+LDS_K; bf16x8 kf[8];
  const lds_cptr shm3=(lds_cptr)shm; const lds_cptr kp0=shm3+LDS_K+hi*1024+r32*16; const lds_cptr vp0=shm3+LDS_V+((lane>>4)&1)*32+(lane&3)*8+(4*hi+((lane&15)>>2))*64;
  const int NT=(q0+QB)/KVBLK+1-t0;
  float nbq=0.f; if(MODE==1) nbq=biasg[64+q0+wid*QBLK+r32];
  if(MODE==2){} else if(MODE==0){
    const unsigned*mrow=maskg+((long)(rowbase+q0+wid*QBLK+r32))*66;
    __attribute__((address_space(3))) u32x2_t*mdst=(__attribute__((address_space(3))) u32x2_t*)((lds_cptr_w)shm+LDS_AUX+wid*LDS_AUX_BYTES);
    for(int t=hi;t<NT;t+=2){ const u32x2_t w=*reinterpret_cast<const u32x2_t*>(mrow+2*t); mdst[t*32+r32]=w; }
  } else {
    __attribute__((address_space(3))) float*bdst=(__attribute__((address_space(3))) float*)((lds_cptr_w)shm+LDS_AUX);
    for(int i=tid;i<NT*64;i+=NW*64)bdst[i]=biasg[t0*64+i];
  }
  asm volatile("s_waitcnt vmcnt(0) lgkmcnt(0)":::"memory");
  DMA_K(0,0);DMA_V(0,0);DMA_K(1,SLOTB);
  bf16x8 qr[4];
  #pragma unroll
  for(int d0=0;d0<4;++d0)qr[d0]=*reinterpret_cast<const bf16x8*>(&Qw[(long)r32*DM+d0*16+hi*8]);
  float mhat=0.f,l_reg=0.f;f32x16 o[2];o[0]=f32x16{};o[1]=f32x16{};const f32x16 negm=f32x16{};
  const int qrel=wid*QBLK+r32;
  if(MODE==1) mhat=nbq;
  #define CMASK(P0,P1,t) do{ if(MODE==2){ _Pragma("unroll") for(int r=0;r<16;++r){P0[r]-=mhat;P1[r]-=mhat;} int jb_=(t)-(NT-4); if(jb_>=0)cmask(P0,P1,jb_,qrel,hi); } else if(MODE==0){ const u32x2_t mw_=*((const __attribute__((address_space(3))) u32x2_t*)(shm3+LDS_AUX+wid*LDS_AUX_BYTES)+(t)*32+r32); mkx=mw_.x>>(4*hi); mky=mw_.y>>(4*hi); } \
      else { const __attribute__((address_space(3))) float*bp_=(const __attribute__((address_space(3))) float*)(shm3+LDS_AUX)+64*(t)+4*hi; \
        _Pragma("unroll") for(int g_=0;g_<4;++g_){ const f32x4_t b0_=*(const __attribute__((address_space(3))) f32x4_t*)(bp_+8*g_)-mhat, b1_=*(const __attribute__((address_space(3))) f32x4_t*)(bp_+32+8*g_)-mhat; \
          _Pragma("unroll") for(int j_=0;j_<4;++j_){ P0[4*g_+j_]+=b0_[j_]; P1[4*g_+j_]+=b1_[j_]; } SBAR(); } \
        int jb_=(t)-(NT-4); if(jb_>=0)cmask(P0,P1,jb_,qrel,hi); } }while(0)
  bool resc=false; unsigned mkx=0u,mky=0u;
  #define MSK(X,i,W) do{ float xv_=X[i]; unsigned mt_;   \
      asm volatile("v_bfe_i32 %1, %2, %3, 1\n\tv_and_b32 %0, %0, %1":"+v"(xv_),"=&v"(mt_):"v"(W),"n"(((i)&3)+8*((i)>>2))); X[i]=xv_; }while(0)
  #define START(P0,P1) do{ resc=false; \
    if(MODE==2){ const float rm=rowmax(P0,P1); const float dl=rm; mhat=fadd_s(mhat,dl); \
      _Pragma("unroll") for(int r=0;r<16;++r){P0[r]=fsub_s(P0[r],dl);P1[r]=fsub_s(P1[r],dl);} \
      } \
    _Pragma("unroll") for(int r=0;r<16;++r){P0[r]=__builtin_amdgcn_exp2f(P0[r]); if(MODE==0){MSK(P0,r,mkx);}} }while(0)
  #define RESC() do{ if(resc){ asm volatile("s_waitcnt lgkmcnt(0)":::"memory"); \
      _Pragma("unroll") for(int d_=0;d_<2;++d_) _Pragma("unroll") for(int r=0;r<16;++r)o[d_][r]*=wsf[crow(r,hi)]; } }while(0)
  f32x16 pA0,pA1,pB0,pB1;
  int sl_prev=0,sl_cur=0,sl_next=SLOTB;
  #define ROT() do{sl_prev=sl_cur;sl_cur=sl_next;sl_next=(sl_next==(NSLOT-1)*SLOTB)?0:sl_next+SLOTB;}while(0)
  DMA_K(2,2*SLOTB);
  WAIT_BAR(3);
  qkt(pA0,pA1,Kbase,qr,negm,r32,hi);asm volatile("s_nop 15\n\ts_nop 7":"+v"(pA0),"+v"(pA1));CMASK(pA0,pA1,0);
  START(pA0,pA1);
  _Pragma("unroll") for(int r=0;r<16;++r){pA1[r]=__builtin_amdgcn_exp2f(pA1[r]); if(MODE==0){MSK(pA1,r,mky);}}
  WAIT_BAR(0);
  DMA_K(3,0);DMA_V(1,SLOTB);
  ROT();
  kload8(kf,kp0+sl_cur);
  WAIT_BAR(2);
  s16x4 vlo[8],vhi[8]; u32x4 pw0,pw1,pw2,pw3;
  #define PKW(P,B) cvtpk_s(P[B],P[B+1])
  #define PAF(k) __builtin_bit_cast(bf16x8,pw##k)
  #define VFR(i) (bf16x8){vlo[i][0],vlo[i][1],vlo[i][2],vlo[i][3],vhi[i][0],vhi[i][1],vhi[i][2],vhi[i][3]}
  #define PIN(x) asm volatile("":"+v"(x))
  #define MX3(a,b,c) __builtin_fmaxf(__builtin_fmaxf((a),(b)),(c))
  #define GAPA(MF,A0,A1,A2,A3,W0,W1,PW) do{ MF; sacc+=A0; sacc+=A1; sacc+=A2; sacc+=A3; PIN(sacc); W0; W1; PIN(PW); SBAR(); }while(0)
  #define EX(v) __builtin_amdgcn_exp2f(v)
  #define GAPB(MF,X,B,W) do{ MF; X[B]=EX(X[B]); X[B+1]=EX(X[B+1]); X[B+2]=EX(X[B+2]); X[B+3]=EX(X[B+3]); if(MODE==0){MSK(X,B,W);MSK(X,(B)+1,W);MSK(X,(B)+2,W);MSK(X,(B)+3,W);} PIN(X); SBAR(); }while(0)
  #define VRD(i) do{ vlo[i]=vtr(vp_+(((i)>>2)*4096+((i)&3)*1024)); vhi[i]=vtr(vp_+(((i)>>2)*4096+((i)&3)*1024+512)); }while(0)
  #define KRD(G,j) do{ if(G){ kload2(kf,kp0+sl_next,j); SBAR(); } }while(0)
  #define STEP(C0,C1,P0,P1,t,GK,GV,GL) do{ SBAR(); \
    const lds_cptr vp_=vp0+sl_prev; \
    VRD(0); SBAR(); float sacc=(P0[0]+P0[1]); \
    GAPA(C0=__builtin_amdgcn_mfma_f32_32x32x16_bf16(kf[0],qr[0],negm,0,0,0), P0[2],P0[3],P0[4],P0[5],     pw0[0]=PKW(P0,0), pw0[1]=PKW(P0,2), pw0); \
    VRD(4); SBAR(); GAPA(C1=__builtin_amdgcn_mfma_f32_32x32x16_bf16(kf[1],qr[0],negm,0,0,0), P0[6],P0[7],P0[8],P0[9],     pw0[2]=PKW(P0,4), pw0[3]=PKW(P0,6), pw0); \
    VRD(1); SBAR(); GAPA(C0=__builtin_amdgcn_mfma_f32_32x32x16_bf16(kf[2],qr[1],C0,0,0,0),   P0[10],P0[11],P0[12],P0[13], pw1[0]=PKW(P0,8), pw1[1]=PKW(P0,10), pw1); \
    VRD(5); SBAR(); GAPA(C1=__builtin_amdgcn_mfma_f32_32x32x16_bf16(kf[3],qr[1],C1,0,0,0),   P0[14],P0[15],P1[0],P1[1],   pw1[2]=PKW(P0,12),pw1[3]=PKW(P0,14), pw1); \
    VRD(2); SBAR(); GAPA(C0=__builtin_amdgcn_mfma_f32_32x32x16_bf16(kf[4],qr[2],C0,0,0,0),   P1[2],P1[3],P1[4],P1[5],     pw2[0]=PKW(P1,0), pw2[1]=PKW(P1,2), pw2); \
    VRD(6); SBAR(); GAPA(C1=__builtin_amdgcn_mfma_f32_32x32x16_bf16(kf[5],qr[2],C1,0,0,0),   P1[6],P1[7],P1[8],P1[9],     pw2[2]=PKW(P1,4), pw2[3]=PKW(P1,6), pw2); \
    VRD(3); SBAR(); GAPA(C0=__builtin_amdgcn_mfma_f32_32x32x16_bf16(kf[6],qr[3],C0,0,0,0),   P1[10],P1[11],P1[12],P1[13], pw3[0]=PKW(P1,8), pw3[1]=PKW(P1,10), pw3); \
    VRD(7); SBAR(); GAPA(C1=__builtin_amdgcn_mfma_f32_32x32x16_bf16(kf[7],qr[3],C1,0,0,0),   P1[14],P1[15],0.f,0.f,       pw3[2]=PKW(P1,12),pw3[3]=PKW(P1,14), pw3); \
    l_reg+=sacc; \
    if(GK){DMA_K((t)+3,sl_cur);} if(GV){DMA_V((t)+1,sl_next);} \
    CMASK(C0,C1,t); \
    if(MODE==2){ float a=MX3(C0[0],C0[1],C1[0]),b=MX3(C0[2],C0[3],C1[1]); a=MX3(a,C1[2],C1[3]); \
      _Pragma("unroll") for(int r=4;r<16;r+=4){a=MX3(a,C0[r],C0[r+1]);b=MX3(b,C0[r+2],C0[r+3]);a=MX3(a,C1[r],C1[r+1]);b=MX3(b,C1[r+2],C1[r+3]);} \
      float rm=__builtin_fmaxf(a,b); { auto rr=__builtin_amdgcn_permlane32_swap(__float_as_uint(rm),__float_as_uint(rm),false,false); rm=__builtin_fmaxf(__uint_as_float(rr[0]),__uint_as_float(rr[1])); } \
      resc=false; \
      if(__builtin_expect(__any(rm>(float)THRL),0)){ const float dl=__builtin_fmaxf(rm,0.f); mhat+=dl; \
        _Pragma("unroll") for(int r=0;r<16;++r){C0[r]-=dl;C1[r]-=dl;} \
        \
        const float f=__builtin_amdgcn_exp2f(-dl); l_reg*=f; if(hi==0)wsf[r32]=f; resc=true; } } \
    SBAR(); \
    GAPB(o[0]=__builtin_amdgcn_mfma_f32_32x32x16_bf16(PAF(0),VFR(0),o[0],0,0,0), C0,0,mkx); \
    GAPB(o[1]=__builtin_amdgcn_mfma_f32_32x32x16_bf16(PAF(0),VFR(4),o[1],0,0,0), C0,4,mkx); \
    KRD(GL,0); GAPB(o[0]=__builtin_amdgcn_mfma_f32_32x32x16_bf16(PAF(1),VFR(1),o[0],0,0,0), C0,8,mkx); \
    KRD(GL,1); GAPB(o[1]=__builtin_amdgcn_mfma_f32_32x32x16_bf16(PAF(1),VFR(5),o[1],0,0,0), C0,12,mkx); \
    KRD(GL,2); GAPB(o[0]=__builtin_amdgcn_mfma_f32_32x32x16_bf16(PAF(2),VFR(2),o[0],0,0,0), C1,0,mky); \
    KRD(GL,3); GAPB(o[1]=__builtin_amdgcn_mfma_f32_32x32x16_bf16(PAF(2),VFR(6),o[1],0,0,0), C1,4,mky); \
    GAPB(o[0]=__builtin_amdgcn_mfma_f32_32x32x16_bf16(PAF(3),VFR(3),o[0],0,0,0), C1,8,mky); \
    GAPB(o[1]=__builtin_amdgcn_mfma_f32_32x32x16_bf16(PAF(3),VFR(7),o[1],0,0,0), C1,12,mky); \
    }while(0)
  int t=1;
  for(;t+5<NT;t+=2){
    STEP(pB0,pB1,pA0,pA1,t,true,true,true);     WAIT_BAR(2); RESC(); ROT();
    STEP(pA0,pA1,pB0,pB1,t+1,true,true,true);   WAIT_BAR(2); RESC(); ROT();
  }
  #define ENDW(tt) do{ if((tt)+3<NT){WAIT_BAR(2);} else if((tt)+2<NT){WAIT_BAR(1);} else {WAIT_BAR(0);} }while(0)
  for(;t+1<NT;t+=2){
    STEP(pB0,pB1,pA0,pA1,t,(t+3<NT),(t+1<NT),(t+1<NT));       ENDW(t);   RESC(); ROT();
    STEP(pA0,pA1,pB0,pB1,t+1,(t+4<NT),(t+2<NT),(t+2<NT));
    if(t+2<NT){ ENDW(t+1); RESC(); ROT(); } else { RESC(); }
  }
  { float sacc=pA0[0]+pA0[1]; _Pragma("unroll") for(int r=2;r<16;++r)sacc+=pA0[r]; _Pragma("unroll") for(int r=0;r<16;++r)sacc+=pA1[r]; l_reg+=sacc;
    pw0=(u32x4){PKW(pA0,0),PKW(pA0,2),PKW(pA0,4),PKW(pA0,6)};pw1=(u32x4){PKW(pA0,8),PKW(pA0,10),PKW(pA0,12),PKW(pA0,14)};pw2=(u32x4){PKW(pA1,0),PKW(pA1,2),PKW(pA1,4),PKW(pA1,6)};pw3=(u32x4){PKW(pA1,8),PKW(pA1,10),PKW(pA1,12),PKW(pA1,14)};
    SBAR(); pv(o,vb0+sl_cur,PAF(0),PAF(1),PAF(2),PAF(3)); }
  #undef PKW
  #undef PAF
  #undef VFR
  #undef PIN
  #undef MX3
  #undef GAPA
  #undef GAPB
  #undef MSK
  #undef EX
  #undef VRD
  #undef KRD
  #undef STEP
  #undef ENDW
  {auto rr=__builtin_amdgcn_permlane32_swap(__float_as_uint(l_reg),__float_as_uint(l_reg),false,false);l_reg=__uint_as_float(rr[0])+__uint_as_float(rr[1]);}
  if(hi==0)wsf[32+r32]=l_reg;asm volatile("s_waitcnt lgkmcnt(0)":::"memory");
  float rli[16];
  #pragma unroll
  for(int r=0;r<16;++r)rli[r]=__builtin_amdgcn_rcpf(wsf[32+crow(r,hi)]);
  bf16*Ow=O+(rowbase+q0+wid*QBLK)*DM+h*D;
  { bf16*stg=(bf16*)(shm+LDS_OST)+wid*2048;
    #pragma unroll
    for(int r=0;r<16;++r){const int orow=crow(r,hi);
      #pragma unroll
      for(int d0=0;d0<2;++d0)stg[orow*64+d0*32+r32]=__float2bfloat16(o[d0][r]*rli[r]);}
    asm volatile("s_waitcnt lgkmcnt(0)":::"memory");
    #pragma unroll
    for(int i=0;i<4;++i){const int row=i*8+(lane>>3),ch=lane&7; const u32x4 v=*(const u32x4*)(stg+row*64+ch*8); ATTN_STORE16(Ow+(long)row*DM+ch*8,v);} }
  asm volatile("s_waitcnt lgkmcnt(0)\n\ts_barrier":::"memory");
  #undef DMA_K
  #undef DMA_V
  #undef CMASK
  #undef START
  #undef RESC
  #undef ROT
}
constexpr int ATTN_LDS_BYTES=LDS_BYTES;
#undef SBAR
#undef WAIT_BAR
}

constexpr int SCHED_OFF = 156 * 1024;
constexpr int CW_ATTQ = 8192;
template <int MODE> __device__ __forceinline__ void attn_phase_fa(const Ptrs& P, char* lds, int G, int bx, bf16* Oout, int lyr) {
    typedef attn_body::bf16 abf;
    if (MODE != 1) {
#pragma unroll 1
        for (int u = bx; u < 2048; u += G) {
            const int bh = (G == 256) ? ((u & 7) * 32 + ((u & 255) >> 3)) : (u & 255), qb = 7 - (u >> 8), b = bh >> 4, h = bh & 15;
            if (MODE == 2) attn_body::attn_unit<8, 2, 1024>(b, h, h, qb, (const abf*)WSP(bf16, OFF_QO), (const abf*)WSP(bf16, OFF_QO), (const abf*)WSP(bf16, OFF_QO), (abf*)Oout, lds, nullptr, nullptr, 0);
            else attn_body::attn_unit<8, 0, 256>(b, h, h >> 2, qb, (const abf*)WSP(bf16, OFF_QO), (const abf*)WSP(bf16, OFF_KA), (const abf*)WSP(bf16, OFF_VA), (abf*)Oout, lds, WSP(unsigned, OFF_MASK), nullptr, 0);
        }
    } else {
        volatile LAS unsigned* sch = (volatile LAS unsigned*)((LAS unsigned char*)lds + SCHED_OFF);
        unsigned* qhead = (unsigned*)(P.ws + OFF_CTL) + CW_ATTQ + 64 * (lyr & 1) + 128 * (Oout != WSP(bf16, OFF_QO));
#pragma unroll 1
        for (;;) {
            int tid_q = threadIdx.x; asm volatile("" : "+v"(tid_q));
            const int lane = tid_q & 63, wave = __builtin_amdgcn_readfirstlane(tid_q >> 6);
            if (wave == 0) {
                unsigned u = 0;
                if (lane == 0) u = __hip_atomic_fetch_add(qhead, 1u, __ATOMIC_RELAXED, __HIP_MEMORY_SCOPE_AGENT);
                u = (unsigned)__builtin_amdgcn_readfirstlane((int)u);
                unsigned t0 = 0;
                if (u < 2048u) {
                    const int bh = u & 255, qb = 7 - (int)(u >> 8);
                    const float* nb = WSP(float, OFF_NB) + (size_t)bh * KROWS;
                    const float lim = nb[PRE + 256 * qb] - WSP(float, OFF_GT)[GT_SKIP];
                    const int cand = 2 * lane;
                    const bool ok = cand <= 4 * qb && (cand == 0 || nb[64 * cand - 1] <= lim);
                    const unsigned long long m = __ballot(ok);
                    t0 = 2u * (unsigned)(63 - __builtin_clzll(m));
                }
                if (lane == 0) { sch[0] = u; sch[1] = t0; }
            }
            asm volatile("s_waitcnt vmcnt(0) lgkmcnt(0)\n\ts_barrier" ::: "memory");
            const unsigned u = sch[0], t0 = sch[1];
            if (u >= 2048u) break;
            const int bh = u & 255, qb = 7 - (int)(u >> 8), b = bh >> 4, h = bh & 15;
            attn_body::attn_unit<8, 1, 1024>(b, h, h, qb, (const abf*)WSP(bf16, OFF_QO), (const abf*)WSP(bf16, OFF_KB), (const abf*)WSP(bf16, OFF_VB), (abf*)Oout, lds, nullptr, WSP(float, OFF_NB) + (size_t)bh * KROWS, (int)t0);
        }
    }
}

typedef GAS unsigned gu32;
#define RLX_AGENT __ATOMIC_RELAXED, __HIP_MEMORY_SCOPE_AGENT
#define XB_TMO      128
#define XB_XCNT(j)  (256  + 64 * (j))
#define XB_XSUB(j)  (1280 + 64 * (j))
#define XB_XGEN(j)  (2304 + 64 * (j))
#define XB_TOP      3328
#define XB_TOPGEN   3392
#define XCD_BAR_WORDS 3456
#define XB_SPIN_CAP (1u << 18)

__device__ __forceinline__ unsigned xb_ld(unsigned* p)              { return __hip_atomic_load(p, __ATOMIC_RELAXED, __HIP_MEMORY_SCOPE_AGENT); }
__device__ __forceinline__ unsigned xb_add(unsigned* p, unsigned v) { return __hip_atomic_fetch_add(p, v, __ATOMIC_RELAXED, __HIP_MEMORY_SCOPE_AGENT); }
__device__ __forceinline__ unsigned xb_xcc_id() { return (unsigned)__builtin_amdgcn_s_getreg((3 << 11) | 20) & 0xFu; }
#define XB_SPIN(cond, bar) do { unsigned _sp = 0; while (cond) { __builtin_amdgcn_s_sleep(1); \
    if ((++_sp & 255u) == 0u) { if (xb_ld(&(bar)[XB_TMO])) break; if (_sp > XB_SPIN_CAP) { atomicAdd(&(bar)[XB_TMO], 1u); break; } } } } while (0)

struct XcdBarrier {
    unsigned* bar; unsigned x;
    volatile LAS unsigned* st;
};

__device__ __forceinline__ XcdBarrier xcd_barrier_post(unsigned* bar, volatile LAS unsigned* st) {
    XcdBarrier b; b.bar = bar; b.x = xb_xcc_id(); b.st = st;
    if (threadIdx.x == 0) (void)xb_add(&bar[XB_XCNT(b.x)], 1u);
    return b;
}
__device__ __forceinline__ void xcd_barrier_complete(unsigned* bar, unsigned x, unsigned& nloc, unsigned& nx) {
    const unsigned G = gridDim.x * gridDim.y * gridDim.z;
    unsigned sum, cnt, mine, sp = 0u;
    for (;;) {
        sum = 0u; cnt = 0u; mine = 0u;
#pragma unroll
        for (unsigned j = 0; j < 16; ++j) { const unsigned c = xb_ld(&bar[XB_XCNT(j)]); sum += c; cnt += (c > 0u) ? 1u : 0u; mine = (j == x) ? c : mine; }
        if (sum == G) break;
        __builtin_amdgcn_s_sleep(1);
        if ((++sp & 255u) == 0u) { if (xb_ld(&bar[XB_TMO])) break; if (sp > XB_SPIN_CAP) { atomicAdd(&bar[XB_TMO], 1u); break; } }
    }
    nloc = mine > 0u ? mine : 1u; nx = cnt > 0u ? cnt : 1u;
}

__device__ __forceinline__ void xcd_barrier(const XcdBarrier& b) {
    asm volatile("s_waitcnt vmcnt(0)" ::: "memory");
    __syncthreads();
    if (threadIdx.x == 0) {
        unsigned* bar = b.bar;
        __builtin_amdgcn_s_waitcnt(0);
        unsigned nloc = b.st[0], nx = b.st[1];
        if (nloc == 0u) { xcd_barrier_complete(bar, b.x, nloc, nx); b.st[0] = nloc; b.st[1] = nx; }
        const unsigned old = xb_add(&bar[XB_XSUB(b.x)], 1u);
        const unsigned gen = old / nloc;
        if (old + 1u == (gen + 1u) * nloc) {
            __builtin_amdgcn_fence(__ATOMIC_RELEASE, "agent");
            asm volatile("s_waitcnt vmcnt(0)" ::: "memory");
            const unsigned og = xb_add(&bar[XB_TOP], 1u);
            const unsigned tg = og / nx;
            if (og + 1u == (tg + 1u) * nx) xb_add(&bar[XB_TOPGEN], 1u);
            else XB_SPIN(xb_ld(&bar[XB_TOPGEN]) == tg, bar);
            __builtin_amdgcn_fence(__ATOMIC_ACQUIRE, "agent");
            xb_add(&bar[XB_XGEN(b.x)], 1u);
            asm volatile("s_waitcnt vmcnt(0)" ::: "memory");
        } else {
            XB_SPIN(xb_ld(&bar[XB_XGEN(b.x)]) == gen, bar);
            __builtin_amdgcn_fence(__ATOMIC_ACQUIRE, "agent");
            asm volatile("s_waitcnt vmcnt(0)" ::: "memory");
        }
    }
    __syncthreads();
}


constexpr int NWAVES = 8;
constexpr int LDS_BYTES = 160 * 1024;
constexpr int MISC_OFF = LDS_BYTES - 256;
constexpr int CW_BAR = 4096;

struct Args { Ptrs P; int ph_lo, ph_hi; };
constexpr int N_PHASES = 1 + 8 * 4;
#ifndef PROBE_ID
#define PROBE_ID 0
#endif
#ifndef PROBE_DRY
#define PROBE_DRY 0
#endif
#ifndef PROBE_REPS
#define PROBE_REPS 3
#endif

#define SITE_IDS() int tid_s = threadIdx.x; asm volatile("" : "+v"(tid_s)); const int lane = tid_s & 63; const int wave = __builtin_amdgcn_readfirstlane(tid_s >> 6); \
    const int gw = bx * NWAVES + wave; (void)gw; (void)lane
__global__ void __launch_bounds__(NWAVES * 64, 2) mega_fwd(Args args) {
    extern __shared__ __attribute__((aligned(16))) unsigned char lds[];
    const Ptrs& P = args.P;
    const int G = gridDim.x, bx = blockIdx.x, ngw = G * NWAVES;
    volatile LAS unsigned* MISC = (volatile LAS unsigned*)((LAS unsigned char*)lds + MISC_OFF);
    for (int u = threadIdx.x; u < 64; u += NWAVES * 64) MISC[u] = 0u;
    __syncthreads();
    XcdBarrier bar = xcd_barrier_post((unsigned*)(P.ws + OFF_CTL) + CW_BAR, MISC + 8);
    const int lo = args.ph_lo, hi = args.ph_hi;
#define IN(k) (lo <= (k) && (k) < hi)
#define SEAM(k) do { if (IN(k) && IN((k) + 1)) xcd_barrier(bar); } while (0)
#define WSCR() ((float*)lds + wave * (64 * 65))

#define REPS(id) ((PROBE_ID == (id)) ? PROBE_REPS : 1)
#pragma unroll 1
    for (int rp = REPS(9); rp > 0; --rp) { if (IN(0)) { SITE_IDS(); prologue_work(P, gw, ngw, WSCR(), lane); } SEAM(0); }
#pragma unroll 1
    for (int l = 0; l < 4; ++l) {
        const int pb = 1 + 8 * l;
        if (l < 2) {
#pragma unroll 1
            for (int rp = REPS(1); rp > 0; --rp) {
            if (IN(pb + 0)) {
                { SITE_IDS(); if (l == 0 && rp == 1) for (int j = gw; j < 4 * D; j += ngw) colsum_job(P, j, lane);
                  for (int j = bx; j < 33; j += G) strip_job(P, SP_INA, l, M / 16, j, lane, 8, wave, (float*)lds);
                  for (int j = gw; j < M / 16; j += ngw) strip_job(P, SP_INA, l, j, 32, lane); }
                { pg8::Gemm g{WSP(bf16, OFF_H8A), WSP(bf16, OFF_WIN8 + l * SZ_WIN8), M, 1536, D / 2}; pg8::StaticOrder So; So.init(M, 1536, G, bx);
                  EpiInA E{P, l, 1, 0};
                  pg8::gemm_phase<EpiInA, pg8::StaticOrder, true, true, 1, true>((LAS unsigned char*)lds, g, So, E); }
                { pg8::Gemm g{WSP(bf16, OFF_H), WSP(bf16, OFF_WIN + l * SZ_WIN) + (size_t)1536 * D, M, 512, D}; pg8::StaticOrder So; So.init(M, 512, G, bx);
                  EpiInA E{P, l, 0, 6};
                  pg8::gemm_phase<EpiInA, pg8::StaticOrder, true, true>((LAS unsigned char*)lds, g, So, E); }
                { SITE_IDS(); zero_pads(P, gw, ngw, lane); }
            }
            SEAM(pb + 0); }
#pragma unroll 1
            for (int rp = REPS(2); rp > 0; --rp) {
            if (IN(pb + 1)) { SITE_IDS();
                const int itv = (G == 256) ? ((bx & 7) * 256 + (bx >> 3) * 8 + wave) : gw;
                for (int it = itv; it < NB * 128; it += ngw) { const int b = it >> 7, w = it & 127;
#pragma unroll 1
                    for (int j = 0; j < 8; ++j) { const int g2 = 128 * j + ((j & 1) ? 127 - w : w); indexer_pass(P, b, g2, lane, (LAS unsigned*)lds + wave * (IDX_LDS_PER_WAVE / 4), rp > 1 ? PROBE_DRY : 0); } } }
            SEAM(pb + 1); }
#pragma unroll 1
            for (int rp = REPS(3); rp > 0; --rp) {
            if (IN(pb + 2)) {
                { SITE_IDS(); attn_naive_work<0>(P, gw, ngw, WSCR(), lane, M, MR); }
                __syncthreads();
                if (PROBE_DRY && rp > 1) attn_phase_fa<2>(P, (char*)lds, G, bx, (bf16*)P.out, l); else
                attn_phase_fa<0>(P, (char*)lds, G, bx, rp > 1 ? (bf16*)P.out : WSP(bf16, OFF_QO), l);
            }
            SEAM(pb + 2); }
        } else {
#pragma unroll 1
            for (int rp = REPS(7); rp > 0; --rp) {
            if (IN(pb + 0)) {
                if (l == 2) { SITE_IDS(); for (int j = bx; j < 33; j += G) strip_job(P, SP_QKVB, l, M / 16, 16 + j, lane, 8, wave, (float*)lds);
                  for (int j = gw; j < M / 16; j += ngw) strip_job(P, SP_QKVB, l, j, 48, lane); }
                pg8::Gemm g{WSP(bf16, OFF_H8B), WSP(bf16, OFF_WQKV8 + (l == 2 ? 0 : size_t(3072) * D)), M, l == 2 ? 3072 : 1024, D / 2}; pg8::StaticOrder So; So.init(M, g.N, G, bx);
                EpiInB E{P, l};
                pg8::gemm_phase<EpiInB, pg8::StaticOrder, true, true, 1, true>((LAS unsigned char*)lds, g, So, E);
            }
            SEAM(pb + 0); }
            if (IN(pb + 1) && l == 2) { SITE_IDS(); for (int bh = bx; bh < 256; bh += G) scan_work(P, bh, (float*)lds, tid_s); }
            SEAM(pb + 1);
#pragma unroll 1
            for (int rp = REPS(8); rp > 0; --rp) {
            if (IN(pb + 2)) attn_phase_fa<1>(P, (char*)lds, G, bx, rp > 1 ? (bf16*)P.out : WSP(bf16, OFF_QO), l);
            SEAM(pb + 2); }
        }
#pragma unroll 1
        for (int rp = REPS(4); rp > 0; --rp) {
        if (IN(pb + 3)) {
            if (l < 2 && rp == 1) { SITE_IDS(); for (int j = bx; j < 16; j += G) strip_job(P, SP_RES_O, l, M / 16, j, lane, 8, wave, (float*)lds); }
            pg8::Gemm g{WSP(bf16, OFF_QO), wo_t(P, l), M, D, D}; pg8::StaticOrder So; So.init(M, D, G, bx);
            EpiRes<false> E{P, l, rp > 1};
            pg8::gemm_phase<EpiRes<false>, pg8::StaticOrder, true, true>((LAS unsigned char*)lds, g, So, E);
        }
        SEAM(pb + 3); }
#pragma unroll 1
        for (int rp = REPS(5); rp > 0; --rp) {
        if (IN(pb + 4)) {
            if (l < 2) { SITE_IDS(); for (int j = bx; j < 64; j += G) strip_job(P, SP_MLP1, l, M / 16, j, lane, 8, wave, (float*)lds); }
            pg8::Gemm g{WSP(bf16, OFF_HQ), WSP(bf16, OFF_W18 + l * SZ_W28), M, FF, D / 2}; pg8::StaticOrder So; So.init(M, FF, G, bx);
            EpiRelu2 E{P, l, (PROBE_DRY && rp > 1) ? 1 : 0};
            pg8::gemm_phase<EpiRelu2, pg8::StaticOrder, true, true, 2, true>((LAS unsigned char*)lds, g, So, E);
        }
        SEAM(pb + 4); }
#pragma unroll 1
        for (int rp = REPS(6); rp > 0; --rp) {
        if (IN(pb + 5)) {
            if (l < 2 && rp == 1) { SITE_IDS(); for (int j = bx; j < 16; j += G) strip_job(P, SP_RES_M, l, M / 16, j, lane, 8, wave, (float*)lds); }
            pg8::StaticOrder So; So.init(M, D, G, bx); EpiRes<true> E{P, l, rp > 1};
            pg8::Gemm g{WSP(bf16, OFF_U), WSP(bf16, OFF_W28 + l * SZ_W28), M, D, FF / 2};
            pg8::gemm_phase<EpiRes<true>, pg8::StaticOrder, true, true, 2, true>((LAS unsigned char*)lds, g, So, E);
        }
        if (rp > 1 || (l < 3 && IN(pb + 5) && IN(pb + 8))) xcd_barrier(bar); }
    }
#undef IN
#undef SEAM
}

#ifndef MK_ONE_LAUNCH
#define MK_ONE_LAUNCH 1
#endif
extern "C" void kernel_launch(void* const* d_in, const int* in_sizes, int n_in, void* d_out, int out_size, void* d_ws, size_t ws_size, hipStream_t stream) {
    static int grid = 0;
    if (grid == 0) {
        if (n_in != 17 || in_sizes[0] != M * D || out_size != M * D || ws_size < WS_END) {
            fprintf(stderr, "kernel_launch: unexpected shapes (n_in %d, in0 %d, out %d, ws %zu, need %zu)\n", n_in, n_in > 0 ? in_sizes[0] : -1, out_size, ws_size, (size_t)WS_END); grid = -1; return; }
        int dev = 0, cus = 0, per_cu = 0;
        if (hipGetDevice(&dev) != hipSuccess || hipDeviceGetAttribute(&cus, hipDeviceAttributeMultiprocessorCount, dev) != hipSuccess) { grid = -1; return; }
        if (hipFuncSetAttribute((const void*)mega_fwd, hipFuncAttributeMaxDynamicSharedMemorySize, LDS_BYTES) != hipSuccess) { fprintf(stderr, "kernel_launch: hipFuncSetAttribute failed\n"); grid = -1; return; }
        if (hipOccupancyMaxActiveBlocksPerMultiprocessor(&per_cu, (const void*)mega_fwd, NWAVES * 64, LDS_BYTES) != hipSuccess || per_cu < 1)
            fprintf(stderr, "kernel_launch: note: occupancy query reports %d workgroups per CU\n", per_cu);
        (void)hipGetLastError();
        grid = cus;
    }
    if (grid < 0) return;
    (void)hipMemsetAsync((char*)d_ws + OFF_CTL, 0, 65536, stream);
    Args a{};
    for (int i = 0; i < 17; ++i) a.P.in[i] = (const float*)d_in[i];
    a.P.out = (float*)d_out; a.P.ws = (unsigned char*)d_ws;
#if MK_ONE_LAUNCH
    a.ph_lo = 0; a.ph_hi = N_PHASES;
    hipLaunchKernelGGL(mega_fwd, dim3(grid), dim3(NWAVES * 64), LDS_BYTES, stream, a);
#else
    for (int ph = 0; ph < N_PHASES; ++ph) { a.ph_lo = ph; a.ph_hi = ph + 1; hipLaunchKernelGGL(mega_fwd, dim3(grid), dim3(NWAVES * 64), LDS_BYTES, stream, a); }
#endif
}
```

```cpp
#include <hip/hip_runtime.h>
#include <cstdint>
#include <cstdio>

typedef unsigned short bf16;
typedef short bf16x8 __attribute__((ext_vector_type(8)));
typedef float f32x4 __attribute__((ext_vector_type(4)));
typedef float f32x16 __attribute__((ext_vector_type(16)));
typedef unsigned u32x4 __attribute__((ext_vector_type(4)));

constexpr int NB = 16, S = 2048, D = 1024, NMETA = 16, HD = 64, FF = 4096;
constexpr int M = NB * S, MR = M + NMETA;
constexpr int PRE = 64, KROWS = PRE + S;
constexpr int NWORDS = KROWS / 32;
constexpr int NPOS = S + NMETA;
constexpr int WIN_ROWS = 2048 + 96, WKV_ROWS = 2048 + 32;
constexpr float EPS = 1e-6f;
constexpr float LOG2E = 1.4426950408889634f;
constexpr float C2 = 0.125f * LOG2E;
constexpr int TOPK = 256;

constexpr size_t al4k(size_t x) { return (x + 4095) & ~size_t(4095); }
constexpr size_t OFF_CTL = 0, SZ_CTL = size_t(4) << 20;
constexpr size_t OFF_ROPE = OFF_CTL + SZ_CTL, SZ_ROPE = al4k(size_t(2) * NPOS * 32 * 4);
constexpr size_t OFF_SSQ = OFF_ROPE + SZ_ROPE, SZ_SSQ1 = al4k(size_t(MR) * 16 * 4);
constexpr size_t OFF_GT = OFF_SSQ + 2 * SZ_SSQ1, SZ_GT = 4096;
constexpr int GT_AQG = 0, GT_AKG = 128, GT_KFB = 256, GT_KKG = 272, GT_BQG = 336, GT_N = 464, GT_SKIP = 464;
constexpr size_t OFF_W1B = OFF_GT + SZ_GT;
constexpr size_t SZ_W1 = size_t(FF) * D * 2, SZ_W2 = SZ_W1, SZ_SQ = size_t(D) * D * 2;
constexpr size_t OFF_W2B = OFF_W1B + 2 * SZ_W1;
constexpr size_t OFF_WOB = OFF_W2B + 2 * SZ_W2;
constexpr size_t OFF_WQ1 = OFF_WOB + 2 * SZ_SQ;
constexpr size_t OFF_WQ0 = OFF_WQ1 + SZ_SQ;
constexpr size_t OFF_WKV = OFF_WQ0 + SZ_SQ, SZ_WKV = al4k(size_t(WKV_ROWS) * D * 2);
constexpr size_t OFF_H = OFF_WKV + SZ_WKV, SZ_H = al4k(size_t(MR) * D * 2);
constexpr size_t OFF_SCR = OFF_H + SZ_H;
constexpr size_t OFF_U = OFF_SCR, SZ_U = al4k(size_t(MR) * FF * 2);
constexpr size_t OFF_QO = OFF_SCR, SZ_QO = al4k(size_t(MR) * D * 2);
constexpr size_t OFF_KA = OFF_QO + SZ_QO, SZ_KA = al4k(size_t(NB) * KROWS * 256 * 2 + 65536);
constexpr size_t OFF_VA = OFF_KA + SZ_KA;
constexpr size_t OFF_KI = OFF_VA + SZ_KA, SZ_KI = al4k(size_t(NB) * KROWS * 64 * 2 + 65536);
constexpr size_t OFF_QI = OFF_KI + SZ_KI, SZ_QI = al4k(size_t(MR) * 512 * 2);
constexpr size_t OFF_WI = OFF_QI + SZ_QI, SZ_WI = al4k(size_t(MR) * 8 * 4);
constexpr size_t OFF_MASK = OFF_WI + SZ_WI, SZ_MASK = al4k(size_t(M) * NWORDS * 4);
constexpr size_t OFF_LF = OFF_MASK + SZ_MASK, SZ_LF = al4k(size_t(MR) * 16 * 4);
constexpr size_t OFF_UM = OFF_U + size_t(M) * FF * 2;
constexpr size_t OFF_W28 = OFF_W2B, SZ_W28 = size_t(D) * FF;
constexpr size_t OFF_W18 = OFF_W1B;
static_assert(OFF_LF + SZ_LF <= OFF_U + SZ_U && OFF_UM + size_t(16) * FF * 2 <= OFF_U + SZ_U && 4 * SZ_W28 <= 2 * SZ_W2, "mixer scratch / hidden / fp8 W2 fit");
constexpr size_t OFF_X = OFF_SCR + SZ_U;
constexpr size_t SZ_WIN = al4k(size_t(WIN_ROWS) * D * 2);
constexpr size_t OFF_WIN = OFF_X;
constexpr size_t OFF_WOA = OFF_WIN + 2 * SZ_WIN;
constexpr size_t OFF_W1A = OFF_WOA + 2 * SZ_SQ;
constexpr size_t OFF_W2A = OFF_W1A + 2 * SZ_W1;
constexpr size_t OFF_KB = OFF_X, SZ_KB = al4k(size_t(NB) * KROWS * D * 2 + 262144);
constexpr size_t OFF_VB = OFF_KB + SZ_KB;
constexpr size_t OFF_NB = OFF_VB + SZ_KB, SZ_NB = al4k(size_t(NB) * 16 * KROWS * 4);
constexpr size_t WS_END = OFF_NB + SZ_NB;
constexpr size_t SZ_H8 = size_t(M) * D, OFF_H8A = OFF_X + (size_t(48) << 20), OFF_H8B = OFF_SCR + (size_t(160) << 20);
constexpr size_t SZ_WIN8 = size_t(2048) * D, OFF_WIN8 = OFF_H8A + SZ_H8;
constexpr size_t OFF_WQKV8 = WS_END;
constexpr size_t OFF_HQ = OFF_SCR + (size_t(192) << 20);
constexpr int EPI_RS_OFF = 132 * 1024;
constexpr int CW_CS = 12288;
constexpr float QA = 127.f / 5.f, QW1 = 127.f * 32.f / 4.5f, QU = 255.f / 24.f, QW2 = 127.f * 64.f / 4.f, SQRT_QU = 3.2596012026f;
constexpr float IN_F8S = 32.f;
static_assert(OFF_W2A + 2 * SZ_W2 <= OFF_H8A && OFF_WIN8 + 2 * SZ_WIN8 <= WS_END && OFF_LF + SZ_LF <= OFF_H8B && size_t(M) * FF <= (size_t(160) << 20) && OFF_H8B + SZ_H8 <= OFF_HQ && OFF_HQ + SZ_H8 <= OFF_UM && OFF_WQKV8 + size_t(4096) * D <= (size_t(512) << 20), "8-bit buffers fit");
static_assert(OFF_W2A + 2 * SZ_W2 <= WS_END, "A weights fit in region X");
static_assert(WS_END <= (size_t(512) << 20), "d_ws map fits 512 MiB");

#define GAS __attribute__((address_space(1)))
#define LAS __attribute__((address_space(3)))
__device__ __forceinline__ unsigned f2bf(float f) { unsigned u = __builtin_bit_cast(unsigned, f); return (u + 0x7fffu + ((u >> 16) & 1u)) >> 16; }
__device__ __forceinline__ float bf2f(unsigned h) { return __builtin_bit_cast(float, h << 16); }
__device__ __forceinline__ unsigned pk2(float lo, float hi) { return f2bf(lo) | (f2bf(hi) << 16); }
typedef unsigned u32x2 __attribute__((ext_vector_type(2)));
__device__ __forceinline__ size_t blk8(int R, int c, int rowlen) { return ((size_t)(R >> 4) * (rowlen / 32) + (c >> 5)) * 512 + (R & 15) * 32 + (c & 31); }
typedef int i32x4v __attribute__((ext_vector_type(4)));
__device__ __forceinline__ unsigned pk4_fp8(float a, float b, float c, float d) {
    a = fminf(fmaxf(a, -448.f), 448.f); b = fminf(fmaxf(b, -448.f), 448.f); c = fminf(fmaxf(c, -448.f), 448.f); d = fminf(fmaxf(d, -448.f), 448.f);
    int p = __builtin_amdgcn_cvt_pk_fp8_f32(a, b, 0, false); p = __builtin_amdgcn_cvt_pk_fp8_f32(c, d, p, true); return (unsigned)p; }
__device__ __forceinline__ unsigned pk4_i8(float a, float b, float c, float d) {
    a += 128.f; b += 128.f; c += 128.f; d += 128.f;
    int p = __builtin_amdgcn_cvt_pk_u8_f32(a, 0, 0); p = __builtin_amdgcn_cvt_pk_u8_f32(b, 1, p); p = __builtin_amdgcn_cvt_pk_u8_f32(c, 2, p); p = __builtin_amdgcn_cvt_pk_u8_f32(d, 3, p);
    return (unsigned)p ^ 0x80808080u; }
__device__ __forceinline__ float red16(float v) { v += __shfl_xor(v, 1); v += __shfl_xor(v, 2); v += __shfl_xor(v, 4); v += __shfl_xor(v, 8); return v; }
__device__ __forceinline__ float wave_sum(float v) {
#pragma unroll
    for (int o = 1; o < 64; o <<= 1) v += __shfl_xor(v, o);
    return v;
}
__device__ __forceinline__ float wave_max(float v) {
#pragma unroll
    for (int o = 1; o < 64; o <<= 1) v = fmaxf(v, __shfl_xor(v, o));
    return v;
}

struct Ptrs {
    const float* in[17]; float* out; unsigned char* ws;
};
#define WSP(T, off) ((T*)(P.ws + (off)))
__device__ __forceinline__ bf16* w1_t(const Ptrs& P, int l) { return l < 2 ? WSP(bf16, OFF_W1A + l * SZ_W1) : WSP(bf16, OFF_W1B + (l - 2) * SZ_W1); }
__device__ __forceinline__ bf16* w2_t(const Ptrs& P, int l) { return l < 2 ? WSP(bf16, OFF_W2A + l * SZ_W2) : WSP(bf16, OFF_W2B + (l - 2) * SZ_W2); }
__device__ __forceinline__ bf16* wo_t(const Ptrs& P, int l) { return l < 2 ? WSP(bf16, OFF_WOA + l * SZ_SQ) : WSP(bf16, OFF_WOB + (l - 2) * SZ_SQ); }
__device__ __forceinline__ float* ssq_p(const Ptrs& P, int k) { return WSP(float, OFF_SSQ + (size_t)(k & 1) * SZ_SSQ1); }

struct MatDesc { const float* W; int pitch, K, col0, ncols, nblk; const float* gain; bf16* WT; int dst0, perm; unsigned char* WT8; float s8; int q8; int* cs; };
__device__ __forceinline__ bool get_mat(const Ptrs& P, int id, MatDesc& d) {
    d.gain = nullptr; d.perm = 0; d.dst0 = 0; d.col0 = 0; d.WT8 = nullptr; d.s8 = IN_F8S; d.q8 = 0; d.cs = nullptr;
    if (id < 2) { d.W = P.in[6] + (size_t)id * D * 2120; d.pitch = 2120; d.K = D; d.ncols = 2048; d.nblk = 64; d.gain = P.in[2] + id * D; d.WT = WSP(bf16, OFF_WIN + id * SZ_WIN); d.perm = 1; d.WT8 = WSP(unsigned char, OFF_WIN8 + id * SZ_WIN8); return true; }
    if (id < 4) { const int l = id - 2; d.W = P.in[6] + (size_t)l * D * 2120; d.pitch = 2120; d.K = D; d.col0 = 2048; d.ncols = 72; d.nblk = 3; d.gain = P.in[2] + l * D; d.WT = WSP(bf16, OFF_WIN + l * SZ_WIN); d.dst0 = 2048; return true; }
    if (id < 6) { const int l = id - 4; d.W = P.in[9] + (size_t)l * D * D; d.pitch = D; d.K = D; d.ncols = D; d.nblk = 32; d.WT = WSP(bf16, OFF_WOA + l * SZ_SQ); return true; }
    if (id < 10) { const int l = id - 6; d.W = P.in[4] + (size_t)l * D * FF; d.pitch = FF; d.K = D; d.ncols = FF; d.nblk = 128; d.gain = P.in[3] + l * D; d.WT = l < 2 ? w1_t(P, l) : nullptr; d.WT8 = WSP(unsigned char, OFF_W18 + l * SZ_W28); d.s8 = QW1; d.q8 = 1; return true; }
    if (id < 14) { const int l = id - 10; d.W = P.in[5] + (size_t)l * FF * D; d.pitch = D; d.K = FF; d.ncols = D; d.nblk = 32; d.WT = l < 2 ? w2_t(P, l) : nullptr; d.WT8 = WSP(unsigned char, OFF_W28 + l * SZ_W28); d.s8 = QW2; d.q8 = 1; return true; }
    if (id == 14) { d.W = P.in[11]; d.pitch = 2064; d.K = D; d.col0 = 0; d.ncols = 1024; d.nblk = 32; d.gain = P.in[10]; d.WT = WSP(bf16, OFF_WKV); d.perm = 1; d.WT8 = WSP(unsigned char, OFF_WQKV8 + size_t(1024) * D); return true; }
    if (id == 15) { d.W = P.in[11]; d.pitch = 2064; d.K = D; d.col0 = 1024; d.ncols = 1024; d.nblk = 32; d.gain = P.in[10]; d.WT = WSP(bf16, OFF_WKV); d.perm = 1; d.dst0 = 1024; d.WT8 = WSP(unsigned char, OFF_WQKV8 + size_t(1024) * D); return true; }
    if (id == 16) { d.W = P.in[11]; d.pitch = 2064; d.K = D; d.col0 = 2048; d.ncols = 16; d.nblk = 1; d.gain = P.in[10]; d.WT = WSP(bf16, OFF_WKV); d.dst0 = 2048; return true; }
    if (id < 19) { const int j = id - 17; d.W = P.in[14] + (size_t)j * D * D; d.pitch = D; d.K = D; d.ncols = D; d.nblk = 32; d.gain = P.in[2] + (2 + j) * D; d.WT = WSP(bf16, j == 0 ? OFF_WQ0 : OFF_WQ1); d.perm = 1; d.WT8 = WSP(unsigned char, OFF_WQKV8 + (j == 0 ? 0 : size_t(3072) * D)); return true; }
    if (id < 21) { const int j = id - 19; d.W = P.in[16] + (size_t)j * D * D; d.pitch = D; d.K = D; d.ncols = D; d.nblk = 32; d.WT = WSP(bf16, OFF_WOB + j * SZ_SQ); return true; }
    return false;
}
constexpr int NMAT = 21;
__device__ __forceinline__ void transpose_block(const MatDesc& d, int item, float* scr, int lane) {
    const int nb64 = (d.nblk + 1) >> 1, kb = item / nb64, nb = item % nb64, k0 = 64 * kb, n0 = 64 * nb;
    const int c4 = lane & 15; const bool okc = (n0 + 4 * c4) < d.ncols;
#pragma unroll 8
    for (int i = 0; i < 16; ++i) { const int kk = 4 * i + (lane >> 4);
        f32x4 v = okc ? *(const f32x4*)(d.W + (size_t)(k0 + kk) * d.pitch + d.col0 + n0 + 4 * c4) : (f32x4){0.f, 0.f, 0.f, 0.f};
        if (d.gain) v = v * d.gain[k0 + kk];
        float* sp = scr + kk * 65 + 4 * c4; sp[0] = v[0]; sp[1] = v[1]; sp[2] = v[2]; sp[3] = v[3]; }
    __builtin_amdgcn_s_waitcnt(0xc07f); asm volatile("" ::: "memory");
    const int c = lane & 7;
#pragma unroll
    for (int hb = 0; hb < 2; ++hb) {
        const int nn0 = n0 + 32 * hb; if (nn0 >= 32 * d.nblk) break;
        int drow0;
        if (d.perm) { const int pn = nn0 >> 8, wc = (nn0 & 255) >> 6, bj = (nn0 & 63) >> 5; drow0 = d.dst0 + 256 * pn + 128 * bj + 32 * wc; }
        else drow0 = d.dst0 + nn0;
#pragma unroll
        for (int j = 0; j < 4; ++j) { const int n = (lane >> 3) + 8 * j; const float* sq = scr + (8 * c) * 65 + 32 * hb + n;
            u32x4 o; o.x = pk2(sq[0 * 65], sq[1 * 65]); o.y = pk2(sq[2 * 65], sq[3 * 65]); o.z = pk2(sq[4 * 65], sq[5 * 65]); o.w = pk2(sq[6 * 65], sq[7 * 65]);
            if (d.WT) *(u32x4*)(d.WT + (size_t)(drow0 + n) * d.K + k0 + 8 * c) = o;
            if (d.WT8) { u32x2 o8;
                if (d.q8) { o8.x = pk4_i8(sq[0 * 65] * d.s8, sq[1 * 65] * d.s8, sq[2 * 65] * d.s8, sq[3 * 65] * d.s8); o8.y = pk4_i8(sq[4 * 65] * d.s8, sq[5 * 65] * d.s8, sq[6 * 65] * d.s8, sq[7 * 65] * d.s8); }
                else { o8.x = pk4_fp8(sq[0 * 65] * d.s8, sq[1 * 65] * d.s8, sq[2 * 65] * d.s8, sq[3 * 65] * d.s8); o8.y = pk4_fp8(sq[4 * 65] * d.s8, sq[5 * 65] * d.s8, sq[6 * 65] * d.s8, sq[7 * 65] * d.s8); }
                *(u32x2*)(d.WT8 + (size_t)(drow0 + n) * d.K + k0 + 8 * c) = o8; } }
    }
    __builtin_amdgcn_s_waitcnt(0xc07f); asm volatile("" ::: "memory");
}
__device__ __forceinline__ void prologue_work(const Ptrs& P, int gw, int ngw, float* scr, int lane) {
    int base = 0;
    for (int id = 0; id < NMAT; ++id) {
        MatDesc d; get_mat(P, id, d);
        const int nit = (d.K / 64) * ((d.nblk + 1) >> 1);
        int first = (gw - base % ngw + ngw) % ngw;
        for (int it = first; it < nit; it += ngw) transpose_block(d, it, scr, lane);
        base += nit;
    }
    bf16* H = WSP(bf16, OFF_H); float* ssq0 = ssq_p(P, 0);
    for (int r = gw; r < MR; r += ngw) {
        const float* src = r < M ? P.in[0] + (size_t)r * D : P.in[1] + (size_t)(r - M) * D;
        float s = 0.f;
#pragma unroll
        for (int j = 0; j < 4; ++j) { const f32x4 v = *(const f32x4*)(src + 256 * j + 4 * lane); s += v.x * v.x + v.y * v.y + v.z * v.z + v.w * v.w;
            uint2 o; o.x = pk2(v.x, v.y); o.y = pk2(v.z, v.w); *(uint2*)(H + (size_t)r * D + 256 * j + 4 * lane) = o;
            if (r < M) *(unsigned*)(WSP(unsigned char, OFF_H8A) + blk8(r, 256 * j + 4 * lane, D)) = pk4_fp8(v.x, v.y, v.z, v.w); }
        s = wave_sum(s); if (lane < 16) ssq0[(size_t)r * 16 + lane] = lane == 0 ? s : 0.f;
    }
    if (gw == 0) { float* GT = WSP(float, OFF_GT);
        for (int e = lane; e < GT_N; e += 64) { float v;
            if (e < GT_AKG) v = P.in[7][e]; else if (e < GT_KFB) v = P.in[8][e - GT_AKG]; else if (e < GT_KKG) v = P.in[12][e - GT_KFB]; else if (e < GT_BQG) v = P.in[13][e - GT_KKG]; else v = P.in[15][e - GT_BQG];
            GT[e] = v; }
        { float gq = 0.f, gk = 0.f;
          for (int e = lane; e < 128; e += 64) gq = fmaxf(gq, fabsf(P.in[15][e]));
          gk = fabsf(P.in[13][lane]);
          gq = wave_max(gq); gk = wave_max(gk);
          if (lane == 0) GT[GT_SKIP] = 2.0f * 64.0f * C2 * gq * gk + 24.0f; } }
    float* COS = WSP(float, OFF_ROPE); float* SIN = COS + NPOS * 32;
    for (int e = gw * 64 + lane; e < NPOS * 32; e += ngw * 64) { const int pos = e >> 5, i = e & 31;
        const float inv = 1.0f / powf(10000.0f, (float)(2 * i) / 64.0f); const float ang = (float)pos * inv;
        COS[e] = (float)cos((double)ang); SIN[e] = (float)sin((double)ang); }
}
__device__ __forceinline__ void zero_pads(const Ptrs& P, int gw, int ngw, int lane) {
    bf16* KA = WSP(bf16, OFF_KA); bf16* VA = WSP(bf16, OFF_VA); bf16* KI = WSP(bf16, OFF_KI);
    unsigned zz = 0u; asm volatile("" : "+v"(zz));
    for (int e = gw * 64 + lane; e < NB * 48 * 32; e += ngw * 64) { const int b = e / (48 * 32), r = (e / 32) % 48 + 16, c = e % 32;
        const u32x4 z = {zz, zz, zz, zz};
        *(u32x4*)(KA + ((size_t)b * KROWS + r) * 256 + c * 8) = z; *(u32x4*)(VA + ((size_t)b * KROWS + r) * 256 + c * 8) = z;
        if (c < 8) *(u32x4*)(KI + ((size_t)b * KROWS + r) * 64 + c * 8) = z; }
}
__device__ __forceinline__ void colsum_job(const Ptrs& P, int j, int lane) {
    const u32x4* src = (const u32x4*)(WSP(unsigned char, OFF_W28) + (size_t)j * FF); int t = 0;
#pragma unroll
    for (int i = 0; i < 4; ++i) { const u32x4 v = src[i * 64 + lane];
        t = __builtin_amdgcn_sdot4((int)v.x, 0x01010101, t, false); t = __builtin_amdgcn_sdot4((int)v.y, 0x01010101, t, false); t = __builtin_amdgcn_sdot4((int)v.z, 0x01010101, t, false); t = __builtin_amdgcn_sdot4((int)v.w, 0x01010101, t, false); }
#pragma unroll
    for (int o = 1; o < 64; o <<= 1) t += __shfl_xor(t, o);
    if (lane == 0) ((int*)(P.ws + OFF_CTL) + CW_CS)[j] = t;
}
template <int NCT>
__device__ __forceinline__ bool strip_mma(const bf16* A, int lda, const bf16* Bt, const int* brow, int K, f32x4 (&acc)[NCT], int lane, int ks = 1, int wave = 0, float* red = nullptr) {
    const int fr = lane & 15, fq = lane >> 4;
    const int kb = ks == 1 ? 0 : wave * (K / 8), ke = ks == 1 ? K : kb + K / 8;
    const bf16* ap = A + (size_t)fr * lda + 8 * fq;
    const bf16* bp[NCT];
#pragma unroll
    for (int j = 0; j < NCT; ++j) { bp[j] = Bt + (size_t)(brow[j] + fr) * K + 8 * fq; acc[j] = (f32x4){0.f, 0.f, 0.f, 0.f}; }
    bf16x8 ca[2], cb[2][NCT], na[2], nb[2][NCT];
#define SM_LOAD(da, db, k0_) do { _Pragma("unroll") for (int h_ = 0; h_ < 2; ++h_) { da[h_] = *(const bf16x8*)(ap + (k0_) + 32 * h_); \
        _Pragma("unroll") for (int j_ = 0; j_ < NCT; ++j_) db[h_][j_] = *(const bf16x8*)(bp[j_] + (k0_) + 32 * h_); } } while (0)
    SM_LOAD(ca, cb, kb);
#pragma unroll 1
    for (int k0 = kb; k0 < ke; k0 += 64) {
        const int kn = k0 + 64 < ke ? k0 + 64 : k0;
        SM_LOAD(na, nb, kn);
#pragma unroll
        for (int h = 0; h < 2; ++h)
#pragma unroll
            for (int j = 0; j < NCT; ++j) acc[j] = __builtin_amdgcn_mfma_f32_16x16x32_bf16(ca[h], cb[h][j], acc[j], 0, 0, 0);
#pragma unroll
        for (int h = 0; h < 2; ++h) { ca[h] = na[h];
#pragma unroll
            for (int j = 0; j < NCT; ++j) cb[h][j] = nb[h][j]; }
    }
#undef SM_LOAD
    if (ks == 1) return true;
#pragma unroll
    for (int j = 0; j < NCT; ++j)
#pragma unroll
        for (int r = 0; r < 4; ++r) red[(wave * NCT * 4 + j * 4 + r) * 64 + lane] = acc[j][r];
    __syncthreads();
    if (wave == 0) {
#pragma unroll
        for (int j = 0; j < NCT; ++j)
#pragma unroll
            for (int r = 0; r < 4; ++r) { float t = 0.f;
#pragma unroll
                for (int w = 0; w < 8; ++w) t += red[(w * NCT * 4 + j * 4 + r) * 64 + lane];
                acc[j][r] = t; }
    }
    __syncthreads();
    return wave == 0;
}
__device__ __forceinline__ int row_pos(int R) { return R < M ? (R & (S - 1)) + NMETA : R - M; }
__device__ __forceinline__ float row_scale(const float* ssq, int R) {
    const f32x4* p = (const f32x4*)(ssq + (size_t)R * 16); const f32x4 a = p[0], b = p[1], c = p[2], d = p[3];
    const float t = ((a.x + a.y) + (a.z + a.w)) + ((b.x + b.y) + (b.z + b.w)) + ((c.x + c.y) + (c.z + c.w)) + ((d.x + d.y) + (d.z + d.w));
    return rsqrtf(t * (1.0f / D) + EPS);
}

__device__ __forceinline__ size_t ki_off(size_t grow, int d) { return (grow >> 4) * 1024 + (size_t)((d >> 5) * 512 + ((d >> 3) & 3) * 128 + (int)(grow & 15) * 8 + (d & 7)); }
__device__ __forceinline__ void store_ki(bf16* KI, int R, int d, unsigned v) {
    if (R < M) { const int b = R >> 11, i = R & (S - 1); KI[ki_off((size_t)b * KROWS + PRE + i, d)] = (bf16)v; }
    else { const int j = R - M;
#pragma unroll 4
        for (int b = 0; b < NB; ++b) KI[ki_off((size_t)b * KROWS + j, d)] = (bf16)v; }
}
struct HeadEpi { bf16* dst; int ldd, col0; const float* gain; int norm, rope, kvmap; float scale; const float* ssq; };
__device__ __forceinline__ void store_mapped(bf16* dst, int ldd, int R, int col, unsigned v, int kvmap) {
    if (!kvmap) { dst[(size_t)R * ldd + col] = (bf16)v; return; }
    if (R < M) { const int b = R >> 11, i = R & (S - 1); dst[((size_t)b * KROWS + PRE + i) * ldd + col] = (bf16)v; }
    else { const int j = R - M;
#pragma unroll 4
        for (int b = 0; b < NB; ++b) dst[((size_t)b * KROWS + j) * ldd + col] = (bf16)v; }
}
__device__ __forceinline__ void epi_head(const Ptrs& P, const HeadEpi& E, const f32x4 (&acc)[4], int R0, int lane) {
    const int fr = lane & 15, fq = lane >> 4;
    const float* COS = WSP(float, OFF_ROPE); const float* SIN = COS + NPOS * 32;
#pragma unroll
    for (int reg = 0; reg < 4; ++reg) {
        const int R = R0 + 4 * fq + reg; const float rr = row_scale(E.ssq, R);
        float x[4];
#pragma unroll
        for (int j = 0; j < 4; ++j) x[j] = acc[j][reg] * rr;
        if (E.norm) { float ss = x[0] * x[0] + x[1] * x[1] + x[2] * x[2] + x[3] * x[3]; ss = red16(ss); const float rn = rsqrtf(ss * (1.0f / 64.0f) + EPS);
#pragma unroll
            for (int j = 0; j < 4; ++j) x[j] *= rn * E.gain[16 * j + fr]; }
        if (E.rope) { const int pos = row_pos(R);
#pragma unroll
            for (int j = 0; j < 2; ++j) { const float c = COS[pos * 32 + 16 * j + fr], s = SIN[pos * 32 + 16 * j + fr]; const float a = x[j], b = x[j + 2]; x[j] = a * c - b * s; x[j + 2] = a * s + b * c; } }
#pragma unroll
        for (int j = 0; j < 4; ++j) store_mapped(E.dst, E.ldd, R, E.col0 + 16 * j + fr, f2bf(x[j] * E.scale), E.kvmap);
    }
}
enum { SP_INA = 0, SP_RES_O = 1, SP_MLP1 = 2, SP_RES_M = 3, SP_QKVB = 4, SP_QB = 5 };
__device__ __forceinline__ int strips_of(int ph) { return ph == SP_INA ? 33 : ph == SP_RES_O ? 16 : ph == SP_MLP1 ? 64 : ph == SP_RES_M ? 16 : ph == SP_QKVB ? 49 : 16; }
__device__ __forceinline__ void perm_rows(int base, int pn, int wc, int* brow) { const int b0 = base + 256 * pn + 32 * wc; brow[0] = b0; brow[1] = b0 + 16; brow[2] = b0 + 128; brow[3] = b0 + 144; }

__device__ __forceinline__ void strip_job(const Ptrs& P, int ph, int l, int rg, int s, int lane, int ks = 1, int wave = 0, float* red = nullptr) {
    asm volatile("" : "+s"(rg), "+s"(s), "+v"(lane));
    const int R0 = rg * 16; const int fr = lane & 15, fq = lane >> 4;
    bf16* H = WSP(bf16, OFF_H); bf16* QO = WSP(bf16, OFF_QO); bf16* UM = WSP(bf16, OFF_UM);
    int brow[5];
    if (ph == SP_INA) {
        const bf16* Bt = WSP(bf16, OFF_WIN + l * SZ_WIN); const float* ssq = ssq_p(P, 2 * l);
        if (s < 32) {
            f32x4 acc[4]; HeadEpi E; E.ssq = ssq; E.kvmap = 0; E.norm = 1; E.rope = 1; E.scale = 1.f; E.gain = nullptr;
            if (s < 16) { perm_rows(0, s >> 2, s & 3, brow); E.dst = QO; E.ldd = D; E.col0 = 64 * s; E.gain = WSP(float, OFF_GT) + GT_AQG + l * 64; E.scale = C2; }
            else if (s < 20) { const int kh = s - 16; perm_rows(0, 4, kh, brow); E.dst = WSP(bf16, OFF_KA); E.ldd = 256; E.col0 = 64 * kh; E.gain = WSP(float, OFF_GT) + GT_AKG + l * 64; E.kvmap = 1; }
            else if (s < 24) { const int vh = s - 20; perm_rows(0, 5, vh, brow); E.dst = WSP(bf16, OFF_VA); E.ldd = 256; E.col0 = 64 * vh; E.norm = 0; E.rope = 0; E.kvmap = 1; }
            else { const int qh = s - 24; perm_rows(0, 6 + (qh >> 2), qh & 3, brow); E.dst = WSP(bf16, OFF_QI); E.ldd = 512; E.col0 = 64 * qh; E.norm = 0; }
            if (strip_mma<4>(H + (size_t)R0 * D, D, Bt, brow, D, acc, lane, ks, wave, red))
            epi_head(P, E, acc, R0, lane);
        } else {
            f32x4 acc[5];
#pragma unroll
            for (int j = 0; j < 5; ++j) brow[j] = 2048 + 16 * j;
            if (!strip_mma<5>(H + (size_t)R0 * D, D, Bt, brow, D, acc, lane, ks, wave, red)) return;
            const float* COS = WSP(float, OFF_ROPE); const float* SIN = COS + NPOS * 32; bf16* KI = WSP(bf16, OFF_KI); float* WI = WSP(float, OFF_WI);
#pragma unroll
            for (int reg = 0; reg < 4; ++reg) { const int R = R0 + 4 * fq + reg; const float rr = row_scale(ssq, R); const int pos = row_pos(R);
                float x[4];
#pragma unroll
                for (int j = 0; j < 4; ++j) x[j] = acc[j][reg] * rr;
#pragma unroll
                for (int j = 0; j < 2; ++j) { const float c = COS[pos * 32 + 16 * j + fr], sn = SIN[pos * 32 + 16 * j + fr]; const float a = x[j], b = x[j + 2]; x[j] = a * c - b * sn; x[j + 2] = a * sn + b * c; }
#pragma unroll
                for (int j = 0; j < 4; ++j) store_ki(KI, R, 16 * j + fr, f2bf(x[j]));
                if (fr < 8) WI[(size_t)R * 8 + fr] = acc[4][reg] * rr * 0.044194173824159216f; }
        }
    } else if (ph == SP_RES_O || ph == SP_RES_M) {
        const bool mlp = ph == SP_RES_M; const int K = mlp ? FF : D;
        const bf16* A = mlp ? UM + (size_t)(R0 - M) * FF : QO + (size_t)R0 * D; const bf16* Bt = mlp ? w2_t(P, l) : wo_t(P, l);
        float* ssqn = ssq_p(P, 2 * l + (mlp ? 2 : 1)); const bool last = mlp && l == 3; const float* ssqm = ssq_p(P, 2 * l + 1);
        f32x4 acc[4];
#pragma unroll
        for (int j = 0; j < 4; ++j) brow[j] = 64 * s + 16 * j;
        if (!strip_mma<4>(A, K, Bt, brow, K, acc, lane, ks, wave, red)) return;
#pragma unroll
        for (int reg = 0; reg < 4; ++reg) { const int R = R0 + 4 * fq + reg; float sq = 0.f; float r2 = 1.f; if (mlp) { const float rr = row_scale(ssqm, R); r2 = rr * rr; }
#pragma unroll
            for (int j = 0; j < 4; ++j) { const int col = 64 * s + 16 * j + fr; const float hv = bf2f(H[(size_t)R * D + col]) + acc[j][reg] * r2; H[(size_t)R * D + col] = (bf16)f2bf(hv); sq += hv * hv;
                if (last && R < M) P.out[(size_t)R * D + col] = hv; }
            sq = red16(sq); if (fr == 0) ssqn[(size_t)R * 16 + s] = sq; }
    } else if (ph == SP_MLP1) {
        f32x4 acc[4];
#pragma unroll
        for (int j = 0; j < 4; ++j) brow[j] = 64 * s + 16 * j;
        if (!strip_mma<4>(H + (size_t)R0 * D, D, w1_t(P, l), brow, D, acc, lane, ks, wave, red)) return;
#pragma unroll
        for (int reg = 0; reg < 4; ++reg) { const int R = R0 + 4 * fq + reg;
#pragma unroll
            for (int j = 0; j < 4; ++j) { const float v = fmaxf(acc[j][reg], 0.f); UM[(size_t)(R - M) * FF + 64 * s + 16 * j + fr] = (bf16)f2bf(v * v); } }
    } else {
        const int jb = l - 2; const float* ssq = ssq_p(P, 2 * l);
        if (s < 48) {
            f32x4 acc[4]; HeadEpi E; E.ssq = ssq; E.rope = 0; E.norm = 1; E.kvmap = 0; E.scale = 1.f; const bf16* Bt;
            if (s < 16) { Bt = WSP(bf16, jb == 0 ? OFF_WQ0 : OFF_WQ1); perm_rows(0, s >> 2, s & 3, brow); E.dst = QO; E.ldd = D; E.col0 = 64 * s; E.gain = WSP(float, OFF_GT) + GT_BQG + jb * 64; E.scale = C2; }
            else if (s < 32) { const int kh = s - 16; Bt = WSP(bf16, OFF_WKV); perm_rows(0, kh >> 2, kh & 3, brow); E.dst = WSP(bf16, OFF_KB); E.ldd = D; E.col0 = 64 * kh; E.gain = WSP(float, OFF_GT) + GT_KKG; E.kvmap = 1; }
            else { const int vh = s - 32; Bt = WSP(bf16, OFF_WKV); perm_rows(1024, vh >> 2, vh & 3, brow); E.dst = WSP(bf16, OFF_VB); E.ldd = D; E.col0 = 64 * vh; E.norm = 0; E.gain = nullptr; E.kvmap = 1; }
            if (strip_mma<4>(H + (size_t)R0 * D, D, Bt, brow, D, acc, lane, ks, wave, red))
            epi_head(P, E, acc, R0, lane);
        } else {
            f32x4 acc[1]; brow[0] = 2048;
            if (!strip_mma<1>(H + (size_t)R0 * D, D, WSP(bf16, OFF_WKV), brow, D, acc, lane, ks, wave, red)) return;
            float* LF = WSP(float, OFF_LF); const float bias = WSP(float, OFF_GT)[GT_KFB + fr];
#pragma unroll
            for (int reg = 0; reg < 4; ++reg) { const int R = R0 + 4 * fq + reg; const float z = acc[0][reg] * row_scale(ssq, R) + bias;
                LF[(size_t)R * 16 + fr] = fminf(z, 0.f) - log1pf(expf(-fabsf(z))); }
        }
    }
}
__device__ __forceinline__ unsigned okey(float f) { const unsigned u = __builtin_bit_cast(unsigned, f); return (u & 0x80000000u) ? ~u : (u | 0x80000000u); }
__device__ __forceinline__ unsigned half_sum(unsigned v) {
    v += __shfl_xor(v, 1); v += __shfl_xor(v, 2); v += __shfl_xor(v, 4); v += __shfl_xor(v, 8); v += __shfl_xor(v, 16); return v;
}
constexpr int NKT = 65;
constexpr int IDX_LDS_PER_WAVE = NKT * 64 * 4;
__device__ __forceinline__ float swap16_sum(float x) {
    auto s2 = __builtin_amdgcn_permlane16_swap(__float_as_uint(x), __float_as_uint(x), false, false);
    return __uint_as_float(s2[0]) + __uint_as_float(s2[1]);
}
template <int CTRL> __device__ __forceinline__ unsigned dppu(unsigned x) { return (unsigned)__builtin_amdgcn_mov_dpp((int)x, CTRL, 0xf, 0xf, true); }
__device__ __forceinline__ unsigned half_sum_dpp(unsigned v) {
    v += dppu<0xB1>(v); v += dppu<0x4E>(v); v += dppu<0x141>(v); v += dppu<0x128>(v);
    auto s2 = __builtin_amdgcn_permlane16_swap(v, v, false, false);
    return s2[0] + s2[1];
}
__device__ __forceinline__ void count4_ge(unsigned& cnt, unsigned a, unsigned b, unsigned c4, unsigned d, unsigned c) {
    asm volatile("v_cmp_ge_u32_e64 s[20:21], %1, %5\n\tv_cmp_ge_u32_e64 s[22:23], %2, %5\n\tv_cmp_ge_u32_e64 s[24:25], %3, %5\n\tv_cmp_ge_u32_e64 s[26:27], %4, %5\n\t"
                 "v_addc_co_u32_e64 %0, s[20:21], %0, 0, s[20:21]\n\tv_addc_co_u32_e64 %0, s[22:23], %0, 0, s[22:23]\n\tv_addc_co_u32_e64 %0, s[24:25], %0, 0, s[24:25]\n\tv_addc_co_u32_e64 %0, s[26:27], %0, 0, s[26:27]"
                 : "+v"(cnt) : "v"(a), "v"(b), "v"(c4), "v"(d), "v"(c) : "s20", "s21", "s22", "s23", "s24", "s25", "s26", "s27");
}
__device__ __forceinline__ void indexer_pass(const Ptrs& P, int b, int g2, int lane, LAS unsigned* stg  , int dry = 0  ) {
    const bf16* QI = WSP(bf16, OFF_QI); const bf16* KI = WSP(bf16, OFF_KI) + (size_t)b * KROWS * 64; const float* WI = WSP(float, OFF_WI);
    unsigned* MASK = WSP(unsigned, OFF_MASK);
    const int i0 = 2 * g2, n = lane & 31, gg = lane >> 5, fr = lane & 15, fq = lane >> 4;
    const size_t row0 = (size_t)b * S + i0;
    const int ntile = 2 + ((i0 + 1) >> 5);
    const unsigned lt = (1u << n) - 1u;
    const __amdgpu_buffer_rsrc_t krs = __builtin_amdgcn_make_buffer_rsrc((void*)KI, 0, KROWS * 128, 0x00020000);
    const int iq = i0 + gg;
    bf16x8 af[2];
    { const bf16* qp = QI + (row0 + (fr >> 3)) * 512 + (fr & 7) * 64 + 8 * fq;
      af[0] = *(const bf16x8*)(qp); af[1] = *(const bf16x8*)(qp + 32); }
    const f32x4 w4 = *(const f32x4*)(WI + (row0 + (fq >> 1)) * 8 + 4 * (fq & 1));
    const unsigned loff = (unsigned)(16 * lane);
    bf16x8 b0[2][2], b1[2][2], b2[2][2], b3[2][2];
#define IDX_TBASE(t_) (((t_) == 0 ? 0 : PRE + 32 * ((t_) - 1)) * 128)
#define IDX_LOADB(dst, t_) do { const int tt_ = (t_) < ntile ? (t_) : ntile - 1; const int bo_ = IDX_TBASE(tt_); _Pragma("unroll") for (int u_ = 0; u_ < 2; ++u_) _Pragma("unroll") for (int ks_ = 0; ks_ < 2; ++ks_) \
        dst[u_][ks_] = __builtin_bit_cast(bf16x8, __builtin_amdgcn_raw_buffer_load_b128(krs, loff + 2048 * u_ + 1024 * ks_, bo_, 0)); } while (0)
#define IDX_TILE(bb, t_) do { float pu_[2]; \
        _Pragma("unroll") for (int u_ = 0; u_ < 2; ++u_) { f32x4 acc_ = {0.f, 0.f, 0.f, 0.f}; \
            acc_ = __builtin_amdgcn_mfma_f32_16x16x32_bf16(af[0], bb[u_][0], acc_, 0, 0, 0); acc_ = __builtin_amdgcn_mfma_f32_16x16x32_bf16(af[1], bb[u_][1], acc_, 0, 0, 0); \
            float x_ = w4[0] * __builtin_amdgcn_fmed3f(acc_[0], 0.f, 3.0e38f); x_ += w4[1] * __builtin_amdgcn_fmed3f(acc_[1], 0.f, 3.0e38f); \
            x_ += w4[2] * __builtin_amdgcn_fmed3f(acc_[2], 0.f, 3.0e38f); x_ += w4[3] * __builtin_amdgcn_fmed3f(acc_[3], 0.f, 3.0e38f); pu_[u_] = swap16_sum(x_); } \
        const float sc_ = (fq & 1) ? pu_[1] : pu_[0]; \
        const bool v_ = (t_) == 0 ? (n < NMETA) : ((32 * ((t_) - 1) + n) <= iq); \
        stg[(t_) * 64 + lane] = v_ ? okey(sc_) : 0x007FFFFFu; } while (0)
    IDX_LOADB(b0, 0); IDX_LOADB(b1, 1); IDX_LOADB(b2, 2); IDX_LOADB(b3, 3);
#pragma unroll 1
    for (int t = 0; t < ntile; t += 4) {
        const int t1 = t + 1 < ntile ? t + 1 : ntile - 1, t2 = t + 2 < ntile ? t + 2 : ntile - 1, t3 = t + 3 < ntile ? t + 3 : ntile - 1;
        IDX_TILE(b0, t); IDX_LOADB(b0, t + 4);
        IDX_TILE(b1, t1); IDX_LOADB(b1, t + 5);
        IDX_TILE(b2, t2); IDX_LOADB(b2, t + 6);
        IDX_TILE(b3, t3); IDX_LOADB(b3, t + 7);
    }
#undef IDX_LOADB
#undef IDX_TILE
#undef IDX_TBASE
    if (dry) return;
#pragma unroll 1
    for (int t = ntile; t < NKT; ++t) stg[t * 64 + lane] = 0x007FFFFFu;
    unsigned k[NKT];
#pragma unroll
    for (int T = 0; T < NKT; ++T) k[T] = stg[T * 64 + lane];
    unsigned thr = 0u; bool done = (NMETA + iq + 1) <= TOPK;
    if (done) thr = 0x00800000u;
#pragma unroll 1
    for (int bit = 31; bit >= 0; --bit) {
        if (__all(done)) break;
        const unsigned c = thr | (1u << bit);
        unsigned cnt = (k[NKT - 1] >= c) ? 1u : 0u;
#pragma unroll
        for (int T = 0; T + 3 < NKT; T += 4) count4_ge(cnt, k[T], k[T + 1], k[T + 2], k[T + 3], c);
        cnt = half_sum_dpp(cnt);
        if (!done && cnt >= (unsigned)TOPK) { thr = c; if (cnt == (unsigned)TOPK) done = true; }
    }
    const bool slow = !__all(done);
    unsigned* mp = MASK + row0 * NWORDS;
    unsigned m0 = 0u, m1 = 0u, m2 = 0u, m3 = 0u;
#define IDX_PUT(bs_, widx_) do { const unsigned lo_ = (unsigned)(bs_), hi_ = (unsigned)((bs_) >> 32);   \
        if ((widx_) < 64) asm volatile("s_nop 1\n\tv_writelane_b32 %0, %2, %4\n\tv_writelane_b32 %1, %3, %4" : "+v"(m0), "+v"(m2) : "s"(lo_), "s"(hi_), "n"((widx_) & 63)); \
        else asm volatile("s_nop 1\n\tv_writelane_b32 %0, %2, %4\n\tv_writelane_b32 %1, %3, %4" : "+v"(m1), "+v"(m3) : "s"(lo_), "s"(hi_), "n"((widx_) & 63)); } while (0)
    if (!slow) {
#pragma unroll
        for (int T = 0; T < NKT; ++T) { const unsigned long long bs = __ballot(k[T] >= thr); IDX_PUT(bs, T == 0 ? 0 : T + 1); }
    } else {
        unsigned gcnt = 0;
#pragma unroll
        for (int T = 0; T < NKT; ++T) gcnt += (k[T] > thr) ? 1u : 0u;
        gcnt = half_sum_dpp(gcnt);
        const unsigned need = done ? 0x7fffffffu : (unsigned)TOPK - gcnt;
        unsigned base = 0;
#pragma unroll
        for (int T = 0; T < NKT; ++T) {
            const bool eq = k[T] == thr;
            const unsigned long long be = __ballot(eq);
            const unsigned hh = gg ? (unsigned)(be >> 32) : (unsigned)be;
            const bool sel = (k[T] > thr) || (eq && (base + (unsigned)__builtin_popcount(hh & lt)) < need);
            base += (unsigned)__builtin_popcount(hh);
            const unsigned long long bs = __ballot(sel); IDX_PUT(bs, T == 0 ? 0 : T + 1);
            __builtin_amdgcn_sched_barrier(0);
        }
    }
#undef IDX_PUT
    mp[lane] = m0; mp[NWORDS + lane] = m2;
    if (lane < NWORDS - 64) { mp[64 + lane] = m1; mp[NWORDS + 64 + lane] = m3; }
}

template <int MODE>
__device__ __forceinline__ void attn_naive_work(const Ptrs& P, int gw, int ngw, float* sc, int lane, int row_lo, int row_hi) {
    bf16* QO = WSP(bf16, OFF_QO);
    for (int job = gw; job < (row_hi - row_lo) * 16; job += ngw) {
        const int R = row_lo + (job >> 4), h = job & 15;
        const bool meta = R >= M; const int b = meta ? 0 : R >> 11, i = R & (S - 1);
        const int kmax = meta ? (R - M) : PRE + i;
        const bf16* Kb; const bf16* Vb; int ldk;
        if (MODE == 0) { Kb = WSP(bf16, OFF_KA) + (size_t)b * KROWS * 256 + 64 * (h >> 2); Vb = WSP(bf16, OFF_VA) + (size_t)b * KROWS * 256 + 64 * (h >> 2); ldk = 256; }
        else { Kb = WSP(bf16, OFF_KB) + (size_t)b * KROWS * D + 64 * h; Vb = WSP(bf16, OFF_VB) + (size_t)b * KROWS * D + 64 * h; ldk = D; }
        const unsigned* mrow = WSP(unsigned, OFF_MASK) + (size_t)(meta ? 0 : R) * NWORDS;
        const float* nb = WSP(float, OFF_NB) + ((size_t)b * 16 + h) * KROWS;
        float q[64];
        { const bf16* qp = QO + (size_t)R * D + 64 * h;
#pragma unroll
          for (int c = 0; c < 8; ++c) { const u32x4 v = *(const u32x4*)(qp + 8 * c);
              q[8 * c + 0] = bf2f(v.x & 0xffffu); q[8 * c + 1] = bf2f(v.x >> 16); q[8 * c + 2] = bf2f(v.y & 0xffffu); q[8 * c + 3] = bf2f(v.y >> 16);
              q[8 * c + 4] = bf2f(v.z & 0xffffu); q[8 * c + 5] = bf2f(v.z >> 16); q[8 * c + 6] = bf2f(v.w & 0xffffu); q[8 * c + 7] = bf2f(v.w >> 16); } }
        float mx = -INFINITY;
        for (int kr = lane; kr <= kmax; kr += 64) {
            bool sel;
            if (MODE == 0) sel = meta ? true : ((mrow[kr >> 5] >> (kr & 31)) & 1u) != 0u;
            else sel = (kr < NMETA) || (kr >= PRE);
            float s = -INFINITY;
            if (sel) { const bf16* kp = Kb + (size_t)kr * ldk; float a = 0.f;
#pragma unroll
                for (int c = 0; c < 8; ++c) { const u32x4 v = *(const u32x4*)(kp + 8 * c);
                    a += q[8 * c + 0] * bf2f(v.x & 0xffffu) + q[8 * c + 1] * bf2f(v.x >> 16) + q[8 * c + 2] * bf2f(v.y & 0xffffu) + q[8 * c + 3] * bf2f(v.y >> 16)
                       + q[8 * c + 4] * bf2f(v.z & 0xffffu) + q[8 * c + 5] * bf2f(v.z >> 16) + q[8 * c + 6] * bf2f(v.w & 0xffffu) + q[8 * c + 7] * bf2f(v.w >> 16); }
                s = a; if (MODE == 1) s += nb[kr]; }
            sc[kr] = s; mx = fmaxf(mx, s);
        }
        mx = wave_max(mx);
        float ls = 0.f;
        for (int kr = lane; kr <= kmax; kr += 64) { const float p = exp2f(sc[kr] - mx); sc[kr] = p; ls += p; }
        ls = wave_sum(ls);
        __builtin_amdgcn_s_waitcnt(0xc07f); asm volatile("" ::: "memory");
        float o = 0.f;
        for (int kr = 0; kr <= kmax; ++kr) { const float p = sc[kr]; if (p != 0.f) o += p * bf2f(Vb[(size_t)kr * ldk + lane]); }
        QO[(size_t)R * D + 64 * h + lane] = (bf16)f2bf(o / ls);
        __builtin_amdgcn_s_waitcnt(0xc07f); asm volatile("" ::: "memory");
    }
}

__device__ __forceinline__ void scan_work(const Ptrs& P, int bh, float* part  , int t) {
    const int b = bh >> 4, h = bh & 15; const bool act = t < 256;
    const float* LF = WSP(float, OFF_LF); float* NBp = WSP(float, OFF_NB) + ((size_t)b * 16 + h) * KROWS;
    float cm = 0.f;
    for (int j = 0; j < NMETA; ++j) { cm += LF[(size_t)(M + j) * 16 + h]; if (t == 0) NBp[j] = -cm * LOG2E; }
    if (t >= NMETA && t < PRE) NBp[t] = -INFINITY;
    float v[8]; float run = 0.f;
    if (act) {
#pragma unroll
        for (int e = 0; e < 8; ++e) { run += LF[((size_t)b * S + 8 * t + e) * 16 + h]; v[e] = run; }
        part[t] = run; }
    __syncthreads();
    for (int o = 1; o < 256; o <<= 1) { float x = 0.f; if (act && t >= o) x = part[t - o]; __syncthreads(); if (act) part[t] += x; __syncthreads(); }
    if (act) { const float off = cm + (t ? part[t - 1] : 0.f);
#pragma unroll
        for (int e = 0; e < 8; ++e) NBp[PRE + 8 * t + e] = -(off + v[e]) * LOG2E; }
    bf16* KB = WSP(bf16, OFF_KB); bf16* VB = WSP(bf16, OFF_VB);
    for (int e = t; e < 48 * 8; e += 512) { const int r = 16 + e / 8, c = e % 8; const u32x4 z = {0u, 0u, 0u, 0u};
        *(u32x4*)(KB + ((size_t)b * KROWS + r) * D + 64 * h + 8 * c) = z; *(u32x4*)(VB + ((size_t)b * KROWS + r) * D + 64 * h + 8 * c) = z; }
    __syncthreads();
}


namespace pg8 {
#define PG8_LAS __attribute__((address_space(3)))
typedef unsigned short bf16_t;
typedef short bf16x8 __attribute__((ext_vector_type(8)));
typedef float f32x4 __attribute__((ext_vector_type(4)));
typedef unsigned u32x4 __attribute__((ext_vector_type(4)));
constexpr int BM = 256, BK = 64, HALF = 128, HTB = HALF * BK * 2  , STAGE_BYTES = 8 * HTB, NXCD = 8, WGM = 4;

__host__ __device__ __forceinline__ int lds_byte(int r, int c) { const int st = (r >> 4) * 2 + (c >> 5), rr = r & 15, cc = c & 31, ob = rr * 64 + cc * 2; return st * 1024 + (ob ^ (((ob >> 9) & 1) << 5)); }
__host__ __device__ __forceinline__ void stage_rc(int b, int& R, int& C) { const int st = b / 1024, sb = b % 1024, swz = sb ^ (((sb >> 9) & 1) << 5); R = (st >> 1) * 16 + swz / 64; C = (st & 1) * 32 + (swz % 64) / 2; }
__host__ __device__ __forceinline__ int perm32(int rho) { const int n = rho >> 4, i = rho & 15; return 8 * (i >> 2) + 4 * n + (i & 3); }

struct Unit { int pm, pn; };
struct Gemm { const bf16_t* A; const bf16_t* Bt; int M, N, K; };

struct StaticOrder {
    int nM, nN, nwg, G, c;
    __host__ __device__ void init(int M, int N, int G_, int c_) { nM = M / BM; nN = N / BM; nwg = nM * nN; G = G_; c = c_; }
    __host__ __device__ bool next(int i, Unit& u) const {
        const long L = (long)i * G + c; if (L >= nwg) return false;
        int wgid = (int)L; { const int q = nwg / NXCD, r = nwg % NXCD, xcd = wgid % NXCD, off = wgid / NXCD; wgid = (xcd < r ? xcd * (q + 1) : r * (q + 1) + (xcd - r) * q) + off; }
        const int nig = WGM * nN, gid = wgid / nig, fm = gid * WGM, gsz = (nM - fm) < WGM ? (nM - fm) : WGM;
        u.pm = fm + ((wgid % nig) % gsz); u.pn = (wgid % nig) / gsz; return true;
    }
    __device__ __forceinline__ void a_ready(const Unit&) const {}
    __device__ __forceinline__ void done(const Unit&) const {}
};

__device__ __forceinline__ unsigned cvt_pk_bf16(float lo, float hi) { unsigned r; asm volatile("v_cvt_pk_bf16_f32 %0, %1, %2" : "=v"(r) : "v"(lo), "v"(hi)); return r; }
typedef float f32x2 __attribute__((ext_vector_type(2)));
typedef int i32x4 __attribute__((ext_vector_type(4)));
template <class Epi, class Sched, bool ALIGN_EPI = false, bool SP2 = false, int QM = 0, bool ABLK = false>
__device__ __forceinline__ void gemm_phase(PG8_LAS unsigned char* lds, const Gemm g, const Sched& S, const Epi& E) {
    int tid = threadIdx.x; asm volatile("" : "+v"(tid));
    const int wid = __builtin_amdgcn_readfirstlane(tid >> 6), lane = tid & 63, wr = wid >> 2, wc = wid & 3, fr = lane & 15, fq = lane >> 4;
    constexpr bool F8 = QM == 1, I8 = QM == 2;
    const int K = g.K, nt = K / BK;
    unsigned voffA[2], voffB[2];
#pragma unroll
    for (int i = 0; i < 2; ++i) { int R, C; stage_rc(tid * 16 + i * 8192, R, C); const int Rb = Epi::PERM ? ((R & ~31) + perm32(R & 31)) : R;
        voffA[i] = ABLK ? (unsigned)(((R >> 4) * (K * 2 / 32) + (C * 2 >> 5)) * 512 + (R & 15) * 32 + (C * 2 & 31)) : (unsigned)(R * K + C) * 2u; voffB[i] = (unsigned)(Rb * K + C) * 2u; }
    const size_t kstepA = ABLK ? (size_t)2048 : (size_t)(BK * 2);
    const size_t kstep = (size_t)(BK * 2);
    const size_t hstep = (size_t)HALF * K * 2;
    const size_t tstep = 2 * hstep;
    const unsigned ldsw = (unsigned)wid * 1024u;
    const int aoff = lds_byte(wr * 64 + fr, fq * 8), boff = lds_byte(wc * 32 + fr, fq * 8);
#define PG8_SA(b, h) (((b) * 2 + (h)) * HTB)
#define PG8_SB(b, h) ((4 + (b) * 2 + (h)) * HTB)
#define PG8_STAGE(bufoff, gbase, voff) do { _Pragma("unroll") for (int _i = 0; _i < 2; ++_i) \
        __builtin_amdgcn_global_load_lds((const unsigned*)((const char*)(gbase) + (voff)[_i]), (PG8_LAS unsigned*)(lds + (bufoff) + ldsw + _i * 8192), 16, 0, 0); } while (0)
#define PG8_LDA(dst, b, h) do { _Pragma("unroll") for (int m = 0; m < 4; ++m) _Pragma("unroll") for (int k = 0; k < 2; ++k) dst[m][k] = *(const PG8_LAS bf16x8*)(lds + PG8_SA(b, h) + aoff + m * 2048 + k * 1024); } while (0)
#define PG8_LDB(dst, b, h) do { _Pragma("unroll") for (int n = 0; n < 2; ++n) _Pragma("unroll") for (int k = 0; k < 2; ++k) dst[n][k] = *(const PG8_LAS bf16x8*)(lds + PG8_SB(b, h) + boff + n * 2048 + k * 1024); } while (0)
#define PG8_CAT8(x) __builtin_shufflevector(__builtin_bit_cast(i32x4, (x)[0]), __builtin_bit_cast(i32x4, (x)[1]), 0, 1, 2, 3, 4, 5, 6, 7)
#define PG8_MMA(ai, bj, At, Bt) do { __builtin_amdgcn_s_setprio(1); _Pragma("unroll") for (int m = 0; m < 4; ++m) _Pragma("unroll") for (int n = 0; n < 2; ++n) { \
        if constexpr (F8) asm volatile("v_mfma_f32_16x16x128_f8f6f4 %0, %1, %2, %0" : "+v"(acc[ai][bj][m][n]) : "v"(PG8_CAT8(Bt[n])), "v"(PG8_CAT8(At[m])));   \
        else if constexpr (I8) { _Pragma("unroll") for (int k = 0; k < 2; ++k) acc[ai][bj][m][n] = __builtin_bit_cast(f32x4, __builtin_amdgcn_mfma_i32_16x16x64_i8(__builtin_bit_cast(i32x4, Bt[n][k]), __builtin_bit_cast(i32x4, At[m][k]), __builtin_bit_cast(i32x4, acc[ai][bj][m][n]), 0, 0, 0)); } \
        else { _Pragma("unroll") for (int k = 0; k < 2; ++k) acc[ai][bj][m][n] = __builtin_amdgcn_mfma_f32_16x16x32_bf16(Bt[n][k], At[m][k], acc[ai][bj][m][n], 0, 0, 0); } } __builtin_amdgcn_s_setprio(0); } while (0)
#define PG8_WAIT_V(n) asm volatile("s_waitcnt vmcnt(" #n ")" ::: "memory")
#define PG8_WAIT_L(n) asm volatile("s_waitcnt lgkmcnt(" #n ")" ::: "memory")
#define PG8_BAR __builtin_amdgcn_s_barrier()
#define PG8_SCHED __builtin_amdgcn_sched_barrier(0)
    Unit cur, nxt; int ui = 0;
    if (!S.next(0, cur)) return;
    f32x4 acc[2][2][4][2];
    float zf = 0.f; asm volatile("" : "+v"(zf));
#pragma unroll
    for (int a = 0; a < 2; ++a)
#pragma unroll
        for (int b = 0; b < 2; ++b)
#pragma unroll
            for (int m = 0; m < 4; ++m)
#pragma unroll
                for (int n = 0; n < 2; ++n) acc[a][b][m][n] = (f32x4){zf, zf, zf, zf};
    bf16x8 At[4][2], B0[2][2], B1[2][2];
    const char* cA = (const char*)g.A + (size_t)cur.pm * tstep; const char* cB = (const char*)g.Bt + (size_t)cur.pn * tstep;
    S.a_ready(cur);
    if constexpr (SP2) {
        PG8_STAGE(PG8_SB(0, 0), cB, voffB); PG8_STAGE(PG8_SB(0, 1), cB + hstep, voffB); PG8_STAGE(PG8_SA(0, 0), cA, voffA); PG8_STAGE(PG8_SA(0, 1), cA + hstep, voffA);
        if (wr == 1) PG8_BAR;
        PG8_WAIT_V(2); PG8_BAR;
        PG8_STAGE(PG8_SB(1, 0), cB + kstep, voffB); PG8_STAGE(PG8_SA(1, 0), cA + kstepA, voffA); PG8_STAGE(PG8_SB(1, 1), cB + hstep + kstep, voffB);
        PG8_WAIT_V(6); PG8_BAR;
    } else {
        PG8_STAGE(PG8_SB(0, 0), cB, voffB); PG8_STAGE(PG8_SA(0, 0), cA, voffA); PG8_STAGE(PG8_SB(0, 1), cB + hstep, voffB); PG8_STAGE(PG8_SA(0, 1), cA + hstep, voffA);
        if (wr == 1) PG8_BAR;
        PG8_WAIT_V(4); PG8_BAR;
        PG8_STAGE(PG8_SB(1, 0), cB + kstep, voffB); PG8_STAGE(PG8_SA(1, 0), cA + kstepA, voffA); PG8_STAGE(PG8_SB(1, 1), cB + hstep + kstep, voffB);
        PG8_WAIT_V(6); PG8_BAR;
    }
    for (;;) {
        const bool has_next = S.next(ui + 1, nxt);
        const char* nA = has_next ? (const char*)g.A + (size_t)nxt.pm * tstep : cA; const char* nB = has_next ? (const char*)g.Bt + (size_t)nxt.pn * tstep : cB;
        for (int t = 0; t < nt; t += 2) {
            const bool last = (t == nt - 2);
            const char* a1 = cA + (size_t)(t + 1) * kstepA;
            const char* a2 = last ? nA : cA + (size_t)(t + 2) * kstepA; const char* b2 = last ? nB : cB + (size_t)(t + 2) * kstep;
            const char* a3 = a2 + kstepA; const char* b3 = b2 + kstep;
            if (last && has_next) S.a_ready(nxt);
            if constexpr (SP2) {
            PG8_LDB(B0, 0, 0); PG8_LDB(B1, 0, 1); PG8_SCHED; PG8_LDA(At, 0, 0); PG8_STAGE(PG8_SA(1, 1), a1 + hstep, voffA);
            PG8_WAIT_V(8); PG8_WAIT_L(0); PG8_BAR; PG8_MMA(0, 0, At, B0); PG8_MMA(0, 1, At, B1); PG8_BAR; PG8_SCHED;
            PG8_LDA(At, 0, 1); PG8_STAGE(PG8_SB(0, 0), b2, voffB); PG8_STAGE(PG8_SB(0, 1), b2 + hstep, voffB); PG8_STAGE(PG8_SA(0, 0), a2, voffA);
            PG8_WAIT_V(8); PG8_WAIT_L(0); PG8_BAR; PG8_MMA(1, 0, At, B0); PG8_MMA(1, 1, At, B1); PG8_BAR; PG8_SCHED;
            PG8_LDB(B0, 1, 0); PG8_LDB(B1, 1, 1); PG8_SCHED; PG8_LDA(At, 1, 0); PG8_STAGE(PG8_SA(0, 1), a2 + hstep, voffA);
            PG8_WAIT_V(8); PG8_WAIT_L(0); PG8_BAR; PG8_MMA(0, 0, At, B0); PG8_MMA(0, 1, At, B1); PG8_BAR; PG8_SCHED;
            PG8_LDA(At, 1, 1); PG8_STAGE(PG8_SB(1, 0), b3, voffB); PG8_STAGE(PG8_SB(1, 1), b3 + hstep, voffB); PG8_STAGE(PG8_SA(1, 0), a3, voffA);
            PG8_WAIT_V(8); PG8_WAIT_L(0); PG8_BAR; PG8_MMA(1, 0, At, B0); PG8_MMA(1, 1, At, B1); PG8_BAR; PG8_SCHED;
            } else {
            PG8_LDB(B0, 0, 0); PG8_SCHED; PG8_LDA(At, 0, 0); PG8_STAGE(PG8_SA(1, 1), a1 + hstep, voffA);
            PG8_WAIT_L(8); PG8_BAR; PG8_WAIT_L(0); PG8_MMA(0, 0, At, B0); PG8_BAR; PG8_SCHED;
            PG8_LDB(B1, 0, 1); PG8_STAGE(PG8_SB(0, 0), b2, voffB);
            PG8_BAR; PG8_WAIT_L(0); PG8_MMA(0, 1, At, B1); PG8_BAR;
            PG8_LDA(At, 0, 1); PG8_STAGE(PG8_SA(0, 0), a2, voffA);
            PG8_BAR; PG8_WAIT_L(0); PG8_MMA(1, 0, At, B0); PG8_BAR; PG8_SCHED;
            PG8_STAGE(PG8_SB(0, 1), b2 + hstep, voffB);
            PG8_WAIT_V(6); PG8_BAR; PG8_MMA(1, 1, At, B1); PG8_BAR;
            PG8_LDB(B0, 1, 0); PG8_SCHED; PG8_LDA(At, 1, 0); PG8_STAGE(PG8_SA(0, 1), a2 + hstep, voffA);
            PG8_WAIT_L(8); PG8_BAR; PG8_WAIT_L(0); PG8_MMA(0, 0, At, B0); PG8_BAR; PG8_SCHED;
            PG8_LDB(B1, 1, 1); PG8_STAGE(PG8_SB(1, 0), b3, voffB);
            PG8_BAR; PG8_WAIT_L(0); PG8_MMA(0, 1, At, B1); PG8_BAR;
            PG8_LDA(At, 1, 1); PG8_STAGE(PG8_SA(1, 0), a3, voffA);
            PG8_BAR; PG8_WAIT_L(0); PG8_MMA(1, 0, At, B0); PG8_BAR; PG8_SCHED;
            PG8_STAGE(PG8_SB(1, 1), b3 + hstep, voffB);
            PG8_WAIT_V(6); PG8_BAR; PG8_MMA(1, 1, At, B1); PG8_BAR;
            }
        }
        if constexpr (ALIGN_EPI) { if (wr == 0) PG8_BAR; }
        if constexpr (F8) asm volatile("s_nop 15\n\ts_nop 7" ::: "memory");
        if constexpr (!Epi::AFTER_DRAIN) { E(acc, cur, wr, wc, fr, fq); S.done(cur); }
        if (!has_next) break;
#pragma unroll
        for (int a = 0; a < 2; ++a)
#pragma unroll
            for (int b = 0; b < 2; ++b)
#pragma unroll
                for (int m = 0; m < 4; ++m)
#pragma unroll
                    for (int n = 0; n < 2; ++n) acc[a][b][m][n] = (f32x4){0.f, 0.f, 0.f, 0.f};
        cur = nxt; cA = nA; cB = nB; ++ui;
        if constexpr (ALIGN_EPI) { if (wr == 1) PG8_BAR; }
    }
    PG8_WAIT_V(0);
    if constexpr (!ALIGN_EPI) { if (wr == 0) PG8_BAR; }
    PG8_BAR;
    if constexpr (Epi::AFTER_DRAIN) { E.fused(acc, cur, wr, wc, fr, fq, lds, wid, lane); S.done(cur); }
#undef PG8_SA
#undef PG8_SB
#undef PG8_STAGE
#undef PG8_LDA
#undef PG8_LDB
#undef PG8_MMA
#undef PG8_WAIT_V
#undef PG8_WAIT_L
#undef PG8_BAR
#undef PG8_SCHED
}
}

__device__ __forceinline__ u32x4 pack8(const f32x4& a, const f32x4& b) { u32x4 w; w.x = pg8::cvt_pk_bf16(a[0], a[1]); w.y = pg8::cvt_pk_bf16(a[2], a[3]); w.z = pg8::cvt_pk_bf16(b[0], b[1]); w.w = pg8::cvt_pk_bf16(b[2], b[3]); return w; }
__device__ __forceinline__ float hsum4(const f32x4& a) { return (a[0] + a[1]) + (a[2] + a[3]); }

struct HeadTile { bf16* dst; int ldd, col0, mode; const float* gain; float scale, ascale; };
__device__ __forceinline__ void epi_heads(const Ptrs& P, const HeadTile& T, const float* ssq, const f32x4 (&acc)[2][2][4][2], const pg8::Unit& u, int wr, int wc, int fr, int fq) {
    const float* COS = WSP(float, OFF_ROPE); const float* SIN = COS + NPOS * 32;
    f32x4 g[2][2];
#pragma unroll
    for (int bj = 0; bj < 2; ++bj)
#pragma unroll
        for (int n = 0; n < 2; ++n) g[bj][n] = (T.mode & 1) ? *(const f32x4*)(T.gain + 32 * bj + 8 * fq + 4 * n) : (f32x4){1.f, 1.f, 1.f, 1.f};
    extern __shared__ __attribute__((aligned(16))) unsigned char dyn_lds_epi[];
    float* rs = (float*)(dyn_lds_epi + EPI_RS_OFF) + (wr * 4 + wc) * 128;
    { const int lane = fq * 16 + fr;
#pragma unroll
      for (int h = 0; h < 2; ++h) { const int j = lane + 64 * h; rs[j] = row_scale(ssq, u.pm * 256 + (j >> 6) * 128 + wr * 64 + (j & 63)) * T.ascale; } }
    f32x4 cN[2], sN[2];
    { const int pos0 = ((u.pm * 256 + wr * 64 + fr) & (S - 1)) + NMETA;
#pragma unroll
      for (int n = 0; n < 2; ++n) { cN[n] = *(const f32x4*)(COS + pos0 * 32 + 8 * fq + 4 * n); sN[n] = *(const f32x4*)(SIN + pos0 * 32 + 8 * fq + 4 * n); } }
#pragma unroll
    for (int ai = 0; ai < 2; ++ai)
#pragma unroll
        for (int m = 0; m < 4; ++m) {
            const int R = u.pm * 256 + ai * 128 + wr * 64 + m * 16 + fr;
            const float rr = rs[ai * 64 + m * 16 + fr];
            const f32x4 cC[2] = {cN[0], cN[1]}, sC[2] = {sN[0], sN[1]};
            if (ai * 4 + m < 7) { const int in = ai * 4 + m + 1, posn = ((u.pm * 256 + (in >> 2) * 128 + wr * 64 + (in & 3) * 16 + fr) & (S - 1)) + NMETA;
#pragma unroll
                for (int n = 0; n < 2; ++n) { cN[n] = *(const f32x4*)(COS + posn * 32 + 8 * fq + 4 * n); sN[n] = *(const f32x4*)(SIN + posn * 32 + 8 * fq + 4 * n); } }
            f32x4 x[2][2];
#pragma unroll
            for (int bj = 0; bj < 2; ++bj)
#pragma unroll
                for (int n = 0; n < 2; ++n) x[bj][n] = acc[ai][bj][m][n] * rr;
            if (T.mode & 1) {
                float ss = (hsum4(x[0][0] * x[0][0]) + hsum4(x[0][1] * x[0][1])) + (hsum4(x[1][0] * x[1][0]) + hsum4(x[1][1] * x[1][1]));
                ss += __shfl_xor(ss, 16); ss += __shfl_xor(ss, 32);
                const float rn = rsqrtf(ss * (1.0f / 64.0f) + EPS);
#pragma unroll
                for (int bj = 0; bj < 2; ++bj)
#pragma unroll
                    for (int n = 0; n < 2; ++n) x[bj][n] = x[bj][n] * (g[bj][n] * rn);
            }
            if (T.mode & 2) {
#pragma unroll
                for (int n = 0; n < 2; ++n) { const f32x4 c = cC[n], sn = sC[n];
                    const f32x4 lo = x[0][n], hi = x[1][n]; x[0][n] = lo * c - hi * sn; x[1][n] = lo * sn + hi * c; }
            }
            const size_t drow = (T.mode & 4) ? (size_t)(R >> 11) * KROWS + PRE + (R & (S - 1)) : (size_t)R;
            bf16* dp = T.dst + drow * T.ldd + T.col0 + 8 * fq;
            *(u32x4*)(dp) = pack8(x[0][0] * T.scale, x[0][1] * T.scale);
            *(u32x4*)(dp + 32) = pack8(x[1][0] * T.scale, x[1][1] * T.scale);
        }
}
struct EpiInA {
    static constexpr bool PERM = true, AFTER_DRAIN = false;
    const Ptrs& P; int l; int f8, pn0;
    __device__ __forceinline__ void operator()(const f32x4 (&acc)[2][2][4][2], const pg8::Unit& u, int wr, int wc, int fr, int fq) const {
        HeadTile T; const int pn = u.pn + pn0; T.ascale = f8 ? 1.0f / IN_F8S : 1.0f;
        if (pn < 4) { T.dst = WSP(bf16, OFF_QO); T.ldd = D; T.col0 = 64 * (4 * pn + wc); T.mode = 3; T.gain = WSP(float, OFF_GT) + GT_AQG + l * 64; T.scale = C2; }
        else if (pn == 4) { T.dst = WSP(bf16, OFF_KA); T.ldd = 256; T.col0 = 64 * wc; T.mode = 7; T.gain = WSP(float, OFF_GT) + GT_AKG + l * 64; T.scale = 1.f; }
        else if (pn == 5) { T.dst = WSP(bf16, OFF_VA); T.ldd = 256; T.col0 = 64 * wc; T.mode = 4; T.gain = nullptr; T.scale = 1.f; }
        else { T.dst = WSP(bf16, OFF_QI); T.ldd = 512; T.col0 = 64 * (4 * (pn - 6) + wc); T.mode = 2; T.gain = nullptr; T.scale = 1.f; }
        epi_heads(P, T, ssq_p(P, 2 * l), acc, u, wr, wc, fr, fq);
    }
};
struct EpiInB {
    static constexpr bool PERM = true, AFTER_DRAIN = false;
    const Ptrs& P; int l;
    __device__ __forceinline__ void operator()(const f32x4 (&acc)[2][2][4][2], const pg8::Unit& u, int wr, int wc, int fr, int fq) const {
        HeadTile T; const int pn = u.pn; T.ascale = 1.0f / IN_F8S;
        if (pn < 4) { T.dst = WSP(bf16, OFF_QO); T.ldd = D; T.col0 = 64 * (4 * pn + wc); T.mode = 1; T.gain = WSP(float, OFF_GT) + GT_BQG + (l - 2) * 64; T.scale = C2; }
        else if (pn < 8) { T.dst = WSP(bf16, OFF_KB); T.ldd = D; T.col0 = 64 * (4 * (pn - 4) + wc); T.mode = 5; T.gain = WSP(float, OFF_GT) + GT_KKG; T.scale = 1.f; }
        else { T.dst = WSP(bf16, OFF_VB); T.ldd = D; T.col0 = 64 * (4 * (pn - 8) + wc); T.mode = 4; T.gain = nullptr; T.scale = 1.f; }
        epi_heads(P, T, ssq_p(P, 2 * l), acc, u, wr, wc, fr, fq);
    }
};
__device__ __forceinline__ f32x4 i2f4(const f32x4& v) { f32x4 r; r[0] = (float)__float_as_int(v[0]); r[1] = (float)__float_as_int(v[1]); r[2] = (float)__float_as_int(v[2]); r[3] = (float)__float_as_int(v[3]); return r; }
template <bool MLP>
struct EpiRes {
    static constexpr bool PERM = true, AFTER_DRAIN = false;
    const Ptrs& P; int l, dry;
    __device__ __forceinline__ void operator()(const f32x4 (&acc)[2][2][4][2], const pg8::Unit& u, int wr, int wc, int fr, int fq) const {
        constexpr int mlp = MLP ? 1 : 0;
        const bf16* H = WSP(bf16, OFF_H); bf16* Hw = dry ? (bf16*)P.out : WSP(bf16, OFF_H); float* ssqn = dry ? P.out + (size_t)20 * 1024 * 1024 : ssq_p(P, 2 * l + (mlp ? 2 : 1)); const bool last = mlp && l == 3 && !dry;
        f32x4 csa[2], csb[2];
        if constexpr (MLP) { const int* cs = (const int*)(P.ws + OFF_CTL) + CW_CS + l * D;
#pragma unroll
            for (int bj = 0; bj < 2; ++bj) { const int col = u.pn * 256 + bj * 128 + wc * 32 + 8 * fq; const i32x4v c0 = *(const i32x4v*)(cs + col), c1 = *(const i32x4v*)(cs + col + 4);
#pragma unroll
                for (int j = 0; j < 4; ++j) { csa[bj][j] = 128.f * (float)c0[j]; csb[bj][j] = 128.f * (float)c1[j]; } } }
        u32x4 hvv[2][4][2];
#pragma unroll
        for (int ai = 0; ai < 2; ++ai)
#pragma unroll
            for (int m = 0; m < 4; ++m)
#pragma unroll
                for (int bj = 0; bj < 2; ++bj) hvv[ai][m][bj] = *(const u32x4*)(H + (size_t)(u.pm * 256 + ai * 128 + wr * 64 + m * 16 + fr) * D + u.pn * 256 + bj * 128 + wc * 32 + 8 * fq);
        extern __shared__ __attribute__((aligned(16))) unsigned char dyn_lds_epi[];
        float* rs = (float*)(dyn_lds_epi + EPI_RS_OFF) + (wr * 4 + wc) * 128;
        if constexpr (!MLP) { const int lane = fq * 16 + fr;
#pragma unroll
            for (int h = 0; h < 2; ++h) { const int j = lane + 64 * h; rs[j] = row_scale(ssq_p(P, 2 * l), u.pm * 256 + (j >> 6) * 128 + wr * 64 + (j & 63)) * QA; } }
#pragma unroll
        for (int ai = 0; ai < 2; ++ai)
#pragma unroll
            for (int m = 0; m < 4; ++m) {
                const int R = u.pm * 256 + ai * 128 + wr * 64 + m * 16 + fr; float sq = 0.f;
                float qs = 0.f; if constexpr (!MLP) qs = rs[ai * 64 + m * 16 + fr];
#pragma unroll
                for (int bj = 0; bj < 2; ++bj) {
                    const int col = u.pn * 256 + bj * 128 + wc * 32 + 8 * fq;
                    const u32x4 hv = hvv[ai][m][bj];
                    f32x4 a, b;
                    if constexpr (MLP) { a = (i2f4(acc[ai][bj][m][0]) + csa[bj]) * (1.0f / (QU * QW2)); b = (i2f4(acc[ai][bj][m][1]) + csb[bj]) * (1.0f / (QU * QW2)); }
                    else { a = acc[ai][bj][m][0]; b = acc[ai][bj][m][1]; }
                    a[0] += bf2f(hv.x & 0xffffu); a[1] += bf2f(hv.x >> 16); a[2] += bf2f(hv.y & 0xffffu); a[3] += bf2f(hv.y >> 16);
                    b[0] += bf2f(hv.z & 0xffffu); b[1] += bf2f(hv.z >> 16); b[2] += bf2f(hv.w & 0xffffu); b[3] += bf2f(hv.w >> 16);
                    sq += hsum4(a * a) + hsum4(b * b);
                    if (!last) *(u32x4*)(Hw + (size_t)R * D + col) = pack8(a, b);
                    if constexpr (MLP) { if (!last && !dry) { u32x2 o8; o8.x = pk4_fp8(a[0], a[1], a[2], a[3]); o8.y = pk4_fp8(b[0], b[1], b[2], b[3]);
                        *(u32x2*)(WSP(unsigned char, l == 0 ? OFF_H8A : OFF_H8B) + blk8(R, col, D)) = o8; } }
                    else { if (!dry) { u32x2 o8; o8.x = pk4_i8(a[0] * qs, a[1] * qs, a[2] * qs, a[3] * qs); o8.y = pk4_i8(b[0] * qs, b[1] * qs, b[2] * qs, b[3] * qs);
                        *(u32x2*)(WSP(unsigned char, OFF_HQ) + blk8(R, col, D)) = o8; } }
                    if (last) { float* op = P.out + (size_t)R * D + col; *(f32x4*)op = a; *(f32x4*)(op + 4) = b; }
                }
                sq += __shfl_xor(sq, 16); sq += __shfl_xor(sq, 32);
                if (fq == 0 && !last) ssqn[(size_t)R * 16 + 4 * u.pn + wc] = sq;
            }
    }
};
struct EpiRelu2 {
    static constexpr bool PERM = true, AFTER_DRAIN = false;
    const Ptrs& P; int l, blk;
    __device__ __forceinline__ void operator()(const f32x4 (&acc)[2][2][4][2], const pg8::Unit& u, int wr, int wc, int fr, int fq) const {
        unsigned char* U8 = WSP(unsigned char, OFF_U);
        extern __shared__ __attribute__((aligned(16))) unsigned char dyn_lds_epi[];
        float* rs = (float*)(dyn_lds_epi + EPI_RS_OFF) + (wr * 4 + wc) * 128;
        { const int lane = fq * 16 + fr; float v[2];
#pragma unroll
          for (int h = 0; h < 2; ++h) { const int j = lane + 64 * h, Rj = u.pm * 256 + (j >> 6) * 128 + wr * 64 + (j & 63);
              v[h] = row_scale(ssq_p(P, 2 * l + 1), Rj) * SQRT_QU / (row_scale(ssq_p(P, 2 * l), Rj) * (QA * QW1)); }
          rs[lane] = v[0]; rs[lane + 64] = v[1]; }
#pragma unroll
        for (int ai = 0; ai < 2; ++ai)
#pragma unroll
            for (int m = 0; m < 4; ++m) {
                const int R = u.pm * 256 + ai * 128 + wr * 64 + m * 16 + fr;
                const float sc = rs[ai * 64 + m * 16 + fr];
#pragma unroll
                for (int bj = 0; bj < 2; ++bj) {
                    const f32x4 sc4 = {sc, sc, sc, sc};
                    f32x4 a = i2f4(acc[ai][bj][m][0]) * sc4, b = i2f4(acc[ai][bj][m][1]) * sc4;
#pragma unroll
                    for (int j = 0; j < 4; ++j) { a[j] = fmaxf(a[j], 0.f); b[j] = fmaxf(b[j], 0.f); }
                    a = a * a; b = b * b;

                    const int col = u.pn * 256 + bj * 128 + wc * 32 + 8 * fq;
                    int p0 = __builtin_amdgcn_cvt_pk_u8_f32(a[0], 0, 0); p0 = __builtin_amdgcn_cvt_pk_u8_f32(a[1], 1, p0); p0 = __builtin_amdgcn_cvt_pk_u8_f32(a[2], 2, p0); p0 = __builtin_amdgcn_cvt_pk_u8_f32(a[3], 3, p0);
                    int p1 = __builtin_amdgcn_cvt_pk_u8_f32(b[0], 0, 0); p1 = __builtin_amdgcn_cvt_pk_u8_f32(b[1], 1, p1); p1 = __builtin_amdgcn_cvt_pk_u8_f32(b[2], 2, p1); p1 = __builtin_amdgcn_cvt_pk_u8_f32(b[3], 3, p1);
                    u32x2 o; o.x = (unsigned)p0 ^ 0x80808080u; o.y = (unsigned)p1 ^ 0x80808080u;
                    __builtin_nontemporal_store(o, (u32x2*)(U8 + ((size_t)(R >> 4) * (FF / 32) + (col >> 5)) * 512 + (R & 15) * 32 + (col & 31)));
                }
            }
    }
};

#include <hip/hip_bf16.h>
#include <cmath>
namespace attn_body {
typedef unsigned u32x2_t __attribute__((ext_vector_type(2)));
constexpr int KVROWS=64+2048;
constexpr int LDS_AUX_BYTES=33*32*8;
using bf16=__hip_bfloat16;
using bf16x8=__attribute__((ext_vector_type(8)))short;
using s16x4=__attribute__((ext_vector_type(4)))short;
using f32x16=__attribute__((ext_vector_type(16)))float;
using u32x4=__attribute__((ext_vector_type(4)))unsigned;
constexpr int BATCH=16,NHEAD=16,SEQ=2048,D=64,DM=NHEAD*D;
constexpr int NW=8,QBLK=32,QB=QBLK*NW,KVBLK=64,NQB=SEQ/QB;
constexpr int ATTN_PITCH=DM, ATTN_UNIT_ROWS=QB;
__device__ __forceinline__ int crow(int r,int hi){return (r&3)+8*(r>>2)+4*hi;}
#define SBAR() __builtin_amdgcn_sched_barrier(0)
__device__ __forceinline__ void cmask(f32x16&p0,f32x16&p1,int jb,int qrel,int hi){
  const float NEG=-INFINITY; int kb=64*jb+4*hi;
  #pragma unroll
  for(int r=0;r<16;++r){int kv=kb+(r&3)+8*(r>>2); if(kv>qrel)p0[r]=NEG; if(kv+32>qrel)p1[r]=NEG;}
}

constexpr int NSLOT=3, SLOTB=8192;
constexpr int LDS_K=0, LDS_V=NSLOT*SLOTB, LDS_WS=2*NSLOT*SLOTB, LDS_OST=LDS_WS+NW*64*4, LDS_CORE=LDS_OST+NW*4096, LDS_AUX=LDS_CORE, LDS_BYTES=LDS_AUX+NW*LDS_AUX_BYTES;
constexpr float C2=0.125f*1.4426950408889634f;
__device__ __forceinline__ void glds16(const void*gsrc,unsigned lds_dst){unsigned keep;
  asm volatile("s_mov_b32 %0, m0\n\ts_mov_b32 m0, %2\n\ts_nop 0\n\tglobal_load_lds_dwordx4 %1, off\n\ts_mov_b32 m0, %0":"=&s"(keep):"v"(gsrc),"s"(lds_dst):"memory");}
__device__ __forceinline__ float max3f(float a,float b,float c){float r;asm("v_max3_f32 %0, %1, %2, %3":"=v"(r):"v"(a),"v"(b),"v"(c));return r;}
__device__ __forceinline__ float max2f(float a,float b){float r;asm("v_max_f32_e32 %0, %1, %2":"=v"(r):"v"(a),"v"(b));return r;}
__device__ __forceinline__ float fadd_s(float a,float b){float r;asm("v_add_f32_e32 %0, %1, %2":"=v"(r):"v"(a),"v"(b));return r;}
__device__ __forceinline__ float fsub_s(float a,float b){float r;asm("v_sub_f32_e32 %0, %1, %2":"=v"(r):"v"(a),"v"(b));return r;}
typedef float f32x2_t __attribute__((ext_vector_type(2))); typedef float f32x4_t __attribute__((ext_vector_type(4))); typedef __bf16 bf16x2_t __attribute__((ext_vector_type(2)));
__device__ __forceinline__ unsigned cvtpk_s(float lo,float hi){f32x2_t v={lo,hi};bf16x2_t b=__builtin_convertvector(v,bf16x2_t);return __builtin_bit_cast(unsigned,b);}
#define WAIT_BAR(N) asm volatile("s_waitcnt vmcnt(" #N ") lgkmcnt(0)\n\ts_barrier":::"memory")

__device__ __forceinline__ void qkt(f32x16&p0,f32x16&p1,const char*Kslot,const bf16x8*qr,const f32x16&negm,int r32,int hi){
  const char*kb=Kslot+hi*1024+r32*16;
  #pragma unroll
  for(int d0=0;d0<4;++d0){
    const bf16x8 b0=*reinterpret_cast<const bf16x8*>(kb+d0*2048);
    const bf16x8 b1=*reinterpret_cast<const bf16x8*>(kb+d0*2048+512);
    if(d0==0){p0=__builtin_amdgcn_mfma_f32_32x32x16_bf16(b0,qr[0],negm,0,0,0);p1=__builtin_amdgcn_mfma_f32_32x32x16_bf16(b1,qr[0],negm,0,0,0);}
    else{p0=__builtin_amdgcn_mfma_f32_32x32x16_bf16(b0,qr[d0],p0,0,0,0);p1=__builtin_amdgcn_mfma_f32_32x32x16_bf16(b1,qr[d0],p1,0,0,0);}}
}
typedef __attribute__((address_space(3))) const char* lds_cptr;
typedef __attribute__((address_space(3))) char* lds_cptr_w;
typedef short v4i16_t __attribute__((ext_vector_type(4)));
__device__ __forceinline__ void kload8(bf16x8*kf,lds_cptr kp){
  kf[0]=*(const __attribute__((address_space(3))) bf16x8*)(kp);      kf[1]=*(const __attribute__((address_space(3))) bf16x8*)(kp+512);
  kf[2]=*(const __attribute__((address_space(3))) bf16x8*)(kp+2048); kf[3]=*(const __attribute__((address_space(3))) bf16x8*)(kp+2560);
  kf[4]=*(const __attribute__((address_space(3))) bf16x8*)(kp+4096); kf[5]=*(const __attribute__((address_space(3))) bf16x8*)(kp+4608);
  kf[6]=*(const __attribute__((address_space(3))) bf16x8*)(kp+6144); kf[7]=*(const __attribute__((address_space(3))) bf16x8*)(kp+6656);
}
__device__ __forceinline__ void kload2(bf16x8*kf,lds_cptr kp,int j){ kf[2*j]=*(const __attribute__((address_space(3))) bf16x8*)(kp+j*2048); kf[2*j+1]=*(const __attribute__((address_space(3))) bf16x8*)(kp+j*2048+512); }
__device__ __forceinline__ s16x4 vtr(lds_cptr p){ return __builtin_bit_cast(s16x4,__builtin_amdgcn_ds_read_tr16_b64_v4i16((__attribute__((address_space(3))) v4i16_t*)p)); }
__device__ __forceinline__ float rowmax(const f32x16&p0,const f32x16&p1){
  float a=max3f(p0[0],p0[1],p1[0]),b=max3f(p0[2],p0[3],p1[1]);a=max3f(a,p1[2],p1[3]);
  #pragma unroll
  for(int r=4;r<16;r+=4){a=max3f(a,p0[r],p0[r+1]);b=max3f(b,p0[r+2],p0[r+3]);a=max3f(a,p1[r],p1[r+1]);b=max3f(b,p1[r+2],p1[r+3]);}
  const float m=max2f(a,b);
  auto rr=__builtin_amdgcn_permlane32_swap(__float_as_uint(m),__float_as_uint(m),false,false);
  return max2f(__uint_as_float(rr[0]),__uint_as_float(rr[1]));
}
__device__ __forceinline__ void pv(f32x16*o,int vb,bf16x8 pa0,bf16x8 pa1,bf16x8 pa2,bf16x8 pa3){
  #pragma unroll
  for(int d0=0;d0<2;++d0){s16x4 lo[4],hi[4];
    #pragma unroll
    for(int ks=0;ks<4;++ks){
      asm volatile("ds_read_b64_tr_b16 %0,%1 offset:%c2":"=&v"(lo[ks]):"v"(vb),"i"(d0*4096+ks*1024):"memory");
      asm volatile("ds_read_b64_tr_b16 %0,%1 offset:%c2":"=&v"(hi[ks]):"v"(vb),"i"(d0*4096+ks*1024+512):"memory");}
    asm volatile("s_waitcnt lgkmcnt(0)":::"memory");SBAR();
    #define PK(k) (bf16x8){lo[k][0],lo[k][1],lo[k][2],lo[k][3],hi[k][0],hi[k][1],hi[k][2],hi[k][3]}
    o[d0]=__builtin_amdgcn_mfma_f32_32x32x16_bf16(pa0,PK(0),o[d0],0,0,0);
    o[d0]=__builtin_amdgcn_mfma_f32_32x32x16_bf16(pa1,PK(1),o[d0],0,0,0);
    o[d0]=__builtin_amdgcn_mfma_f32_32x32x16_bf16(pa2,PK(2),o[d0],0,0,0);
    o[d0]=__builtin_amdgcn_mfma_f32_32x32x16_bf16(pa3,PK(3),o[d0],0,0,0);
    #undef PK
  }
}

#ifndef ATTN_STORE16
#define ATTN_STORE16(p,v) (*(u32x4*)(p)=(v))
#endif
template<int THRL,int MODE,int KVP> __device__ __forceinline__ void attn_unit(int b,int h,int hk,int qb,const bf16*Q,const bf16*__restrict__ K,const bf16*__restrict__ V,bf16*O,char*shm,const unsigned*maskg,const float*biasg,int t0  ){
  int tid_=threadIdx.x; asm volatile("":"+v"(tid_));
  const int tid=tid_,lane=tid&63,r32=lane&31,hi=lane>>5; const int wid=__builtin_amdgcn_readfirstlane(tid>>6);
  const long rowbase=(long)b*SEQ; const int q0=qb*QB;
  const bf16*Qw=Q+(rowbase+q0+wid*QBLK)*DM+h*D;
  const long kvbase=(long)b*KVROWS+(long)t0*64;
  const bf16*Kh=K+kvbase*KVP+hk*D,*Vh=V+kvbase*KVP+hk*D;
  const unsigned lds0=(unsigned)(uintptr_t)shm;
  float*wsf=(float*)(shm+LDS_WS)+wid*64;
  const bf16*ksrc=Kh+(long)lane*KVP+wid*8;
  const bf16*vsrc=Vh+(long)(16*(wid&3)+(lane>>2))*KVP+(wid>>2)*32+(lane&3)*8;
  const unsigned kdst=lds0+LDS_K+wid*1024, vdst=lds0+LDS_V+wid*1024;
  #define DMA_K(t,slot) glds16(ksrc+(long)(t)*KVBLK*KVP,(unsigned)__builtin_amdgcn_readfirstlane(kdst+(slot)))
  #define DMA_V(t,slot) glds16(vsrc+(long)(t)*KVBLK*KVP,(unsigned)__builtin_amdgcn_readfirstlane(vdst+(slot)))
  const int vb0=(int)(lds0+LDS_V)+((lane>>4)&1)*32+(lane&3)*8+(4*hi+((lane&15)>>2))*64;
  const char*Kbase=shm+LDS_K; bf16x8 kf[8];
  const lds_cptr shm3=(lds_cptr)shm; const lds_cptr kp0=shm3+LDS_K+hi*1024+r32*16; const lds_cptr vp0=shm3+LDS_V+((lane>>4)&1)*32+(lane&3)*8+(4*hi+((lane&15)>>2))*64;
  const int NT=(q0+QB)/KVBLK+1-t0;
  float nbq=0.f; if(MODE==1) nbq=biasg[64+q0+wid*QBLK+r32];
  if(MODE==2){} else if(MODE==0){
    const unsigned*mrow=maskg+((long)(rowbase+q0+wid*QBLK+r32))*66;
    __attribute__((address_space(3))) u32x2_t*mdst=(__attribute__((address_space(3))) u32x2_t*)((lds_cptr_w)shm+LDS_AUX+wid*LDS_AUX_BYTES);
    for(int t=hi;t<NT;t+=2){ const u32x2_t w=*reinterpret_cast<const u32x2_t*>(mrow+2*t); mdst[t*32+r32]=w; }
  } else {
    __attribute__((address_space(3))) float*bdst=(__attribute__((address_space(3))) float*)((lds_cptr_w)shm+LDS_AUX);
    for(int i=tid;i<NT*64;i+=NW*64)bdst[i]=biasg[t0*64+i];
  }
  asm volatile("s_waitcnt vmcnt(0) lgkmcnt(0)":::"memory");
  DMA_K(0,0);DMA_V(0,0);DMA_K(1,SLOTB);
  bf16x8 qr[4];
  #pragma unroll
  for(int d0=0;d0<4;++d0)qr[d0]=*reinterpret_cast<const bf16x8*>(&Qw[(long)r32*DM+d0*16+hi*8]);
  float mhat=0.f,l_reg=0.f;f32x16 o[2];o[0]=f32x16{};o[1]=f32x16{};const f32x16 negm=f32x16{};
  const int qrel=wid*QBLK+r32;
  if(MODE==1) mhat=nbq;
  #define CMASK(P0,P1,t) do{ if(MODE==2){ _Pragma("unroll") for(int r=0;r<16;++r){P0[r]-=mhat;P1[r]-=mhat;} int jb_=(t)-(NT-4); if(jb_>=0)cmask(P0,P1,jb_,qrel,hi); } else if(MODE==0){ const u32x2_t mw_=*((const __attribute__((address_space(3))) u32x2_t*)(shm3+LDS_AUX+wid*LDS_AUX_BYTES)+(t)*32+r32); mkx=mw_.x>>(4*hi); mky=mw_.y>>(4*hi); } \
      else { const __attribute__((address_space(3))) float*bp_=(const __attribute__((address_space(3))) float*)(shm3+LDS_AUX)+64*(t)+4*hi; \
        _Pragma("unroll") for(int g_=0;g_<4;++g_){ const f32x4_t b0_=*(const __attribute__((address_space(3))) f32x4_t*)(bp_+8*g_)-mhat, b1_=*(const __attribute__((address_space(3))) f32x4_t*)(bp_+32+8*g_)-mhat; \
          _Pragma("unroll") for(int j_=0;j_<4;++j_){ P0[4*g_+j_]+=b0_[j_]; P1[4*g_+j_]+=b1_[j_]; } SBAR(); } \
        int jb_=(t)-(NT-4); if(jb_>=0)cmask(P0,P1,jb_,qrel,hi); } }while(0)
  bool resc=false; unsigned mkx=0u,mky=0u;
  #define MSK(X,i,W) do{ float xv_=X[i]; unsigned mt_;   \
      asm volatile("v_bfe_i32 %1, %2, %3, 1\n\tv_and_b32 %0, %0, %1":"+v"(xv_),"=&v"(mt_):"v"(W),"n"(((i)&3)+8*((i)>>2))); X[i]=xv_; }while(0)
  #define START(P0,P1) do{ resc=false; \
    if(MODE==2){ const float rm=rowmax(P0,P1); const float dl=rm; mhat=fadd_s(mhat,dl); \
      _Pragma("unroll") for(int r=0;r<16;++r){P0[r]=fsub_s(P0[r],dl);P1[r]=fsub_s(P1[r],dl);} \
      } \
    _Pragma("unroll") for(int r=0;r<16;++r){P0[r]=__builtin_amdgcn_exp2f(P0[r]); if(MODE==0){MSK(P0,r,mkx);}} }while(0)
  #define RESC() do{ if(resc){ asm volatile("s_waitcnt lgkmcnt(0)":::"memory"); \
      _Pragma("unroll") for(int d_=0;d_<2;++d_) _Pragma("unroll") for(int r=0;r<16;++r)o[d_][r]*=wsf[crow(r,hi)]; } }while(0)
  f32x16 pA0,pA1,pB0,pB1;
  int sl_prev=0,sl_cur=0,sl_next=SLOTB;
  #define ROT() do{sl_prev=sl_cur;sl_cur=sl_next;sl_next=(sl_next==(NSLOT-1)*SLOTB)?0:sl_next+SLOTB;}while(0)
  DMA_K(2,2*SLOTB);
  WAIT_BAR(3);
  qkt(pA0,pA1,Kbase,qr,negm,r32,hi);asm volatile("s_nop 15\n\ts_nop 7":"+v"(pA0),"+v"(pA1));CMASK(pA0,pA1,0);
  START(pA0,pA1);
  _Pragma("unroll") for(int r=0;r<16;++r){pA1[r]=__builtin_amdgcn_exp2f(pA1[r]); if(MODE==0){MSK(pA1,r,mky);}}
  WAIT_BAR(0);
  DMA_K(3,0);DMA_V(1,SLOTB);
  ROT();
  kload8(kf,kp0+sl_cur);
  WAIT_BAR(2);
  s16x4 vlo[8],vhi[8]; u32x4 pw0,pw1,pw2,pw3;
  #define PKW(P,B) cvtpk_s(P[B],P[B+1])
  #define PAF(k) __builtin_bit_cast(bf16x8,pw##k)
  #define VFR(i) (bf16x8){vlo[i][0],vlo[i][1],vlo[i][2],vlo[i][3],vhi[i][0],vhi[i][1],vhi[i][2],vhi[i][3]}
  #define PIN(x) asm volatile("":"+v"(x))
  #define MX3(a,b,c) __builtin_fmaxf(__builtin_fmaxf((a),(b)),(c))
  #define GAPA(MF,A0,A1,A2,A3,W0,W1,PW) do{ MF; sacc+=A0; sacc+=A1; sacc+=A2; sacc+=A3; PIN(sacc); W0; W1; PIN(PW); SBAR(); }while(0)
  #define EX(v) __builtin_amdgcn_exp2f(v)
  #define GAPB(MF,X,B,W) do{ MF; X[B]=EX(X[B]); X[B+1]=EX(X[B+1]); X[B+2]=EX(X[B+2]); X[B+3]=EX(X[B+3]); if(MODE==0){MSK(X,B,W);MSK(X,(B)+1,W);MSK(X,(B)+2,W);MSK(X,(B)+3,W);} PIN(X); SBAR(); }while(0)
  #define VRD(i) do{ vlo[i]=vtr(vp_+(((i)>>2)*4096+((i)&3)*1024)); vhi[i]=vtr(vp_+(((i)>>2)*4096+((i)&3)*1024+512)); }while(0)
  #define KRD(G,j) do{ if(G){ kload2(kf,kp0+sl_next,j); SBAR(); } }while(0)
  #define STEP(C0,C1,P0,P1,t,GK,GV,GL) do{ SBAR(); \
    const lds_cptr vp_=vp0+sl_prev; \
    VRD(0); SBAR(); float sacc=(P0[0]+P0[1]); \
    GAPA(C0=__builtin_amdgcn_mfma_f32_32x32x16_bf16(kf[0],qr[0],negm,0,0,0), P0[2],P0[3],P0[4],P0[5],     pw0[0]=PKW(P0,0), pw0[1]=PKW(P0,2), pw0); \
    VRD(4); SBAR(); GAPA(C1=__builtin_amdgcn_mfma_f32_32x32x16_bf16(kf[1],qr[0],negm,0,0,0), P0[6],P0[7],P0[8],P0[9],     pw0[2]=PKW(P0,4), pw0[3]=PKW(P0,6), pw0); \
    VRD(1); SBAR(); GAPA(C0=__builtin_amdgcn_mfma_f32_32x32x16_bf16(kf[2],qr[1],C0,0,0,0),   P0[10],P0[11],P0[12],P0[13], pw1[0]=PKW(P0,8), pw1[1]=PKW(P0,10), pw1); \
    VRD(5); SBAR(); GAPA(C1=__builtin_amdgcn_mfma_f32_32x32x16_bf16(kf[3],qr[1],C1,0,0,0),   P0[14],P0[15],P1[0],P1[1],   pw1[2]=PKW(P0,12),pw1[3]=PKW(P0,14), pw1); \
    VRD(2); SBAR(); GAPA(C0=__builtin_amdgcn_mfma_f32_32x32x16_bf16(kf[4],qr[2],C0,0,0,0),   P1[2],P1[3],P1[4],P1[5],     pw2[0]=PKW(P1,0), pw2[1]=PKW(P1,2), pw2); \
    VRD(6); SBAR(); GAPA(C1=__builtin_amdgcn_mfma_f32_32x32x16_bf16(kf[5],qr[2],C1,0,0,0),   P1[6],P1[7],P1[8],P1[9],     pw2[2]=PKW(P1,4), pw2[3]=PKW(P1,6), pw2); \
    VRD(3); SBAR(); GAPA(C0=__builtin_amdgcn_mfma_f32_32x32x16_bf16(kf[6],qr[3],C0,0,0,0),   P1[10],P1[11],P1[12],P1[13], pw3[0]=PKW(P1,8), pw3[1]=PKW(P1,10), pw3); \
    VRD(7); SBAR(); GAPA(C1=__builtin_amdgcn_mfma_f32_32x32x16_bf16(kf[7],qr[3],C1,0,0,0),   P1[14],P1[15],0.f,0.f,       pw3[2]=PKW(P1,12),pw3[3]=PKW(P1,14), pw3); \
    l_reg+=sacc; \
    if(GK){DMA_K((t)+3,sl_cur);} if(GV){DMA_V((t)+1,sl_next);} \
    CMASK(C0,C1,t); \
    if(MODE==2){ float a=MX3(C0[0],C0[1],C1[0]),b=MX3(C0[2],C0[3],C1[1]); a=MX3(a,C1[2],C1[3]); \
      _Pragma("unroll") for(int r=4;r<16;r+=4){a=MX3(a,C0[r],C0[r+1]);b=MX3(b,C0[r+2],C0[r+3]);a=MX3(a,C1[r],C1[r+1]);b=MX3(b,C1[r+2],C1[r+3]);} \
      float rm=__builtin_fmaxf(a,b); { auto rr=__builtin_amdgcn_permlane32_swap(__float_as_uint(rm),__float_as_uint(rm),false,false); rm=__builtin_fmaxf(__uint_as_float(rr[0]),__uint_as_float(rr[1])); } \
      resc=false; \
      if(__builtin_expect(__any(rm>(float)THRL),0)){ const float dl=__builtin_fmaxf(rm,0.f); mhat+=dl; \
        _Pragma("unroll") for(int r=0;r<16;++r){C0[r]-=dl;C1[r]-=dl;} \
        \
        const float f=__builtin_amdgcn_exp2f(-dl); l_reg*=f; if(hi==0)wsf[r32]=f; resc=true; } } \
    SBAR(); \
    GAPB(o[0]=__builtin_amdgcn_mfma_f32_32x32x16_bf16(PAF(0),VFR(0),o[0],0,0,0), C0,0,mkx); \
    GAPB(o[1]=__builtin_amdgcn_mfma_f32_32x32x16_bf16(PAF(0),VFR(4),o[1],0,0,0), C0,4,mkx); \
    KRD(GL,0); GAPB(o[0]=__builtin_amdgcn_mfma_f32_32x32x16_bf16(PAF(1),VFR(1),o[0],0,0,0), C0,8,mkx); \
    KRD(GL,1); GAPB(o[1]=__builtin_amdgcn_mfma_f32_32x32x16_bf16(PAF(1),VFR(5),o[1],0,0,0), C0,12,mkx); \
    KRD(GL,2); GAPB(o[0]=__builtin_amdgcn_mfma_f32_32x32x16_bf16(PAF(2),VFR(2),o[0],0,0,0), C1,0,mky); \
    KRD(GL,3); GAPB(o[1]=__builtin_amdgcn_mfma_f32_32x32x16_bf16(PAF(2),VFR(6),o[1],0,0,0), C1,4,mky); \
    GAPB(o[0]=__builtin_amdgcn_mfma_f32_32x32x16_bf16(PAF(3),VFR(3),o[0],0,0,0), C1,8,mky); \
    GAPB(o[1]=__builtin_amdgcn_mfma_f32_32x32x16_bf16(PAF(3),VFR(7),o[1],0,0,0), C1,12,mky); \
    }while(0)
  int t=1;
  for(;t+5<NT;t+=2){
    STEP(pB0,pB1,pA0,pA1,t,true,true,true);     WAIT_BAR(2); RESC(); ROT();
    STEP(pA0,pA1,pB0,pB1,t+1,true,true,true);   WAIT_BAR(2); RESC(); ROT();
  }
  #define ENDW(tt) do{ if((tt)+3<NT){WAIT_BAR(2);} else if((tt)+2<NT){WAIT_BAR(1);} else {WAIT_BAR(0);} }while(0)
  for(;t+1<NT;t+=2){
    STEP(pB0,pB1,pA0,pA1,t,(t+3<NT),(t+1<NT),(t+1<NT));       ENDW(t);   RESC(); ROT();
    STEP(pA0,pA1,pB0,pB1,t+1,(t+4<NT),(t+2<NT),(t+2<NT));
    if(t+2<NT){ ENDW(t+1); RESC(); ROT(); } else { RESC(); }
  }
  { float sacc=pA0[0]+pA0[1]; _Pragma("unroll") for(int r=2;r<16;++r)sacc+=pA0[r]; _Pragma("unroll") for(int r=0;r<16;++r)sacc+=pA1[r]; l_reg+=sacc;
    pw0=(u32x4){PKW(pA0,0),PKW(pA0,2),PKW(pA0,4),PKW(pA0,6)};pw1=(u32x4){PKW(pA0,8),PKW(pA0,10),PKW(pA0,12),PKW(pA0,14)};pw2=(u32x4){PKW(pA1,0),PKW(pA1,2),PKW(pA1,4),PKW(pA1,6)};pw3=(u32x4){PKW(pA1,8),PKW(pA1,10),PKW(pA1,12),PKW(pA1,14)};
    SBAR(); pv(o,vb0+sl_cur,PAF(0),PAF(1),PAF(2),PAF(3)); }
  #undef PKW
  #undef PAF
  #undef VFR
  #undef PIN
  #undef MX3
  #undef GAPA
  #undef GAPB
  #undef MSK
  #undef EX
  #undef VRD
  #undef KRD
  #undef STEP
  #undef ENDW
  {auto rr=__builtin_amdgcn_permlane32_swap(__float_as_uint(l_reg),__float_as_uint(l_reg),false,false);l_reg=__uint_as_float(rr[0])+__uint_as_float(rr[1]);}
  if(hi==0)wsf[32+r32]=l_reg;asm volatile("s_waitcnt lgkmcnt(0)":::"memory");
  float rli[16];
  #pragma unroll
  for(int r=0;r<16;++r)rli[r]=__builtin_amdgcn_rcpf(wsf[32+crow(r,hi)]);
  bf16*Ow=O+(rowbase+q0+wid*QBLK)*DM+h*D;
  { bf16*stg=(bf16*)(shm+LDS_OST)+wid*2048;
    #pragma unroll
    for(int r=0;r<16;++r){const int orow=crow(r,hi);
      #pragma unroll
      for(int d0=0;d0<2;++d0)stg[orow*64+d0*32+r32]=__float2bfloat16(o[d0][r]*rli[r]);}
    asm volatile("s_waitcnt lgkmcnt(0)":::"memory");
    #pragma unroll
    for(int i=0;i<4;++i){const int row=i*8+(lane>>3),ch=lane&7; const u32x4 v=*(const u32x4*)(stg+row*64+ch*8); ATTN_STORE16(Ow+(long)row*DM+ch*8,v);} }
  asm volatile("s_waitcnt lgkmcnt(0)\n\ts_barrier":::"memory");
  #undef DMA_K
  #undef DMA_V
  #undef CMASK
  #undef START
  #undef RESC
  #undef ROT
}
constexpr int ATTN_LDS_BYTES=LDS_BYTES;
#undef SBAR
#undef WAIT_BAR
}

constexpr int SCHED_OFF = 156 * 1024;
constexpr int CW_ATTQ = 8192;
template <int MODE> __device__ __forceinline__ void attn_phase_fa(const Ptrs& P, char* lds, int G, int bx, bf16* Oout, int lyr) {
    typedef attn_body::bf16 abf;
    if (MODE != 1) {
#pragma unroll 1
        for (int u = bx; u < 2048; u += G) {
            const int bh = (G == 256) ? ((u & 7) * 32 + ((u & 255) >> 3)) : (u & 255), qb = 7 - (u >> 8), b = bh >> 4, h = bh & 15;
            if (MODE == 2) attn_body::attn_unit<8, 2, 1024>(b, h, h, qb, (const abf*)WSP(bf16, OFF_QO), (const abf*)WSP(bf16, OFF_QO), (const abf*)WSP(bf16, OFF_QO), (abf*)Oout, lds, nullptr, nullptr, 0);
            else attn_body::attn_unit<8, 0, 256>(b, h, h >> 2, qb, (const abf*)WSP(bf16, OFF_QO), (const abf*)WSP(bf16, OFF_KA), (const abf*)WSP(bf16, OFF_VA), (abf*)Oout, lds, WSP(unsigned, OFF_MASK), nullptr, 0);
        }
    } else {
        volatile LAS unsigned* sch = (volatile LAS unsigned*)((LAS unsigned char*)lds + SCHED_OFF);
        unsigned* qhead = (unsigned*)(P.ws + OFF_CTL) + CW_ATTQ + 64 * (lyr & 1) + 128 * (Oout != WSP(bf16, OFF_QO));
#pragma unroll 1
        for (;;) {
            int tid_q = threadIdx.x; asm volatile("" : "+v"(tid_q));
            const int lane = tid_q & 63, wave = __builtin_amdgcn_readfirstlane(tid_q >> 6);
            if (wave == 0) {
                unsigned u = 0;
                if (lane == 0) u = __hip_atomic_fetch_add(qhead, 1u, __ATOMIC_RELAXED, __HIP_MEMORY_SCOPE_AGENT);
                u = (unsigned)__builtin_amdgcn_readfirstlane((int)u);
                unsigned t0 = 0;
                if (u < 2048u) {
                    const int bh = u & 255, qb = 7 - (int)(u >> 8);
                    const float* nb = WSP(float, OFF_NB) + (size_t)bh * KROWS;
                    const float lim = nb[PRE + 256 * qb] - WSP(float, OFF_GT)[GT_SKIP];
                    const int cand = 2 * lane;
                    const bool ok = cand <= 4 * qb && (cand == 0 || nb[64 * cand - 1] <= lim);
                    const unsigned long long m = __ballot(ok);
                    t0 = 2u * (unsigned)(63 - __builtin_clzll(m));
                }
                if (lane == 0) { sch[0] = u; sch[1] = t0; }
            }
            asm volatile("s_waitcnt vmcnt(0) lgkmcnt(0)\n\ts_barrier" ::: "memory");
            const unsigned u = sch[0], t0 = sch[1];
            if (u >= 2048u) break;
            const int bh = u & 255, qb = 7 - (int)(u >> 8), b = bh >> 4, h = bh & 15;
            attn_body::attn_unit<8, 1, 1024>(b, h, h, qb, (const abf*)WSP(bf16, OFF_QO), (const abf*)WSP(bf16, OFF_KB), (const abf*)WSP(bf16, OFF_VB), (abf*)Oout, lds, nullptr, WSP(float, OFF_NB) + (size_t)bh * KROWS, (int)t0);
        }
    }
}

typedef GAS unsigned gu32;
#define RLX_AGENT __ATOMIC_RELAXED, __HIP_MEMORY_SCOPE_AGENT
#define XB_TMO      128
#define XB_XCNT(j)  (256  + 64 * (j))
#define XB_XSUB(j)  (1280 + 64 * (j))
#define XB_XGEN(j)  (2304 + 64 * (j))
#define XB_TOP      3328
#define XB_TOPGEN   3392
#define XCD_BAR_WORDS 3456
#define XB_SPIN_CAP (1u << 18)

__device__ __forceinline__ unsigned xb_ld(unsigned* p)              { return __hip_atomic_load(p, __ATOMIC_RELAXED, __HIP_MEMORY_SCOPE_AGENT); }
__device__ __forceinline__ unsigned xb_add(unsigned* p, unsigned v) { return __hip_atomic_fetch_add(p, v, __ATOMIC_RELAXED, __HIP_MEMORY_SCOPE_AGENT); }
__device__ __forceinline__ unsigned xb_xcc_id() { return (unsigned)__builtin_amdgcn_s_getreg((3 << 11) | 20) & 0xFu; }
#define XB_SPIN(cond, bar) do { unsigned _sp = 0; while (cond) { __builtin_amdgcn_s_sleep(1); \
    if ((++_sp & 255u) == 0u) { if (xb_ld(&(bar)[XB_TMO])) break; if (_sp > XB_SPIN_CAP) { atomicAdd(&(bar)[XB_TMO], 1u); break; } } } } while (0)

struct XcdBarrier {
    unsigned* bar; unsigned x;
    volatile LAS unsigned* st;
};

__device__ __forceinline__ XcdBarrier xcd_barrier_post(unsigned* bar, volatile LAS unsigned* st) {
    XcdBarrier b; b.bar = bar; b.x = xb_xcc_id(); b.st = st;
    if (threadIdx.x == 0) (void)xb_add(&bar[XB_XCNT(b.x)], 1u);
    return b;
}
__device__ __forceinline__ void xcd_barrier_complete(unsigned* bar, unsigned x, unsigned& nloc, unsigned& nx) {
    const unsigned G = gridDim.x * gridDim.y * gridDim.z;
    unsigned sum, cnt, mine, sp = 0u;
    for (;;) {
        sum = 0u; cnt = 0u; mine = 0u;
#pragma unroll
        for (unsigned j = 0; j < 16; ++j) { const unsigned c = xb_ld(&bar[XB_XCNT(j)]); sum += c; cnt += (c > 0u) ? 1u : 0u; mine = (j == x) ? c : mine; }
        if (sum == G) break;
        __builtin_amdgcn_s_sleep(1);
        if ((++sp & 255u) == 0u) { if (xb_ld(&bar[XB_TMO])) break; if (sp > XB_SPIN_CAP) { atomicAdd(&bar[XB_TMO], 1u); break; } }
    }
    nloc = mine > 0u ? mine : 1u; nx = cnt > 0u ? cnt : 1u;
}

__device__ __forceinline__ void xcd_barrier(const XcdBarrier& b) {
    asm volatile("s_waitcnt vmcnt(0)" ::: "memory");
    __syncthreads();
    if (threadIdx.x == 0) {
        unsigned* bar = b.bar;
        __builtin_amdgcn_s_waitcnt(0);
        unsigned nloc = b.st[0], nx = b.st[1];
        if (nloc == 0u) { xcd_barrier_complete(bar, b.x, nloc, nx); b.st[0] = nloc; b.st[1] = nx; }
        const unsigned old = xb_add(&bar[XB_XSUB(b.x)], 1u);
        const unsigned gen = old / nloc;
        if (old + 1u == (gen + 1u) * nloc) {
            __builtin_amdgcn_fence(__ATOMIC_RELEASE, "agent");
            asm volatile("s_waitcnt vmcnt(0)" ::: "memory");
            const unsigned og = xb_add(&bar[XB_TOP], 1u);
            const unsigned tg = og / nx;
            if (og + 1u == (tg + 1u) * nx) xb_add(&bar[XB_TOPGEN], 1u);
            else XB_SPIN(xb_ld(&bar[XB_TOPGEN]) == tg, bar);
            __builtin_amdgcn_fence(__ATOMIC_ACQUIRE, "agent");
            xb_add(&bar[XB_XGEN(b.x)], 1u);
            asm volatile("s_waitcnt vmcnt(0)" ::: "memory");
        } else {
            XB_SPIN(xb_ld(&bar[XB_XGEN(b.x)]) == gen, bar);
            __builtin_amdgcn_fence(__ATOMIC_ACQUIRE, "agent");
            asm volatile("s_waitcnt vmcnt(0)" ::: "memory");
        }
    }
    __syncthreads();
}


constexpr int NWAVES = 8;
constexpr int LDS_BYTES = 160 * 1024;
constexpr int MISC_OFF = LDS_BYTES - 256;
constexpr int CW_BAR = 4096;

struct Args { Ptrs P; int ph_lo, ph_hi; };
constexpr int N_PHASES = 1 + 8 * 4;
#ifndef PROBE_ID
#define PROBE_ID 0
#endif
#ifndef PROBE_DRY
#define PROBE_DRY 0
#endif
#ifndef PROBE_REPS
#define PROBE_REPS 3
#endif

#define SITE_IDS() int tid_s = threadIdx.x; asm volatile("" : "+v"(tid_s)); const int lane = tid_s & 63; const int wave = __builtin_amdgcn_readfirstlane(tid_s >> 6); \
    const int gw = bx * NWAVES + wave; (void)gw; (void)lane
__global__ void __launch_bounds__(NWAVES * 64, 2) mega_fwd(Args args) {
    extern __shared__ __attribute__((aligned(16))) unsigned char lds[];
    const Ptrs& P = args.P;
    const int G = gridDim.x, bx = blockIdx.x, ngw = G * NWAVES;
    volatile LAS unsigned* MISC = (volatile LAS unsigned*)((LAS unsigned char*)lds + MISC_OFF);
    for (int u = threadIdx.x; u < 64; u += NWAVES * 64) MISC[u] = 0u;
    __syncthreads();
    XcdBarrier bar = xcd_barrier_post((unsigned*)(P.ws + OFF_CTL) + CW_BAR, MISC + 8);
    const int lo = args.ph_lo, hi = args.ph_hi;
#define IN(k) (lo <= (k) && (k) < hi)
#define SEAM(k) do { if (IN(k) && IN((k) + 1)) xcd_barrier(bar); } while (0)
#define WSCR() ((float*)lds + wave * (64 * 65))

#define REPS(id) ((PROBE_ID == (id)) ? PROBE_REPS : 1)
#pragma unroll 1
    for (int rp = REPS(9); rp > 0; --rp) { if (IN(0)) { SITE_IDS(); prologue_work(P, gw, ngw, WSCR(), lane); } SEAM(0); }
#pragma unroll 1
    for (int l = 0; l < 4; ++l) {
        const int pb = 1 + 8 * l;
        if (l < 2) {
#pragma unroll 1
            for (int rp = REPS(1); rp > 0; --rp) {
            if (IN(pb + 0)) {
                { SITE_IDS(); if (l == 0 && rp == 1) for (int j = gw; j < 4 * D; j += ngw) colsum_job(P, j, lane);
                  for (int j = bx; j < 33; j += G) strip_job(P, SP_INA, l, M / 16, j, lane, 8, wave, (float*)lds);
                  for (int j = gw; j < M / 16; j += ngw) strip_job(P, SP_INA, l, j, 32, lane); }
                { pg8::Gemm g{WSP(bf16, OFF_H8A), WSP(bf16, OFF_WIN8 + l * SZ_WIN8), M, 1536, D / 2}; pg8::StaticOrder So; So.init(M, 1536, G, bx);
                  EpiInA E{P, l, 1, 0};
                  pg8::gemm_phase<EpiInA, pg8::StaticOrder, true, true, 1, true>((LAS unsigned char*)lds, g, So, E); }
                { pg8::Gemm g{WSP(bf16, OFF_H), WSP(bf16, OFF_WIN + l * SZ_WIN) + (size_t)1536 * D, M, 512, D}; pg8::StaticOrder So; So.init(M, 512, G, bx);
                  EpiInA E{P, l, 0, 6};
                  pg8::gemm_phase<EpiInA, pg8::StaticOrder, true, true>((LAS unsigned char*)lds, g, So, E); }
                { SITE_IDS(); zero_pads(P, gw, ngw, lane); }
            }
            SEAM(pb + 0); }
#pragma unroll 1
            for (int rp = REPS(2); rp > 0; --rp) {
            if (IN(pb + 1)) { SITE_IDS();
                const int itv = (G == 256) ? ((bx & 7) * 256 + (bx >> 3) * 8 + wave) : gw;
                for (int it = itv; it < NB * 128; it += ngw) { const int b = it >> 7, w = it & 127;
#pragma unroll 1
                    for (int j = 0; j < 8; ++j) { const int g2 = 128 * j + ((j & 1) ? 127 - w : w); indexer_pass(P, b, g2, lane, (LAS unsigned*)lds + wave * (IDX_LDS_PER_WAVE / 4), rp > 1 ? PROBE_DRY : 0); } } }
            SEAM(pb + 1); }
#pragma unroll 1
            for (int rp = REPS(3); rp > 0; --rp) {
            if (IN(pb + 2)) {
                { SITE_IDS(); attn_naive_work<0>(P, gw, ngw, WSCR(), lane, M, MR); }
                __syncthreads();
                if (PROBE_DRY && rp > 1) attn_phase_fa<2>(P, (char*)lds, G, bx, (bf16*)P.out, l); else
                attn_phase_fa<0>(P, (char*)lds, G, bx, rp > 1 ? (bf16*)P.out : WSP(bf16, OFF_QO), l);
            }
            SEAM(pb + 2); }
        } else {
#pragma unroll 1
            for (int rp = REPS(7); rp > 0; --rp) {
            if (IN(pb + 0)) {
                if (l == 2) { SITE_IDS(); for (int j = bx; j < 33; j += G) strip_job(P, SP_QKVB, l, M / 16, 16 + j, lane, 8, wave, (float*)lds);
                  for (int j = gw; j < M / 16; j += ngw) strip_job(P, SP_QKVB, l, j, 48, lane); }
                pg8::Gemm g{WSP(bf16, OFF_H8B), WSP(bf16, OFF_WQKV8 + (l == 2 ? 0 : size_t(3072) * D)), M, l == 2 ? 3072 : 1024, D / 2}; pg8::StaticOrder So; So.init(M, g.N, G, bx);
                EpiInB E{P, l};
                pg8::gemm_phase<EpiInB, pg8::StaticOrder, true, true, 1, true>((LAS unsigned char*)lds, g, So, E);
            }
            SEAM(pb + 0); }
            if (IN(pb + 1) && l == 2) { SITE_IDS(); for (int bh = bx; bh < 256; bh += G) scan_work(P, bh, (float*)lds, tid_s); }
            SEAM(pb + 1);
#pragma unroll 1
            for (int rp = REPS(8); rp > 0; --rp) {
            if (IN(pb + 2)) attn_phase_fa<1>(P, (char*)lds, G, bx, rp > 1 ? (bf16*)P.out : WSP(bf16, OFF_QO), l);
            SEAM(pb + 2); }
        }
#pragma unroll 1
        for (int rp = REPS(4); rp > 0; --rp) {
        if (IN(pb + 3)) {
            if (l < 2 && rp == 1) { SITE_IDS(); for (int j = bx; j < 16; j += G) strip_job(P, SP_RES_O, l, M / 16, j, lane, 8, wave, (float*)lds); }
            pg8::Gemm g{WSP(bf16, OFF_QO), wo_t(P, l), M, D, D}; pg8::StaticOrder So; So.init(M, D, G, bx);
            EpiRes<false> E{P, l, rp > 1};
            pg8::gemm_phase<EpiRes<false>, pg8::StaticOrder, true, true>((LAS unsigned char*)lds, g, So, E);
        }
        SEAM(pb + 3); }
#pragma unroll 1
        for (int rp = REPS(5); rp > 0; --rp) {
        if (IN(pb + 4)) {
            if (l < 2) { SITE_IDS(); for (int j = bx; j < 64; j += G) strip_job(P, SP_MLP1, l, M / 16, j, lane, 8, wave, (float*)lds); }
            pg8::Gemm g{WSP(bf16, OFF_HQ), WSP(bf16, OFF_W18 + l * SZ_W28), M, FF, D / 2}; pg8::StaticOrder So; So.init(M, FF, G, bx);
            EpiRelu2 E{P, l, (PROBE_DRY && rp > 1) ? 1 : 0};
            pg8::gemm_phase<EpiRelu2, pg8::StaticOrder, true, true, 2, true>((LAS unsigned char*)lds, g, So, E);
        }
        SEAM(pb + 4); }
#pragma unroll 1
        for (int rp = REPS(6); rp > 0; --rp) {
        if (IN(pb + 5)) {
            if (l < 2 && rp == 1) { SITE_IDS(); for (int j = bx; j < 16; j += G) strip_job(P, SP_RES_M, l, M / 16, j, lane, 8, wave, (float*)lds); }
            pg8::StaticOrder So; So.init(M, D, G, bx); EpiRes<true> E{P, l, rp > 1};
            pg8::Gemm g{WSP(bf16, OFF_U), WSP(bf16, OFF_W28 + l * SZ_W28), M, D, FF / 2};
            pg8::gemm_phase<EpiRes<true>, pg8::StaticOrder, true, true, 2, true>((LAS unsigned char*)lds, g, So, E);
        }
        if (rp > 1 || (l < 3 && IN(pb + 5) && IN(pb + 8))) xcd_barrier(bar); }
    }
#undef IN
#undef SEAM
}

#ifndef MK_ONE_LAUNCH
#define MK_ONE_LAUNCH 1
#endif
extern "C" void kernel_launch(void* const* d_in, const int* in_sizes, int n_in, void* d_out, int out_size, void* d_ws, size_t ws_size, hipStream_t stream) {
    static int grid = 0;
    if (grid == 0) {
        if (n_in != 17 || in_sizes[0] != M * D || out_size != M * D || ws_size < WS_END) {
            fprintf(stderr, "kernel_launch: unexpected shapes (n_in %d, in0 %d, out %d, ws %zu, need %zu)\n", n_in, n_in > 0 ? in_sizes[0] : -1, out_size, ws_size, (size_t)WS_END); grid = -1; return; }
        int dev = 0, cus = 0, per_cu = 0;
        if (hipGetDevice(&dev) != hipSuccess || hipDeviceGetAttribute(&cus, hipDeviceAttributeMultiprocessorCount, dev) != hipSuccess) { grid = -1; return; }
        if (hipFuncSetAttribute((const void*)mega_fwd, hipFuncAttributeMaxDynamicSharedMemorySize, LDS_BYTES) != hipSuccess) { fprintf(stderr, "kernel_launch: hipFuncSetAttribute failed\n"); grid = -1; return; }
        if (hipOccupancyMaxActiveBlocksPerMultiprocessor(&per_cu, (const void*)mega_fwd, NWAVES * 64, LDS_BYTES) != hipSuccess || per_cu < 1)
            fprintf(stderr, "kernel_launch: note: occupancy query reports %d workgroups per CU\n", per_cu);
        (void)hipGetLastError();
        grid = cus;
    }
    if (grid < 0) return;
    (void)hipMemsetAsync((char*)d_ws + OFF_CTL, 0, 65536, stream);
    Args a{};
    for (int i = 0; i < 17; ++i) a.P.in[i] = (const float*)d_in[i];
    a.P.out = (float*)d_out; a.P.ws = (unsigned char*)d_ws;
#if MK_ONE_LAUNCH
    a.ph_lo = 0; a.ph_hi = N_PHASES;
    hipLaunchKernelGGL(mega_fwd, dim3(grid), dim3(NWAVES * 64), LDS_BYTES, stream, a);
#else
    for (int ph = 0; ph < N_PHASES; ++ph) { a.ph_lo = ph; a.ph_hi = ph + 1; hipLaunchKernelGGL(mega_fwd, dim3(grid), dim3(NWAVES * 64), LDS_BYTES, stream, a); }
#endif
}
```

```cpp
#include <hip/hip_runtime.h>
#include <cstdint>
#include <cstdio>

typedef unsigned short bf16;
typedef short bf16x8 __attribute__((ext_vector_type(8)));
typedef float f32x4 __attribute__((ext_vector_type(4)));
typedef float f32x16 __attribute__((ext_vector_type(16)));
typedef unsigned u32x4 __attribute__((ext_vector_type(4)));

constexpr int NB = 16, S = 2048, D = 1024, NMETA = 16, HD = 64, FF = 4096;
constexpr int M = NB * S, MR = M + NMETA;
constexpr int PRE = 64, KROWS = PRE + S;
constexpr int NWORDS = KROWS / 32;
constexpr int NPOS = S + NMETA;
constexpr int WIN_ROWS = 2048 + 96, WKV_ROWS = 2048 + 32;
constexpr float EPS = 1e-6f;
constexpr float LOG2E = 1.4426950408889634f;
constexpr float C2 = 0.125f * LOG2E;
constexpr int TOPK = 256;

constexpr size_t al4k(size_t x) { return (x + 4095) & ~size_t(4095); }
constexpr size_t OFF_CTL = 0, SZ_CTL = size_t(4) << 20;
constexpr size_t OFF_ROPE = OFF_CTL + SZ_CTL, SZ_ROPE = al4k(size_t(2) * NPOS * 32 * 4);
constexpr size_t OFF_SSQ = OFF_ROPE + SZ_ROPE, SZ_SSQ1 = al4k(size_t(MR) * 16 * 4);
constexpr size_t OFF_GT = OFF_SSQ + 2 * SZ_SSQ1, SZ_GT = 4096;
constexpr int GT_AQG = 0, GT_AKG = 128, GT_KFB = 256, GT_KKG = 272, GT_BQG = 336, GT_N = 464, GT_SKIP = 464;
constexpr size_t OFF_W1B = OFF_GT + SZ_GT;
constexpr size_t SZ_W1 = size_t(FF) * D * 2, SZ_W2 = SZ_W1, SZ_SQ = size_t(D) * D * 2;
constexpr size_t OFF_W2B = OFF_W1B + 2 * SZ_W1;
constexpr size_t OFF_WOB = OFF_W2B + 2 * SZ_W2;
constexpr size_t OFF_WQ1 = OFF_WOB + 2 * SZ_SQ;
constexpr size_t OFF_WQ0 = OFF_WQ1 + SZ_SQ;
constexpr size_t OFF_WKV = OFF_WQ0 + SZ_SQ, SZ_WKV = al4k(size_t(WKV_ROWS) * D * 2);
constexpr size_t OFF_H = OFF_WKV + SZ_WKV, SZ_H = al4k(size_t(MR) * D * 2);
constexpr size_t OFF_SCR = OFF_H + SZ_H;
constexpr size_t OFF_U = OFF_SCR, SZ_U = al4k(size_t(MR) * FF * 2);
constexpr size_t OFF_QO = OFF_SCR, SZ_QO = al4k(size_t(MR) * D * 2);
constexpr size_t OFF_KA = OFF_QO + SZ_QO, SZ_KA = al4k(size_t(NB) * KROWS * 256 * 2 + 65536);
constexpr size_t OFF_VA = OFF_KA + SZ_KA;
constexpr size_t OFF_KI = OFF_VA + SZ_KA, SZ_KI = al4k(size_t(NB) * KROWS * 64 * 2 + 65536);
constexpr size_t OFF_QI = OFF_KI + SZ_KI, SZ_QI = al4k(size_t(MR) * 512 * 2);
constexpr size_t OFF_WI = OFF_QI + SZ_QI, SZ_WI = al4k(size_t(MR) * 8 * 4);
constexpr size_t OFF_MASK = OFF_WI + SZ_WI, SZ_MASK = al4k(size_t(M) * NWORDS * 4);
constexpr size_t OFF_LF = OFF_MASK + SZ_MASK, SZ_LF = al4k(size_t(MR) * 16 * 4);
constexpr size_t OFF_UM = OFF_U + size_t(M) * FF * 2;
constexpr size_t OFF_W28 = OFF_W2B, SZ_W28 = size_t(D) * FF;
constexpr size_t OFF_W18 = OFF_W1B;
static_assert(OFF_LF + SZ_LF <= OFF_U + SZ_U && OFF_UM + size_t(16) * FF * 2 <= OFF_U + SZ_U && 4 * SZ_W28 <= 2 * SZ_W2, "mixer scratch / hidden / fp8 W2 fit");
constexpr size_t OFF_X = OFF_SCR + SZ_U;
constexpr size_t SZ_WIN = al4k(size_t(WIN_ROWS) * D * 2);
constexpr size_t OFF_WIN = OFF_X;
constexpr size_t OFF_WOA = OFF_WIN + 2 * SZ_WIN;
constexpr size_t OFF_W1A = OFF_WOA + 2 * SZ_SQ;
constexpr size_t OFF_W2A = OFF_W1A + 2 * SZ_W1;
constexpr size_t OFF_KB = OFF_X, SZ_KB = al4k(size_t(NB) * KROWS * D * 2 + 262144);
constexpr size_t OFF_VB = OFF_KB + SZ_KB;
constexpr size_t OFF_NB = OFF_VB + SZ_KB, SZ_NB = al4k(size_t(NB) * 16 * KROWS * 4);
constexpr size_t WS_END = OFF_NB + SZ_NB;
constexpr size_t SZ_H8 = size_t(M) * D, OFF_H8A = OFF_X + (size_t(48) << 20), OFF_H8B = OFF_SCR + (size_t(160) << 20);
constexpr size_t SZ_WIN8 = size_t(2048) * D, OFF_WIN8 = OFF_H8A + SZ_H8;
constexpr size_t OFF_WQKV8 = WS_END;
constexpr size_t OFF_HQ = OFF_SCR + (size_t(192) << 20);
constexpr int EPI_RS_OFF = 132 * 1024;
constexpr int CW_CS = 12288;
constexpr float QA = 127.f / 5.f, QW1 = 127.f * 32.f / 4.5f, QU = 255.f / 24.f, QW2 = 127.f * 64.f / 4.f, SQRT_QU = 3.2596012026f;
constexpr float IN_F8S = 32.f;
static_assert(OFF_W2A + 2 * SZ_W2 <= OFF_H8A && OFF_WIN8 + 2 * SZ_WIN8 <= WS_END && OFF_LF + SZ_LF <= OFF_H8B && size_t(M) * FF <= (size_t(160) << 20) && OFF_H8B + SZ_H8 <= OFF_HQ && OFF_HQ + SZ_H8 <= OFF_UM && OFF_WQKV8 + size_t(4096) * D <= (size_t(512) << 20), "8-bit buffers fit");
static_assert(OFF_W2A + 2 * SZ_W2 <= WS_END, "A weights fit in region X");
static_assert(WS_END <= (size_t(512) << 20), "d_ws map fits 512 MiB");

#define GAS __attribute__((address_space(1)))
#define LAS __attribute__((address_space(3)))
__device__ __forceinline__ unsigned f2bf(float f) { unsigned u = __builtin_bit_cast(unsigned, f); return (u + 0x7fffu + ((u >> 16) & 1u)) >> 16; }
__device__ __forceinline__ float bf2f(unsigned h) { return __builtin_bit_cast(float, h << 16); }
__device__ __forceinline__ unsigned pk2(float lo, float hi) { return f2bf(lo) | (f2bf(hi) << 16); }
typedef unsigned u32x2 __attribute__((ext_vector_type(2)));
__device__ __forceinline__ size_t blk8(int R, int c, int rowlen) { return ((size_t)(R >> 4) * (rowlen / 32) + (c >> 5)) * 512 + (R & 15) * 32 + (c & 31); }
typedef int i32x4v __attribute__((ext_vector_type(4)));
__device__ __forceinline__ unsigned pk4_fp8(float a, float b, float c, float d) {
    a = fminf(fmaxf(a, -448.f), 448.f); b = fminf(fmaxf(b, -448.f), 448.f); c = fminf(fmaxf(c, -448.f), 448.f); d = fminf(fmaxf(d, -448.f), 448.f);
    int p = __builtin_amdgcn_cvt_pk_fp8_f32(a, b, 0, false); p = __builtin_amdgcn_cvt_pk_fp8_f32(c, d, p, true); return (unsigned)p; }
__device__ __forceinline__ unsigned pk4_i8(float a, float b, float c, float d) {
    a += 128.f; b += 128.f; c += 128.f; d += 128.f;
    int p = __builtin_amdgcn_cvt_pk_u8_f32(a, 0, 0); p = __builtin_amdgcn_cvt_pk_u8_f32(b, 1, p); p = __builtin_amdgcn_cvt_pk_u8_f32(c, 2, p); p = __builtin_amdgcn_cvt_pk_u8_f32(d, 3, p);
    return (unsigned)p ^ 0x80808080u; }
__device__ __forceinline__ float red16(float v) { v += __shfl_xor(v, 1); v += __shfl_xor(v, 2); v += __shfl_xor(v, 4); v += __shfl_xor(v, 8); return v; }
__device__ __forceinline__ float wave_sum(float v) {
#pragma unroll
    for (int o = 1; o < 64; o <<= 1) v += __shfl_xor(v, o);
    return v;
}
__device__ __forceinline__ float wave_max(float v) {
#pragma unroll
    for (int o = 1; o < 64; o <<= 1) v = fmaxf(v, __shfl_xor(v, o));
    return v;
}

struct Ptrs {
    const float* in[17]; float* out; unsigned char* ws;
};
#define WSP(T, off) ((T*)(P.ws + (off)))
__device__ __forceinline__ bf16* w1_t(const Ptrs& P, int l) { return l < 2 ? WSP(bf16, OFF_W1A + l * SZ_W1) : WSP(bf16, OFF_W1B + (l - 2) * SZ_W1); }
__device__ __forceinline__ bf16* w2_t(const Ptrs& P, int l) { return l < 2 ? WSP(bf16, OFF_W2A + l * SZ_W2) : WSP(bf16, OFF_W2B + (l - 2) * SZ_W2); }
__device__ __forceinline__ bf16* wo_t(const Ptrs& P, int l) { return l < 2 ? WSP(bf16, OFF_WOA + l * SZ_SQ) : WSP(bf16, OFF_WOB + (l - 2) * SZ_SQ); }
__device__ __forceinline__ float* ssq_p(const Ptrs& P, int k) { return WSP(float, OFF_SSQ + (size_t)(k & 1) * SZ_SSQ1); }

struct MatDesc { const float* W; int pitch, K, col0, ncols, nblk; const float* gain; bf16* WT; int dst0, perm; unsigned char* WT8; float s8; int q8; int* cs; };
__device__ __forceinline__ bool get_mat(const Ptrs& P, int id, MatDesc& d) {
    d.gain = nullptr; d.perm = 0; d.dst0 = 0; d.col0 = 0; d.WT8 = nullptr; d.s8 = IN_F8S; d.q8 = 0; d.cs = nullptr;
    if (id < 2) { d.W = P.in[6] + (size_t)id * D * 2120; d.pitch = 2120; d.K = D; d.ncols = 2048; d.nblk = 64; d.gain = P.in[2] + id * D; d.WT = WSP(bf16, OFF_WIN + id * SZ_WIN); d.perm = 1; d.WT8 = WSP(unsigned char, OFF_WIN8 + id * SZ_WIN8); return true; }
    if (id < 4) { const int l = id - 2; d.W = P.in[6] + (size_t)l * D * 2120; d.pitch = 2120; d.K = D; d.col0 = 2048; d.ncols = 72; d.nblk = 3; d.gain = P.in[2] + l * D; d.WT = WSP(bf16, OFF_WIN + l * SZ_WIN); d.dst0 = 2048; return true; }
    if (id < 6) { const int l = id - 4; d.W = P.in[9] + (size_t)l * D * D; d.pitch = D; d.K = D; d.ncols = D; d.nblk = 32; d.WT = WSP(bf16, OFF_WOA + l * SZ_SQ); return true; }
    if (id < 10) { const int l = id - 6; d.W = P.in[4] + (size_t)l * D * FF; d.pitch = FF; d.K = D; d.ncols = FF; d.nblk = 128; d.gain = P.in[3] + l * D; d.WT = l < 2 ? w1_t(P, l) : nullptr; d.WT8 = WSP(unsigned char, OFF_W18 + l * SZ_W28); d.s8 = QW1; d.q8 = 1; return true; }
    if (id < 14) { const int l = id - 10; d.W = P.in[5] + (size_t)l * FF * D; d.pitch = D; d.K = FF; d.ncols = D; d.nblk = 32; d.WT = l < 2 ? w2_t(P, l) : nullptr; d.WT8 = WSP(unsigned char, OFF_W28 + l * SZ_W28); d.s8 = QW2; d.q8 = 1; return true; }
    if (id == 14) { d.W = P.in[11]; d.pitch = 2064; d.K = D; d.col0 = 0; d.ncols = 1024; d.nblk = 32; d.gain = P.in[10]; d.WT = WSP(bf16, OFF_WKV); d.perm = 1; d.WT8 = WSP(unsigned char, OFF_WQKV8 + size_t(1024) * D); return true; }
    if (id == 15) { d.W = P.in[11]; d.pitch = 2064; d.K = D; d.col0 = 1024; d.ncols = 1024; d.nblk = 32; d.gain = P.in[10]; d.WT = WSP(bf16, OFF_WKV); d.perm = 1; d.dst0 = 1024; d.WT8 = WSP(unsigned char, OFF_WQKV8 + size_t(1024) * D); return true; }
    if (id == 16) { d.W = P.in[11]; d.pitch = 2064; d.K = D; d.col0 = 2048; d.ncols = 16; d.nblk = 1; d.gain = P.in[10]; d.WT = WSP(bf16, OFF_WKV); d.dst0 = 2048; return true; }
    if (id < 19) { const int j = id - 17; d.W = P.in[14] + (size_t)j * D * D; d.pitch = D; d.K = D; d.ncols = D; d.nblk = 32; d.gain = P.in[2] + (2 + j) * D; d.WT = WSP(bf16, j == 0 ? OFF_WQ0 : OFF_WQ1); d.perm = 1; d.WT8 = WSP(unsigned char, OFF_WQKV8 + (j == 0 ? 0 : size_t(3072) * D)); return true; }
    if (id < 21) { const int j = id - 19; d.W = P.in[16] + (size_t)j * D * D; d.pitch = D; d.K = D; d.ncols = D; d.nblk = 32; d.WT = WSP(bf16, OFF_WOB + j * SZ_SQ); return true; }
    return false;
}
constexpr int NMAT = 21;
__device__ __forceinline__ void transpose_block(const MatDesc& d, int item, float* scr, int lane) {
    const int nb64 = (d.nblk + 1) >> 1, kb = item / nb64, nb = item % nb64, k0 = 64 * kb, n0 = 64 * nb;
    const int c4 = lane & 15; const bool okc = (n0 + 4 * c4) < d.ncols;
#pragma unroll 8
    for (int i = 0; i < 16; ++i) { const int kk = 4 * i + (lane >> 4);
        f32x4 v = okc ? *(const f32x4*)(d.W + (size_t)(k0 + kk) * d.pitch + d.col0 + n0 + 4 * c4) : (f32x4){0.f, 0.f, 0.f, 0.f};
        if (d.gain) v = v * d.gain[k0 + kk];
        float* sp = scr + kk * 65 + 4 * c4; sp[0] = v[0]; sp[1] = v[1]; sp[2] = v[2]; sp[3] = v[3]; }
    __builtin_amdgcn_s_waitcnt(0xc07f); asm volatile("" ::: "memory");
    const int c = lane & 7;
#pragma unroll
    for (int hb = 0; hb < 2; ++hb) {
        const int nn0 = n0 + 32 * hb; if (nn0 >= 32 * d.nblk) break;
        int drow0;
        if (d.perm) { const int pn = nn0 >> 8, wc = (nn0 & 255) >> 6, bj = (nn0 & 63) >> 5; drow0 = d.dst0 + 256 * pn + 128 * bj + 32 * wc; }
        else drow0 = d.dst0 + nn0;
#pragma unroll
        for (int j = 0; j < 4; ++j) { const int n = (lane >> 3) + 8 * j; const float* sq = scr + (8 * c) * 65 + 32 * hb + n;
            u32x4 o; o.x = pk2(sq[0 * 65], sq[1 * 65]); o.y = pk2(sq[2 * 65], sq[3 * 65]); o.z = pk2(sq[4 * 65], sq[5 * 65]); o.w = pk2(sq[6 * 65], sq[7 * 65]);
            if (d.WT) *(u32x4*)(d.WT + (size_t)(drow0 + n) * d.K + k0 + 8 * c) = o;
            if (d.WT8) { u32x2 o8;
                if (d.q8) { o8.x = pk4_i8(sq[0 * 65] * d.s8, sq[1 * 65] * d.s8, sq[2 * 65] * d.s8, sq[3 * 65] * d.s8); o8.y = pk4_i8(sq[4 * 65] * d.s8, sq[5 * 65] * d.s8, sq[6 * 65] * d.s8, sq[7 * 65] * d.s8); }
                else { o8.x = pk4_fp8(sq[0 * 65] * d.s8, sq[1 * 65] * d.s8, sq[2 * 65] * d.s8, sq[3 * 65] * d.s8); o8.y = pk4_fp8(sq[4 * 65] * d.s8, sq[5 * 65] * d.s8, sq[6 * 65] * d.s8, sq[7 * 65] * d.s8); }
                *(u32x2*)(d.WT8 + (size_t)(drow0 + n) * d.K + k0 + 8 * c) = o8; } }
    }
    __builtin_amdgcn_s_waitcnt(0xc07f); asm volatile("" ::: "memory");
}
__device__ __forceinline__ void prologue_work(const Ptrs& P, int gw, int ngw, float* scr, int lane) {
    int base = 0;
    for (int id = 0; id < NMAT; ++id) {
        MatDesc d; get_mat(P, id, d);
        const int nit = (d.K / 64) * ((d.nblk + 1) >> 1);
        int first = (gw - base % ngw + ngw) % ngw;
        for (int it = first; it < nit; it += ngw) transpose_block(d, it, scr, lane);
        base += nit;
    }
    bf16* H = WSP(bf16, OFF_H); float* ssq0 = ssq_p(P, 0);
    for (int r = gw; r < MR; r += ngw) {
        const float* src = r < M ? P.in[0] + (size_t)r * D : P.in[1] + (size_t)(r - M) * D;
        float s = 0.f;
#pragma unroll
        for (int j = 0; j < 4; ++j) { const f32x4 v = *(const f32x4*)(src + 256 * j + 4 * lane); s += v.x * v.x + v.y * v.y + v.z * v.z + v.w * v.w;
            uint2 o; o.x = pk2(v.x, v.y); o.y = pk2(v.z, v.w); *(uint2*)(H + (size_t)r * D + 256 * j + 4 * lane) = o;
            if (r < M) *(unsigned*)(WSP(unsigned char, OFF_H8A) + blk8(r, 256 * j + 4 * lane, D)) = pk4_fp8(v.x, v.y, v.z, v.w); }
        s = wave_sum(s); if (lane < 16) ssq0[(size_t)r * 16 + lane] = lane == 0 ? s : 0.f;
    }
    if (gw == 0) { float* GT = WSP(float, OFF_GT);
        for (int e = lane; e < GT_N; e += 64) { float v;
            if (e < GT_AKG) v = P.in[7][e]; else if (e < GT_KFB) v = P.in[8][e - GT_AKG]; else if (e < GT_KKG) v = P.in[12][e - GT_KFB]; else if (e < GT_BQG) v = P.in[13][e - GT_KKG]; else v = P.in[15][e - GT_BQG];
            GT[e] = v; }
        { float gq = 0.f, gk = 0.f;
          for (int e = lane; e < 128; e += 64) gq = fmaxf(gq, fabsf(P.in[15][e]));
          gk = fabsf(P.in[13][lane]);
          gq = wave_max(gq); gk = wave_max(gk);
          if (lane == 0) GT[GT_SKIP] = 2.0f * 64.0f * C2 * gq * gk + 24.0f; } }
    float* COS = WSP(float, OFF_ROPE); float* SIN = COS + NPOS * 32;
    for (int e = gw * 64 + lane; e < NPOS * 32; e += ngw * 64) { const int pos = e >> 5, i = e & 31;
        const float inv = 1.0f / powf(10000.0f, (float)(2 * i) / 64.0f); const float ang = (float)pos * inv;
        COS[e] = (float)cos((double)ang); SIN[e] = (float)sin((double)ang); }
}
__device__ __forceinline__ void zero_pads(const Ptrs& P, int gw, int ngw, int lane) {
    bf16* KA = WSP(bf16, OFF_KA); bf16* VA = WSP(bf16, OFF_VA); bf16* KI = WSP(bf16, OFF_KI);
    unsigned zz = 0u; asm volatile("" : "+v"(zz));
    for (int e = gw * 64 + lane; e < NB * 48 * 32; e += ngw * 64) { const int b = e / (48 * 32), r = (e / 32) % 48 + 16, c = e % 32;
        const u32x4 z = {zz, zz, zz, zz};
        *(u32x4*)(KA + ((size_t)b * KROWS + r) * 256 + c * 8) = z; *(u32x4*)(VA + ((size_t)b * KROWS + r) * 256 + c * 8) = z;
        if (c < 8) *(u32x4*)(KI + ((size_t)b * KROWS + r) * 64 + c * 8) = z; }
}
__device__ __forceinline__ void colsum_job(const Ptrs& P, int j, int lane) {
    const u32x4* src = (const u32x4*)(WSP(unsigned char, OFF_W28) + (size_t)j * FF); int t = 0;
#pragma unroll
    for (int i = 0; i < 4; ++i) { const u32x4 v = src[i * 64 + lane];
        t = __builtin_amdgcn_sdot4((int)v.x, 0x01010101, t, false); t = __builtin_amdgcn_sdot4((int)v.y, 0x01010101, t, false); t = __builtin_amdgcn_sdot4((int)v.z, 0x01010101, t, false); t = __builtin_amdgcn_sdot4((int)v.w, 0x01010101, t, false); }
#pragma unroll
    for (int o = 1; o < 64; o <<= 1) t += __shfl_xor(t, o);
    if (lane == 0) ((int*)(P.ws + OFF_CTL) + CW_CS)[j] = t;
}
template <int NCT>
__device__ __forceinline__ bool strip_mma(const bf16* A, int lda, const bf16* Bt, const int* brow, int K, f32x4 (&acc)[NCT], int lane, int ks = 1, int wave = 0, float* red = nullptr) {
    const int fr = lane & 15, fq = lane >> 4;
    const int kb = ks == 1 ? 0 : wave * (K / 8), ke = ks == 1 ? K : kb + K / 8;
    const bf16* ap = A + (size_t)fr * lda + 8 * fq;
    const bf16* bp[NCT];
#pragma unroll
    for (int j = 0; j < NCT; ++j) { bp[j] = Bt + (size_t)(brow[j] + fr) * K + 8 * fq; acc[j] = (f32x4){0.f, 0.f, 0.f, 0.f}; }
    bf16x8 ca[2], cb[2][NCT], na[2], nb[2][NCT];
#define SM_LOAD(da, db, k0_) do { _Pragma("unroll") for (int h_ = 0; h_ < 2; ++h_) { da[h_] = *(const bf16x8*)(ap + (k0_) + 32 * h_); \
        _Pragma("unroll") for (int j_ = 0; j_ < NCT; ++j_) db[h_][j_] = *(const bf16x8*)(bp[j_] + (k0_) + 32 * h_); } } while (0)
    SM_LOAD(ca, cb, kb);
#pragma unroll 1
    for (int k0 = kb; k0 < ke; k0 += 64) {
        const int kn = k0 + 64 < ke ? k0 + 64 : k0;
        SM_LOAD(na, nb, kn);
#pragma unroll
        for (int h = 0; h < 2; ++h)
#pragma unroll
            for (int j = 0; j < NCT; ++j) acc[j] = __builtin_amdgcn_mfma_f32_16x16x32_bf16(ca[h], cb[h][j], acc[j], 0, 0, 0);
#pragma unroll
        for (int h = 0; h < 2; ++h) { ca[h] = na[h];
#pragma unroll
            for (int j = 0; j < NCT; ++j) cb[h][j] = nb[h][j]; }
    }
#undef SM_LOAD
    if (ks == 1) return true;
#pragma unroll
    for (int j = 0; j < NCT; ++j)
#pragma unroll
        for (int r = 0; r < 4; ++r) red[(wave * NCT * 4 + j * 4 + r) * 64 + lane] = acc[j][r];
    __syncthreads();
    if (wave == 0) {
#pragma unroll
        for (int j = 0; j < NCT; ++j)
#pragma unroll
            for (int r = 0; r < 4; ++r) { float t = 0.f;
#pragma unroll
                for (int w = 0; w < 8; ++w) t += red[(w * NCT * 4 + j * 4 + r) * 64 + lane];
                acc[j][r] = t; }
    }
    __syncthreads();
    return wave == 0;
}
__device__ __forceinline__ int row_pos(int R) { return R < M ? (R & (S - 1)) + NMETA : R - M; }
__device__ __forceinline__ float row_scale(const float* ssq, int R) {
    const f32x4* p = (const f32x4*)(ssq + (size_t)R * 16); const f32x4 a = p[0], b = p[1], c = p[2], d = p[3];
    const float t = ((a.x + a.y) + (a.z + a.w)) + ((b.x + b.y) + (b.z + b.w)) + ((c.x + c.y) + (c.z + c.w)) + ((d.x + d.y) + (d.z + d.w));
    return rsqrtf(t * (1.0f / D) + EPS);
}

__device__ __forceinline__ size_t ki_off(size_t grow, int d) { return (grow >> 4) * 1024 + (size_t)((d >> 5) * 512 + ((d >> 3) & 3) * 128 + (int)(grow & 15) * 8 + (d & 7)); }
__device__ __forceinline__ void store_ki(bf16* KI, int R, int d, unsigned v) {
    if (R < M) { const int b = R >> 11, i = R & (S - 1); KI[ki_off((size_t)b * KROWS + PRE + i, d)] = (bf16)v; }
    else { const int j = R - M;
#pragma unroll 4
        for (int b = 0; b < NB; ++b) KI[ki_off((size_t)b * KROWS + j, d)] = (bf16)v; }
}
struct HeadEpi { bf16* dst; int ldd, col0; const float* gain; int norm, rope, kvmap; float scale; const float* ssq; };
__device__ __forceinline__ void store_mapped(bf16* dst, int ldd, int R, int col, unsigned v, int kvmap) {
    if (!kvmap) { dst[(size_t)R * ldd + col] = (bf16)v; return; }
    if (R < M) { const int b = R >> 11, i = R & (S - 1); dst[((size_t)b * KROWS + PRE + i) * ldd + col] = (bf16)v; }
    else { const int j = R - M;
#pragma unroll 4
        for (int b = 0; b < NB; ++b) dst[((size_t)b * KROWS + j) * ldd + col] = (bf16)v; }
}
__device__ __forceinline__ void epi_head(const Ptrs& P, const HeadEpi& E, const f32x4 (&acc)[4], int R0, int lane) {
    const int fr = lane & 15, fq = lane >> 4;
    const float* COS = WSP(float, OFF_ROPE); const float* SIN = COS + NPOS * 32;
#pragma unroll
    for (int reg = 0; reg < 4; ++reg) {
        const int R = R0 + 4 * fq + reg; const float rr = row_scale(E.ssq, R);
        float x[4];
#pragma unroll
        for (int j = 0; j < 4; ++j) x[j] = acc[j][reg] * rr;
        if (E.norm) { float ss = x[0] * x[0] + x[1] * x[1] + x[2] * x[2] + x[3] * x[3]; ss = red16(ss); const float rn = rsqrtf(ss * (1.0f / 64.0f) + EPS);
#pragma unroll
            for (int j = 0; j < 4; ++j) x[j] *= rn * E.gain[16 * j + fr]; }
        if (E.rope) { const int pos = row_pos(R);
#pragma unroll
            for (int j = 0; j < 2; ++j) { const float c = COS[pos * 32 + 16 * j + fr], s = SIN[pos * 32 + 16 * j + fr]; const float a = x[j], b = x[j + 2]; x[j] = a * c - b * s; x[j + 2] = a * s + b * c; } }
#pragma unroll
        for (int j = 0; j < 4; ++j) store_mapped(E.dst, E.ldd, R, E.col0 + 16 * j + fr, f2bf(x[j] * E.scale), E.kvmap);
    }
}
enum { SP_INA = 0, SP_RES_O = 1, SP_MLP1 = 2, SP_RES_M = 3, SP_QKVB = 4, SP_QB = 5 };
__device__ __forceinline__ int strips_of(int ph) { return ph == SP_INA ? 33 : ph == SP_RES_O ? 16 : ph == SP_MLP1 ? 64 : ph == SP_RES_M ? 16 : ph == SP_QKVB ? 49 : 16; }
__device__ __forceinline__ void perm_rows(int base, int pn, int wc, int* brow) { const int b0 = base + 256 * pn + 32 * wc; brow[0] = b0; brow[1] = b0 + 16; brow[2] = b0 + 128; brow[3] = b0 + 144; }

__device__ __forceinline__ void strip_job(const Ptrs& P, int ph, int l, int rg, int s, int lane, int ks = 1, int wave = 0, float* red = nullptr) {
    asm volatile("" : "+s"(rg), "+s"(s), "+v"(lane));
    const int R0 = rg * 16; const int fr = lane & 15, fq = lane >> 4;
    bf16* H = WSP(bf16, OFF_H); bf16* QO = WSP(bf16, OFF_QO); bf16* UM = WSP(bf16, OFF_UM);
    int brow[5];
    if (ph == SP_INA) {
        const bf16* Bt = WSP(bf16, OFF_WIN + l * SZ_WIN); const float* ssq = ssq_p(P, 2 * l);
        if (s < 32) {
            f32x4 acc[4]; HeadEpi E; E.ssq = ssq; E.kvmap = 0; E.norm = 1; E.rope = 1; E.scale = 1.f; E.gain = nullptr;
            if (s < 16) { perm_rows(0, s >> 2, s & 3, brow); E.dst = QO; E.ldd = D; E.col0 = 64 * s; E.gain = WSP(float, OFF_GT) + GT_AQG + l * 64; E.scale = C2; }
            else if (s < 20) { const int kh = s - 16; perm_rows(0, 4, kh, brow); E.dst = WSP(bf16, OFF_KA); E.ldd = 256; E.col0 = 64 * kh; E.gain = WSP(float, OFF_GT) + GT_AKG + l * 64; E.kvmap = 1; }
            else if (s < 24) { const int vh = s - 20; perm_rows(0, 5, vh, brow); E.dst = WSP(bf16, OFF_VA); E.ldd = 256; E.col0 = 64 * vh; E.norm = 0; E.rope = 0; E.kvmap = 1; }
            else { const int qh = s - 24; perm_rows(0, 6 + (qh >> 2), qh & 3, brow); E.dst = WSP(bf16, OFF_QI); E.ldd = 512; E.col0 = 64 * qh; E.norm = 0; }
            if (strip_mma<4>(H + (size_t)R0 * D, D, Bt, brow, D, acc, lane, ks, wave, red))
            epi_head(P, E, acc, R0, lane);
        } else {
            f32x4 acc[5];
#pragma unroll
            for (int j = 0; j < 5; ++j) brow[j] = 2048 + 16 * j;
            if (!strip_mma<5>(H + (size_t)R0 * D, D, Bt, brow, D, acc, lane, ks, wave, red)) return;
            const float* COS = WSP(float, OFF_ROPE); const float* SIN = COS + NPOS * 32; bf16* KI = WSP(bf16, OFF_KI); float* WI = WSP(float, OFF_WI);
#pragma unroll
            for (int reg = 0; reg < 4; ++reg) { const int R = R0 + 4 * fq + reg; const float rr = row_scale(ssq, R); const int pos = row_pos(R);
                float x[4];
#pragma unroll
                for (int j = 0; j < 4; ++j) x[j] = acc[j][reg] * rr;
#pragma unroll
                for (int j = 0; j < 2; ++j) { const float c = COS[pos * 32 + 16 * j + fr], sn = SIN[pos * 32 + 16 * j + fr]; const float a = x[j], b = x[j + 2]; x[j] = a * c - b * sn; x[j + 2] = a * sn + b * c; }
#pragma unroll
                for (int j = 0; j < 4; ++j) store_ki(KI, R, 16 * j + fr, f2bf(x[j]));
                if (fr < 8) WI[(size_t)R * 8 + fr] = acc[4][reg] * rr * 0.044194173824159216f; }
        }
    } else if (ph == SP_RES_O || ph == SP_RES_M) {
        const bool mlp = ph == SP_RES_M; const int K = mlp ? FF : D;
        const bf16* A = mlp ? UM + (size_t)(R0 - M) * FF : QO + (size_t)R0 * D; const bf16* Bt = mlp ? w2_t(P, l) : wo_t(P, l);
        float* ssqn = ssq_p(P, 2 * l + (mlp ? 2 : 1)); const bool last = mlp && l == 3; const float* ssqm = ssq_p(P, 2 * l + 1);
        f32x4 acc[4];
#pragma unroll
        for (int j = 0; j < 4; ++j) brow[j] = 64 * s + 16 * j;
        if (!strip_mma<4>(A, K, Bt, brow, K, acc, lane, ks, wave, red)) return;
#pragma unroll
        for (int reg = 0; reg < 4; ++reg) { const int R = R0 + 4 * fq + reg; float sq = 0.f; float r2 = 1.f; if (mlp) { const float rr = row_scale(ssqm, R); r2 = rr * rr; }
#pragma unroll
            for (int j = 0; j < 4; ++j) { const int col = 64 * s + 16 * j + fr; const float hv = bf2f(H[(size_t)R * D + col]) + acc[j][reg] * r2; H[(size_t)R * D + col] = (bf16)f2bf(hv); sq += hv * hv;
                if (last && R < M) P.out[(size_t)R * D + col] = hv; }
            sq = red16(sq); if (fr == 0) ssqn[(size_t)R * 16 + s] = sq; }
    } else if (ph == SP_MLP1) {
        f32x4 acc[4];
#pragma unroll
        for (int j = 0; j < 4; ++j) brow[j] = 64 * s + 16 * j;
        if (!strip_mma<4>(H + (size_t)R0 * D, D, w1_t(P, l), brow, D, acc, lane, ks, wave, red)) return;
#pragma unroll
        for (int reg = 0; reg < 4; ++reg) { const int R = R0 + 4 * fq + reg;
#pragma unroll
            for (int j = 0; j < 4; ++j) { const float v = fmaxf(acc[j][reg], 0.f); UM[(size_t)(R - M) * FF + 64 * s + 16 * j + fr] = (bf16)f2bf(v * v); } }
    } else {
        const int jb = l - 2; const float* ssq = ssq_p(P, 2 * l);
        if (s < 48) {
            f32x4 acc[4]; HeadEpi E; E.ssq = ssq; E.rope = 0; E.norm = 1; E.kvmap = 0; E.scale = 1.f; const bf16* Bt;
            if (s < 16) { Bt = WSP(bf16, jb == 0 ? OFF_WQ0 : OFF_WQ1); perm_rows(0, s >> 2, s & 3, brow); E.dst = QO; E.ldd = D; E.col0 = 64 * s; E.gain = WSP(float, OFF_GT) + GT_BQG + jb * 64; E.scale = C2; }
            else if (s < 32) { const int kh = s - 16; Bt = WSP(bf16, OFF_WKV); perm_rows(0, kh >> 2, kh & 3, brow); E.dst = WSP(bf16, OFF_KB); E.ldd = D; E.col0 = 64 * kh; E.gain = WSP(float, OFF_GT) + GT_KKG; E.kvmap = 1; }
            else { const int vh = s - 32; Bt = WSP(bf16, OFF_WKV); perm_rows(1024, vh >> 2, vh & 3, brow); E.dst = WSP(bf16, OFF_VB); E.ldd = D; E.col0 = 64 * vh; E.norm = 0; E.gain = nullptr; E.kvmap = 1; }
            if (strip_mma<4>(H + (size_t)R0 * D, D, Bt, brow, D, acc, lane, ks, wave, red))
            epi_head(P, E, acc, R0, lane);
        } else {
            f32x4 acc[1]; brow[0] = 2048;
            if (!strip_mma<1>(H + (size_t)R0 * D, D, WSP(bf16, OFF_WKV), brow, D, acc, lane, ks, wave, red)) return;
            float* LF = WSP(float, OFF_LF); const float bias = WSP(float, OFF_GT)[GT_KFB + fr];
#pragma unroll
            for (int reg = 0; reg < 4; ++reg) { const int R = R0 + 4 * fq + reg; const float z = acc[0][reg] * row_scale(ssq, R) + bias;
                LF[(size_t)R * 16 + fr] = fminf(z, 0.f) - log1pf(expf(-fabsf(z))); }
        }
    }
}
__device__ __forceinline__ unsigned okey(float f) { const unsigned u = __builtin_bit_cast(unsigned, f); return (u & 0x80000000u) ? ~u : (u | 0x80000000u); }
__device__ __forceinline__ unsigned half_sum(unsigned v) {
    v += __shfl_xor(v, 1); v += __shfl_xor(v, 2); v += __shfl_xor(v, 4); v += __shfl_xor(v, 8); v += __shfl_xor(v, 16); return v;
}
constexpr int NKT = 65;
constexpr int IDX_LDS_PER_WAVE = NKT * 64 * 4;
__device__ __forceinline__ float swap16_sum(float x) {
    auto s2 = __builtin_amdgcn_permlane16_swap(__float_as_uint(x), __float_as_uint(x), false, false);
    return __uint_as_float(s2[0]) + __uint_as_float(s2[1]);
}
template <int CTRL> __device__ __forceinline__ unsigned dppu(unsigned x) { return (unsigned)__builtin_amdgcn_mov_dpp((int)x, CTRL, 0xf, 0xf, true); }
__device__ __forceinline__ unsigned half_sum_dpp(unsigned v) {
    v += dppu<0xB1>(v); v += dppu<0x4E>(v); v += dppu<0x141>(v); v += dppu<0x128>(v);
    auto s2 = __builtin_amdgcn_permlane16_swap(v, v, false, false);
    return s2[0] + s2[1];
}
__device__ __forceinline__ void count4_ge(unsigned& cnt, unsigned a, unsigned b, unsigned c4, unsigned d, unsigned c) {
    asm volatile("v_cmp_ge_u32_e64 s[20:21], %1, %5\n\tv_cmp_ge_u32_e64 s[22:23], %2, %5\n\tv_cmp_ge_u32_e64 s[24:25], %3, %5\n\tv_cmp_ge_u32_e64 s[26:27], %4, %5\n\t"
                 "v_addc_co_u32_e64 %0, s[20:21], %0, 0, s[20:21]\n\tv_addc_co_u32_e64 %0, s[22:23], %0, 0, s[22:23]\n\tv_addc_co_u32_e64 %0, s[24:25], %0, 0, s[24:25]\n\tv_addc_co_u32_e64 %0, s[26:27], %0, 0, s[26:27]"
                 : "+v"(cnt) : "v"(a), "v"(b), "v"(c4), "v"(d), "v"(c) : "s20", "s21", "s22", "s23", "s24", "s25", "s26", "s27");
}
__device__ __forceinline__ void indexer_pass(const Ptrs& P, int b, int g2, int lane, LAS unsigned* stg  , int dry = 0  ) {
    const bf16* QI = WSP(bf16, OFF_QI); const bf16* KI = WSP(bf16, OFF_KI) + (size_t)b * KROWS * 64; const float* WI = WSP(float, OFF_WI);
    unsigned* MASK = WSP(unsigned, OFF_MASK);
    const int i0 = 2 * g2, n = lane & 31, gg = lane >> 5, fr = lane & 15, fq = lane >> 4;
    const size_t row0 = (size_t)b * S + i0;
    const int ntile = 2 + ((i0 + 1) >> 5);
    const unsigned lt = (1u << n) - 1u;
    const __amdgpu_buffer_rsrc_t krs = __builtin_amdgcn_make_buffer_rsrc((void*)KI, 0, KROWS * 128, 0x00020000);
    const int iq = i0 + gg;
    bf16x8 af[2];
    { const bf16* qp = QI + (row0 + (fr >> 3)) * 512 + (fr & 7) * 64 + 8 * fq;
      af[0] = *(const bf16x8*)(qp); af[1] = *(const bf16x8*)(qp + 32); }
    const f32x4 w4 = *(const f32x4*)(WI + (row0 + (fq >> 1)) * 8 + 4 * (fq & 1));
    const unsigned loff = (unsigned)(16 * lane);
    bf16x8 b0[2][2], b1[2][2], b2[2][2], b3[2][2];
#define IDX_TBASE(t_) (((t_) == 0 ? 0 : PRE + 32 * ((t_) - 1)) * 128)
#define IDX_LOADB(dst, t_) do { const int tt_ = (t_) < ntile ? (t_) : ntile - 1; const int bo_ = IDX_TBASE(tt_); _Pragma("unroll") for (int u_ = 0; u_ < 2; ++u_) _Pragma("unroll") for (int ks_ = 0; ks_ < 2; ++ks_) \
        dst[u_][ks_] = __builtin_bit_cast(bf16x8, __builtin_amdgcn_raw_buffer_load_b128(krs, loff + 2048 * u_ + 1024 * ks_, bo_, 0)); } while (0)
#define IDX_TILE(bb, t_) do { float pu_[2]; \
        _Pragma("unroll") for (int u_ = 0; u_ < 2; ++u_) { f32x4 acc_ = {0.f, 0.f, 0.f, 0.f}; \
            acc_ = __builtin_amdgcn_mfma_f32_16x16x32_bf16(af[0], bb[u_][0], acc_, 0, 0, 0); acc_ = __builtin_amdgcn_mfma_f32_16x16x32_bf16(af[1], bb[u_][1], acc_, 0, 0, 0); \
            float x_ = w4[0] * __builtin_amdgcn_fmed3f(acc_[0], 0.f, 3.0e38f); x_ += w4[1] * __builtin_amdgcn_fmed3f(acc_[1], 0.f, 3.0e38f); \
            x_ += w4[2] * __builtin_amdgcn_fmed3f(acc_[2], 0.f, 3.0e38f); x_ += w4[3] * __builtin_amdgcn_fmed3f(acc_[3], 0.f, 3.0e38f); pu_[u_] = swap16_sum(x_); } \
        const float sc_ = (fq & 1) ? pu_[1] : pu_[0]; \
        const bool v_ = (t_) == 0 ? (n < NMETA) : ((32 * ((t_) - 1) + n) <= iq); \
        stg[(t_) * 64 + lane] = v_ ? okey(sc_) : 0x007FFFFFu; } while (0)
    IDX_LOADB(b0, 0); IDX_LOADB(b1, 1); IDX_LOADB(b2, 2); IDX_LOADB(b3, 3);
#pragma unroll 1
    for (int t = 0; t < ntile; t += 4) {
        const int t1 = t + 1 < ntile ? t + 1 : ntile - 1, t2 = t + 2 < ntile ? t + 2 : ntile - 1, t3 = t + 3 < ntile ? t + 3 : ntile - 1;
        IDX_TILE(b0, t); IDX_LOADB(b0, t + 4);
        IDX_TILE(b1, t1); IDX_LOADB(b1, t + 5);
        IDX_TILE(b2, t2); IDX_LOADB(b2, t + 6);
        IDX_TILE(b3, t3); IDX_LOADB(b3, t + 7);
    }
#undef IDX_LOADB
#undef IDX_TILE
#undef IDX_TBASE
    if (dry) return;
#pragma unroll 1
    for (int t = ntile; t < NKT; ++t) stg[t * 64 + lane] = 0x007FFFFFu;
    unsigned k[NKT];
#pragma unroll
    for (int T = 0; T < NKT; ++T) k[T] = stg[T * 64 + lane];
    unsigned thr = 0u; bool done = (NMETA + iq + 1) <= TOPK;
    if (done) thr = 0x00800000u;
#pragma unroll 1
    for (int bit = 31; bit >= 0; --bit) {
        if (__all(done)) break;
        const unsigned c = thr | (1u << bit);
        unsigned cnt = (k[NKT - 1] >= c) ? 1u : 0u;
#pragma unroll
        for (int T = 0; T + 3 < NKT; T += 4) count4_ge(cnt, k[T], k[T + 1], k[T + 2], k[T + 3], c);
        cnt = half_sum_dpp(cnt);
        if (!done && cnt >= (unsigned)TOPK) { thr = c; if (cnt == (unsigned)TOPK) done = true; }
    }
    const bool slow = !__all(done);
    unsigned* mp = MASK + row0 * NWORDS;
    unsigned m0 = 0u, m1 = 0u, m2 = 0u, m3 = 0u;
#define IDX_PUT(bs_, widx_) do { const unsigned lo_ = (unsigned)(bs_), hi_ = (unsigned)((bs_) >> 32);   \
        if ((widx_) < 64) asm volatile("s_nop 1\n\tv_writelane_b32 %0, %2, %4\n\tv_writelane_b32 %1, %3, %4" : "+v"(m0), "+v"(m2) : "s"(lo_), "s"(hi_), "n"((widx_) & 63)); \
        else asm volatile("s_nop 1\n\tv_writelane_b32 %0, %2, %4\n\tv_writelane_b32 %1, %3, %4" : "+v"(m1), "+v"(m3) : "s"(lo_), "s"(hi_), "n"((widx_) & 63)); } while (0)
    if (!slow) {
#pragma unroll
        for (int T = 0; T < NKT; ++T) { const unsigned long long bs = __ballot(k[T] >= thr); IDX_PUT(bs, T == 0 ? 0 : T + 1); }
    } else {
        unsigned gcnt = 0;
#pragma unroll
        for (int T = 0; T < NKT; ++T) gcnt += (k[T] > thr) ? 1u : 0u;
        gcnt = half_sum_dpp(gcnt);
        const unsigned need = done ? 0x7fffffffu : (unsigned)TOPK - gcnt;
        unsigned base = 0;
#pragma unroll
        for (int T = 0; T < NKT; ++T) {
            const bool eq = k[T] == thr;
            const unsigned long long be = __ballot(eq);
            const unsigned hh = gg ? (unsigned)(be >> 32) : (unsigned)be;
            const bool sel = (k[T] > thr) || (eq && (base + (unsigned)__builtin_popcount(hh & lt)) < need);
            base += (unsigned)__builtin_popcount(hh);
            const unsigned long long bs = __ballot(sel); IDX_PUT(bs, T == 0 ? 0 : T + 1);
            __builtin_amdgcn_sched_barrier(0);
        }
    }
#undef IDX_PUT
    mp[lane] = m0; mp[NWORDS + lane] = m2;
    if (lane < NWORDS - 64) { mp[64 + lane] = m1; mp[NWORDS + 64 + lane] = m3; }
}

template <int MODE>
__device__ __forceinline__ void attn_naive_work(const Ptrs& P, int gw, int ngw, float* sc, int lane, int row_lo, int row_hi) {
    bf16* QO = WSP(bf16, OFF_QO);
    for (int job = gw; job < (row_hi - row_lo) * 16; job += ngw) {
        const int R = row_lo + (job >> 4), h = job & 15;
        const bool meta = R >= M; const int b = meta ? 0 : R >> 11, i = R & (S - 1);
        const int kmax = meta ? (R - M) : PRE + i;
        const bf16* Kb; const bf16* Vb; int ldk;
        if (MODE == 0) { Kb = WSP(bf16, OFF_KA) + (size_t)b * KROWS * 256 + 64 * (h >> 2); Vb = WSP(bf16, OFF_VA) + (size_t)b * KROWS * 256 + 64 * (h >> 2); ldk = 256; }
        else { Kb = WSP(bf16, OFF_KB) + (size_t)b * KROWS * D + 64 * h; Vb = WSP(bf16, OFF_VB) + (size_t)b * KROWS * D + 64 * h; ldk = D; }
        const unsigned* mrow = WSP(unsigned, OFF_MASK) + (size_t)(meta ? 0 : R) * NWORDS;
        const float* nb = WSP(float, OFF_NB) + ((size_t)b * 16 + h) * KROWS;
        float q[64];
        { const bf16* qp = QO + (size_t)R * D + 64 * h;
#pragma unroll
          for (int c = 0; c < 8; ++c) { const u32x4 v = *(const u32x4*)(qp + 8 * c);
              q[8 * c + 0] = bf2f(v.x & 0xffffu); q[8 * c + 1] = bf2f(v.x >> 16); q[8 * c + 2] = bf2f(v.y & 0xffffu); q[8 * c + 3] = bf2f(v.y >> 16);
              q[8 * c + 4] = bf2f(v.z & 0xffffu); q[8 * c + 5] = bf2f(v.z >> 16); q[8 * c + 6] = bf2f(v.w & 0xffffu); q[8 * c + 7] = bf2f(v.w >> 16); } }
        float mx = -INFINITY;
        for (int kr = lane; kr <= kmax; kr += 64) {
            bool sel;
            if (MODE == 0) sel = meta ? true : ((mrow[kr >> 5] >> (kr & 31)) & 1u) != 0u;
            else sel = (kr < NMETA) || (kr >= PRE);
            float s = -INFINITY;
            if (sel) { const bf16* kp = Kb + (size_t)kr * ldk; float a = 0.f;
#pragma unroll
                for (int c = 0; c < 8; ++c) { const u32x4 v = *(const u32x4*)(kp + 8 * c);
                    a += q[8 * c + 0] * bf2f(v.x & 0xffffu) + q[8 * c + 1] * bf2f(v.x >> 16) + q[8 * c + 2] * bf2f(v.y & 0xffffu) + q[8 * c + 3] * bf2f(v.y >> 16)
                       + q[8 * c + 4] * bf2f(v.z & 0xffffu) + q[8 * c + 5] * bf2f(v.z >> 16) + q[8 * c + 6] * bf2f(v.w & 0xffffu) + q[8 * c + 7] * bf2f(v.w >> 16); }
                s = a; if (MODE == 1) s += nb[kr]; }
            sc[kr] = s; mx = fmaxf(mx, s);
        }
        mx = wave_max(mx);
        float ls = 0.f;
        for (int kr = lane; kr <= kmax; kr += 64) { const float p = exp2f(sc[kr] - mx); sc[kr] = p; ls += p; }
        ls = wave_sum(ls);
        __builtin_amdgcn_s_waitcnt(0xc07f); asm volatile("" ::: "memory");
        float o = 0.f;
        for (int kr = 0; kr <= kmax; ++kr) { const float p = sc[kr]; if (p != 0.f) o += p * bf2f(Vb[(size_t)kr * ldk + lane]); }
        QO[(size_t)R * D + 64 * h + lane] = (bf16)f2bf(o / ls);
        __builtin_amdgcn_s_waitcnt(0xc07f); asm volatile("" ::: "memory");
    }
}

__device__ __forceinline__ void scan_work(const Ptrs& P, int bh, float* part  , int t) {
    const int b = bh >> 4, h = bh & 15; const bool act = t < 256;
    const float* LF = WSP(float, OFF_LF); float* NBp = WSP(float, OFF_NB) + ((size_t)b * 16 + h) * KROWS;
    float cm = 0.f;
    for (int j = 0; j < NMETA; ++j) { cm += LF[(size_t)(M + j) * 16 + h]; if (t == 0) NBp[j] = -cm * LOG2E; }
    if (t >= NMETA && t < PRE) NBp[t] = -INFINITY;
    float v[8]; float run = 0.f;
    if (act) {
#pragma unroll
        for (int e = 0; e < 8; ++e) { run += LF[((size_t)b * S + 8 * t + e) * 16 + h]; v[e] = run; }
        part[t] = run; }
    __syncthreads();
    for (int o = 1; o < 256; o <<= 1) { float x = 0.f; if (act && t >= o) x = part[t - o]; __syncthreads(); if (act) part[t] += x; __syncthreads(); }
    if (act) { const float off = cm + (t ? part[t - 1] : 0.f);
#pragma unroll
        for (int e = 0; e < 8; ++e) NBp[PRE + 8 * t + e] = -(off + v[e]) * LOG2E; }
    bf16* KB = WSP(bf16, OFF_KB); bf16* VB = WSP(bf16, OFF_VB);
    for (int e = t; e < 48 * 8; e += 512) { const int r = 16 + e / 8, c = e % 8; const u32x4 z = {0u, 0u, 0u, 0u};
        *(u32x4*)(KB + ((size_t)b * KROWS + r) * D + 64 * h + 8 * c) = z; *(u32x4*)(VB + ((size_t)b * KROWS + r) * D + 64 * h + 8 * c) = z; }
    __syncthreads();
}


namespace pg8 {
#define PG8_LAS __attribute__((address_space(3)))
typedef unsigned short bf16_t;
typedef short bf16x8 __attribute__((ext_vector_type(8)));
typedef float f32x4 __attribute__((ext_vector_type(4)));
typedef unsigned u32x4 __attribute__((ext_vector_type(4)));
constexpr int BM = 256, BK = 64, HALF = 128, HTB = HALF * BK * 2  , STAGE_BYTES = 8 * HTB, NXCD = 8, WGM = 4;

__host__ __device__ __forceinline__ int lds_byte(int r, int c) { const int st = (r >> 4) * 2 + (c >> 5), rr = r & 15, cc = c & 31, ob = rr * 64 + cc * 2; return st * 1024 + (ob ^ (((ob >> 9) & 1) << 5)); }
__host__ __device__ __forceinline__ void stage_rc(int b, int& R, int& C) { const int st = b / 1024, sb = b % 1024, swz = sb ^ (((sb >> 9) & 1) << 5); R = (st >> 1) * 16 + swz / 64; C = (st & 1) * 32 + (swz % 64) / 2; }
__host__ __device__ __forceinline__ int perm32(int rho) { const int n = rho >> 4, i = rho & 15; return 8 * (i >> 2) + 4 * n + (i & 3); }

struct Unit { int pm, pn; };
struct Gemm { const bf16_t* A; const bf16_t* Bt; int M, N, K; };

struct StaticOrder {
    int nM, nN, nwg, G, c;
    __host__ __device__ void init(int M, int N, int G_, int c_) { nM = M / BM; nN = N / BM; nwg = nM * nN; G = G_; c = c_; }
    __host__ __device__ bool next(int i, Unit& u) const {
        const long L = (long)i * G + c; if (L >= nwg) return false;
        int wgid = (int)L; { const int q = nwg / NXCD, r = nwg % NXCD, xcd = wgid % NXCD, off = wgid / NXCD; wgid = (xcd < r ? xcd * (q + 1) : r * (q + 1) + (xcd - r) * q) + off; }
        const int nig = WGM * nN, gid = wgid / nig, fm = gid * WGM, gsz = (nM - fm) < WGM ? (nM - fm) : WGM;
        u.pm = fm + ((wgid % nig) % gsz); u.pn = (wgid % nig) / gsz; return true;
    }
    __device__ __forceinline__ void a_ready(const Unit&) const {}
    __device__ __forceinline__ void done(const Unit&) const {}
};

__device__ __forceinline__ unsigned cvt_pk_bf16(float lo, float hi) { unsigned r; asm volatile("v_cvt_pk_bf16_f32 %0, %1, %2" : "=v"(r) : "v"(lo), "v"(hi)); return r; }
typedef float f32x2 __attribute__((ext_vector_type(2)));
typedef int i32x4 __attribute__((ext_vector_type(4)));
template <class Epi, class Sched, bool ALIGN_EPI = false, bool SP2 = false, int QM = 0, bool ABLK = false>
__device__ __forceinline__ void gemm_phase(PG8_LAS unsigned char* lds, const Gemm g, const Sched& S, const Epi& E) {
    int tid = threadIdx.x; asm volatile("" : "+v"(tid));
    const int wid = __builtin_amdgcn_readfirstlane(tid >> 6), lane = tid & 63, wr = wid >> 2, wc = wid & 3, fr = lane & 15, fq = lane >> 4;
    constexpr bool F8 = QM == 1, I8 = QM == 2;
    const int K = g.K, nt = K / BK;
    unsigned voffA[2], voffB[2];
#pragma unroll
    for (int i = 0; i < 2; ++i) { int R, C; stage_rc(tid * 16 + i * 8192, R, C); const int Rb = Epi::PERM ? ((R & ~31) + perm32(R & 31)) : R;
        voffA[i] = ABLK ? (unsigned)(((R >> 4) * (K * 2 / 32) + (C * 2 >> 5)) * 512 + (R & 15) * 32 + (C * 2 & 31)) : (unsigned)(R * K + C) * 2u; voffB[i] = (unsigned)(Rb * K + C) * 2u; }
    const size_t kstepA = ABLK ? (size_t)2048 : (size_t)(BK * 2);
    const size_t kstep = (size_t)(BK * 2);
    const size_t hstep = (size_t)HALF * K * 2;
    const size_t tstep = 2 * hstep;
    const unsigned ldsw = (unsigned)wid * 1024u;
    const int aoff = lds_byte(wr * 64 + fr, fq * 8), boff = lds_byte(wc * 32 + fr, fq * 8);
#define PG8_SA(b, h) (((b) * 2 + (h)) * HTB)
#define PG8_SB(b, h) ((4 + (b) * 2 + (h)) * HTB)
#define PG8_STAGE(bufoff, gbase, voff) do { _Pragma("unroll") for (int _i = 0; _i < 2; ++_i) \
        __builtin_amdgcn_global_load_lds((const unsigned*)((const char*)(gbase) + (voff)[_i]), (PG8_LAS unsigned*)(lds + (bufoff) + ldsw + _i * 8192), 16, 0, 0); } while (0)
#define PG8_LDA(dst, b, h) do { _Pragma("unroll") for (int m = 0; m < 4; ++m) _Pragma("unroll") for (int k = 0; k < 2; ++k) dst[m][k] = *(const PG8_LAS bf16x8*)(lds + PG8_SA(b, h) + aoff + m * 2048 + k * 1024); } while (0)
#define PG8_LDB(dst, b, h) do { _Pragma("unroll") for (int n = 0; n < 2; ++n) _Pragma("unroll") for (int k = 0; k < 2; ++k) dst[n][k] = *(const PG8_LAS bf16x8*)(lds + PG8_SB(b, h) + boff + n * 2048 + k * 1024); } while (0)
#define PG8_CAT8(x) __builtin_shufflevector(__builtin_bit_cast(i32x4, (x)[0]), __builtin_bit_cast(i32x4, (x)[1]), 0, 1, 2, 3, 4, 5, 6, 7)
#define PG8_MMA(ai, bj, At, Bt) do { __builtin_amdgcn_s_setprio(1); _Pragma("unroll") for (int m = 0; m < 4; ++m) _Pragma("unroll") for (int n = 0; n < 2; ++n) { \
        if constexpr (F8) asm volatile("v_mfma_f32_16x16x128_f8f6f4 %0, %1, %2, %0" : "+v"(acc[ai][bj][m][n]) : "v"(PG8_CAT8(Bt[n])), "v"(PG8_CAT8(At[m])));   \
        else if constexpr (I8) { _Pragma("unroll") for (int k = 0; k < 2; ++k) acc[ai][bj][m][n] = __builtin_bit_cast(f32x4, __builtin_amdgcn_mfma_i32_16x16x64_i8(__builtin_bit_cast(i32x4, Bt[n][k]), __builtin_bit_cast(i32x4, At[m][k]), __builtin_bit_cast(i32x4, acc[ai][bj][m][n]), 0, 0, 0)); } \
        else { _Pragma("unroll") for (int k = 0; k < 2; ++k) acc[ai][bj][m][n] = __builtin_amdgcn_mfma_f32_16x16x32_bf16(Bt[n][k], At[m][k], acc[ai][bj][m][n], 0, 0, 0); } } __builtin_amdgcn_s_setprio(0); } while (0)
#define PG8_WAIT_V(n) asm volatile("s_waitcnt vmcnt(" #n ")" ::: "memory")
#define PG8_WAIT_L(n) asm volatile("s_waitcnt lgkmcnt(" #n ")" ::: "memory")
#define PG8_BAR __builtin_amdgcn_s_barrier()
#define PG8_SCHED __builtin_amdgcn_sched_barrier(0)
    Unit cur, nxt; int ui = 0;
    if (!S.next(0, cur)) return;
    f32x4 acc[2][2][4][2];
    float zf = 0.f; asm volatile("" : "+v"(zf));
#pragma unroll
    for (int a = 0; a < 2; ++a)
#pragma unroll
        for (int b = 0; b < 2; ++b)
#pragma unroll
            for (int m = 0; m < 4; ++m)
#pragma unroll
                for (int n = 0; n < 2; ++n) acc[a][b][m][n] = (f32x4){zf, zf, zf, zf};
    bf16x8 At[4][2], B0[2][2], B1[2][2];
    const char* cA = (const char*)g.A + (size_t)cur.pm * tstep; const char* cB = (const char*)g.Bt + (size_t)cur.pn * tstep;
    S.a_ready(cur);
    if constexpr (SP2) {
        PG8_STAGE(PG8_SB(0, 0), cB, voffB); PG8_STAGE(PG8_SB(0, 1), cB + hstep, voffB); PG8_STAGE(PG8_SA(0, 0), cA, voffA); PG8_STAGE(PG8_SA(0, 1), cA + hstep, voffA);
        if (wr == 1) PG8_BAR;
        PG8_WAIT_V(2); PG8_BAR;
        PG8_STAGE(PG8_SB(1, 0), cB + kstep, voffB); PG8_STAGE(PG8_SA(1, 0), cA + kstepA, voffA); PG8_STAGE(PG8_SB(1, 1), cB + hstep + kstep, voffB);
        PG8_WAIT_V(6); PG8_BAR;
    } else {
        PG8_STAGE(PG8_SB(0, 0), cB, voffB); PG8_STAGE(PG8_SA(0, 0), cA, voffA); PG8_STAGE(PG8_SB(0, 1), cB + hstep, voffB); PG8_STAGE(PG8_SA(0, 1), cA + hstep, voffA);
        if (wr == 1) PG8_BAR;
        PG8_WAIT_V(4); PG8_BAR;
        PG8_STAGE(PG8_SB(1, 0), cB + kstep, voffB); PG8_STAGE(PG8_SA(1, 0), cA + kstepA, voffA); PG8_STAGE(PG8_SB(1, 1), cB + hstep + kstep, voffB);
        PG8_WAIT_V(6); PG8_BAR;
    }
    for (;;) {
        const bool has_next = S.next(ui + 1, nxt);
        const char* nA = has_next ? (const char*)g.A + (size_t)nxt.pm * tstep : cA; const char* nB = has_next ? (const char*)g.Bt + (size_t)nxt.pn * tstep : cB;
        for (int t = 0; t < nt; t += 2) {
            const bool last = (t == nt - 2);
            const char* a1 = cA + (size_t)(t + 1) * kstepA;
            const char* a2 = last ? nA : cA + (size_t)(t + 2) * kstepA; const char* b2 = last ? nB : cB + (size_t)(t + 2) * kstep;
            const char* a3 = a2 + kstepA; const char* b3 = b2 + kstep;
            if (last && has_next) S.a_ready(nxt);
            if constexpr (SP2) {
            PG8_LDB(B0, 0, 0); PG8_LDB(B1, 0, 1); PG8_SCHED; PG8_LDA(At, 0, 0); PG8_STAGE(PG8_SA(1, 1), a1 + hstep, voffA);
            PG8_WAIT_V(8); PG8_WAIT_L(0); PG8_BAR; PG8_MMA(0, 0, At, B0); PG8_MMA(0, 1, At, B1); PG8_BAR; PG8_SCHED;
            PG8_LDA(At, 0, 1); PG8_STAGE(PG8_SB(0, 0), b2, voffB); PG8_STAGE(PG8_SB(0, 1), b2 + hstep, voffB); PG8_STAGE(PG8_SA(0, 0), a2, voffA);
            PG8_WAIT_V(8); PG8_WAIT_L(0); PG8_BAR; PG8_MMA(1, 0, At, B0); PG8_MMA(1, 1, At, B1); PG8_BAR; PG8_SCHED;
            PG8_LDB(B0, 1, 0); PG8_LDB(B1, 1, 1); PG8_SCHED; PG8_LDA(At, 1, 0); PG8_STAGE(PG8_SA(0, 1), a2 + hstep, voffA);
            PG8_WAIT_V(8); PG8_WAIT_L(0); PG8_BAR; PG8_MMA(0, 0, At, B0); PG8_MMA(0, 1, At, B1); PG8_BAR; PG8_SCHED;
            PG8_LDA(At, 1, 1); PG8_STAGE(PG8_SB(1, 0), b3, voffB); PG8_STAGE(PG8_SB(1, 1), b3 + hstep, voffB); PG8_STAGE(PG8_SA(1, 0), a3, voffA);
            PG8_WAIT_V(8); PG8_WAIT_L(0); PG8_BAR; PG8_MMA(1, 0, At, B0); PG8_MMA(1, 1, At, B1); PG8_BAR; PG8_SCHED;
            } else {
            PG8_LDB(B0, 0, 0); PG8_SCHED; PG8_LDA(At, 0, 0); PG8_STAGE(PG8_SA(1, 1), a1 + hstep, voffA);
            PG8_WAIT_L(8); PG8_BAR; PG8_WAIT_L(0); PG8_MMA(0, 0, At, B0); PG8_BAR; PG8_SCHED;
            PG8_LDB(B1, 0, 1); PG8_STAGE(PG8_SB(0, 0), b2, voffB);
            PG8_BAR; PG8_WAIT_L(0); PG8_MMA(0, 1, At, B1); PG8_BAR;
            PG8_LDA(At, 0, 1); PG8_STAGE(PG8_SA(0, 0), a2, voffA);
            PG8_BAR; PG8_WAIT_L(0); PG8_MMA(1, 0, At, B0); PG8_BAR; PG8_SCHED;
            PG8_STAGE(PG8_SB(0, 1), b2 + hstep, voffB);
            PG8_WAIT_V(6); PG8_BAR; PG8_MMA(1, 1, At, B1); PG8_BAR;
            PG8_LDB(B0, 1, 0); PG8_SCHED; PG8_LDA(At, 1, 0); PG8_STAGE(PG8_SA(0, 1), a2 + hstep, voffA);
            PG8_WAIT_L(8); PG8_BAR; PG8_WAIT_L(0); PG8_MMA(0, 0, At, B0); PG8_BAR; PG8_SCHED;
            PG8_LDB(B1, 1, 1); PG8_STAGE(PG8_SB(1, 0), b3, voffB);
            PG8_BAR; PG8_WAIT_L(0); PG8_MMA(0, 1, At, B1); PG8_BAR;
            PG8_LDA(At, 1, 1); PG8_STAGE(PG8_SA(1, 0), a3, voffA);
            PG8_BAR; PG8_WAIT_L(0); PG8_MMA(1, 0, At, B0); PG8_BAR; PG8_SCHED;
            PG8_STAGE(PG8_SB(1, 1), b3 + hstep, voffB);
            PG8_WAIT_V(6); PG8_BAR; PG8_MMA(1, 1, At, B1); PG8_BAR;
            }
        }
        if constexpr (ALIGN_EPI) { if (wr == 0) PG8_BAR; }
        if constexpr (F8) asm volatile("s_nop 15\n\ts_nop 7" ::: "memory");
        if constexpr (!Epi::AFTER_DRAIN) { E(acc, cur, wr, wc, fr, fq); S.done(cur); }
        if (!has_next) break;
#pragma unroll
        for (int a = 0; a < 2; ++a)
#pragma unroll
            for (int b = 0; b < 2; ++b)
#pragma unroll
                for (int m = 0; m < 4; ++m)
#pragma unroll
                    for (int n = 0; n < 2; ++n) acc[a][b][m][n] = (f32x4){0.f, 0.f, 0.f, 0.f};
        cur = nxt; cA = nA; cB = nB; ++ui;
        if constexpr (ALIGN_EPI) { if (wr == 1) PG8_BAR; }
    }
    PG8_WAIT_V(0);
    if constexpr (!ALIGN_EPI) { if (wr == 0) PG8_BAR; }
    PG8_BAR;
    if constexpr (Epi::AFTER_DRAIN) { E.fused(acc, cur, wr, wc, fr, fq, lds, wid, lane); S.done(cur); }
#undef PG8_SA
#undef PG8_SB
#undef PG8_STAGE
#undef PG8_LDA
#undef PG8_LDB
#undef PG8_MMA
#undef PG8_WAIT_V
#undef PG8_WAIT_L
#undef PG8_BAR
#undef PG8_SCHED
}
}

__device__ __forceinline__ u32x4 pack8(const f32x4& a, const f32x4& b) { u32x4 w; w.x = pg8::cvt_pk_bf16(a[0], a[1]); w.y = pg8::cvt_pk_bf16(a[2], a[3]); w.z = pg8::cvt_pk_bf16(b[0], b[1]); w.w = pg8::cvt_pk_bf16(b[2], b[3]); return w; }
__device__ __forceinline__ float hsum4(const f32x4& a) { return (a[0] + a[1]) + (a[2] + a[3]); }

struct HeadTile { bf16* dst; int ldd, col0, mode; const float* gain; float scale, ascale; };
__device__ __forceinline__ void epi_heads(const Ptrs& P, const HeadTile& T, const float* ssq, const f32x4 (&acc)[2][2][4][2], const pg8::Unit& u, int wr, int wc, int fr, int fq) {
    const float* COS = WSP(float, OFF_ROPE); const float* SIN = COS + NPOS * 32;
    f32x4 g[2][2];
#pragma unroll
    for (int bj = 0; bj < 2; ++bj)
#pragma unroll
        for (int n = 0; n < 2; ++n) g[bj][n] = (T.mode & 1) ? *(const f32x4*)(T.gain + 32 * bj + 8 * fq + 4 * n) : (f32x4){1.f, 1.f, 1.f, 1.f};
    extern __shared__ __attribute__((aligned(16))) unsigned char dyn_lds_epi[];
    float* rs = (float*)(dyn_lds_epi + EPI_RS_OFF) + (wr * 4 + wc) * 128;
    { const int lane = fq * 16 + fr;
#pragma unroll
      for (int h = 0; h < 2; ++h) { const int j = lane + 64 * h; rs[j] = row_scale(ssq, u.pm * 256 + (j >> 6) * 128 + wr * 64 + (j & 63)) * T.ascale; } }
    f32x4 cN[2], sN[2];
    { const int pos0 = ((u.pm * 256 + wr * 64 + fr) & (S - 1)) + NMETA;
#pragma unroll
      for (int n = 0; n < 2; ++n) { cN[n] = *(const f32x4*)(COS + pos0 * 32 + 8 * fq + 4 * n); sN[n] = *(const f32x4*)(SIN + pos0 * 32 + 8 * fq + 4 * n); } }
#pragma unroll
    for (int ai = 0; ai < 2; ++ai)
#pragma unroll
        for (int m = 0; m < 4; ++m) {
            const int R = u.pm * 256 + ai * 128 + wr * 64 + m * 16 + fr;
            const float rr = rs[ai * 64 + m * 16 + fr];
            const f32x4 cC[2] = {cN[0], cN[1]}, sC[2] = {sN[0], sN[1]};
            if (ai * 4 + m < 7) { const int in = ai * 4 + m + 1, posn = ((u.pm * 256 + (in >> 2) * 128 + wr * 64 + (in & 3) * 16 + fr) & (S - 1)) + NMETA;
#pragma unroll
                for (int n = 0; n < 2; ++n) { cN[n] = *(const f32x4*)(COS + posn * 32 + 8 * fq + 4 * n); sN[n] = *(const f32x4*)(SIN + posn * 32 + 8 * fq + 4 * n); } }
            f32x4 x[2][2];
#pragma unroll
            for (int bj = 0; bj < 2; ++bj)
#pragma unroll
                for (int n = 0; n < 2; ++n) x[bj][n] = acc[ai][bj][m][n] * rr;
            if (T.mode & 1) {
                float ss = (hsum4(x[0][0] * x[0][0]) + hsum4(x[0][1] * x[0][1])) + (hsum4(x[1][0] * x[1][0]) + hsum4(x[1][1] * x[1][1]));
                ss += __shfl_xor(ss, 16); ss += __shfl_xor(ss, 32);
                const float rn = rsqrtf(ss * (1.0f / 64.0f) + EPS);
#pragma unroll
                for (int bj = 0; bj < 2; ++bj)
#pragma unroll
                    for (int n = 0; n < 2; ++n) x[bj][n] = x[bj][n] * (g[bj][n] * rn);
            }
            if (T.mode & 2) {
#pragma unroll
                for (int n = 0; n < 2; ++n) { const f32x4 c = cC[n], sn = sC[n];
                    const f32x4 lo = x[0][n], hi = x[1][n]; x[0][n] = lo * c - hi * sn; x[1][n] = lo * sn + hi * c; }
            }
            const size_t drow = (T.mode & 4) ? (size_t)(R >> 11) * KROWS + PRE + (R & (S - 1)) : (size_t)R;
            bf16* dp = T.dst + drow * T.ldd + T.col0 + 8 * fq;
            *(u32x4*)(dp) = pack8(x[0][0] * T.scale, x[0][1] * T.scale);
            *(u32x4*)(dp + 32) = pack8(x[1][0] * T.scale, x[1][1] * T.scale);
        }
}
struct EpiInA {
    static constexpr bool PERM = true, AFTER_DRAIN = false;
    const Ptrs& P; int l; int f8, pn0;
    __device__ __forceinline__ void operator()(const f32x4 (&acc)[2][2][4][2], const pg8::Unit& u, int wr, int wc, int fr, int fq) const {
        HeadTile T; const int pn = u.pn + pn0; T.ascale = f8 ? 1.0f / IN_F8S : 1.0f;
        if (pn < 4) { T.dst = WSP(bf16, OFF_QO); T.ldd = D; T.col0 = 64 * (4 * pn + wc); T.mode = 3; T.gain = WSP(float, OFF_GT) + GT_AQG + l * 64; T.scale = C2; }
        else if (pn == 4) { T.dst = WSP(bf16, OFF_KA); T.ldd = 256; T.col0 = 64 * wc; T.mode = 7; T.gain = WSP(float, OFF_GT) + GT_AKG + l * 64; T.scale = 1.f; }
        else if (pn == 5) { T.dst = WSP(bf16, OFF_VA); T.ldd = 256; T.col0 = 64 * wc; T.mode = 4; T.gain = nullptr; T.scale = 1.f; }
        else { T.dst = WSP(bf16, OFF_QI); T.ldd = 512; T.col0 = 64 * (4 * (pn - 6) + wc); T.mode = 2; T.gain = nullptr; T.scale = 1.f; }
        epi_heads(P, T, ssq_p(P, 2 * l), acc, u, wr, wc, fr, fq);
    }
};
struct EpiInB {
    static constexpr bool PERM = true, AFTER_DRAIN = false;
    const Ptrs& P; int l;
    __device__ __forceinline__ void operator()(const f32x4 (&acc)[2][2][4][2], const pg8::Unit& u, int wr, int wc, int fr, int fq) const {
        HeadTile T; const int pn = u.pn; T.ascale = 1.0f / IN_F8S;
        if (pn < 4) { T.dst = WSP(bf16, OFF_QO); T.ldd = D; T.col0 = 64 * (4 * pn + wc); T.mode = 1; T.gain = WSP(float, OFF_GT) + GT_BQG + (l - 2) * 64; T.scale = C2; }
        else if (pn < 8) { T.dst = WSP(bf16, OFF_KB); T.ldd = D; T.col0 = 64 * (4 * (pn - 4) + wc); T.mode = 5; T.gain = WSP(float, OFF_GT) + GT_KKG; T.scale = 1.f; }
        else { T.dst = WSP(bf16, OFF_VB); T.ldd = D; T.col0 = 64 * (4 * (pn - 8) + wc); T.mode = 4; T.gain = nullptr; T.scale = 1.f; }
        epi_heads(P, T, ssq_p(P, 2 * l), acc, u, wr, wc, fr, fq);
    }
};
__device__ __forceinline__ f32x4 i2f4(const f32x4& v) { f32x4 r; r[0] = (float)__float_as_int(v[0]); r[1] = (float)__float_as_int(v[1]); r[2] = (float)__float_as_int(v[2]); r[3] = (float)__float_as_int(v[3]); return r; }
template <bool MLP>
struct EpiRes {
    static constexpr bool PERM = true, AFTER_DRAIN = false;
    const Ptrs& P; int l, dry;
    __device__ __forceinline__ void operator()(const f32x4 (&acc)[2][2][4][2], const pg8::Unit& u, int wr, int wc, int fr, int fq) const {
        constexpr int mlp = MLP ? 1 : 0;
        const bf16* H = WSP(bf16, OFF_H); bf16* Hw = dry ? (bf16*)P.out : WSP(bf16, OFF_H); float* ssqn = dry ? P.out + (size_t)20 * 1024 * 1024 : ssq_p(P, 2 * l + (mlp ? 2 : 1)); const bool last = mlp && l == 3 && !dry;
        f32x4 csa[2], csb[2];
        if constexpr (MLP) { const int* cs = (const int*)(P.ws + OFF_CTL) + CW_CS + l * D;
#pragma unroll
            for (int bj = 0; bj < 2; ++bj) { const int col = u.pn * 256 + bj * 128 + wc * 32 + 8 * fq; const i32x4v c0 = *(const i32x4v*)(cs + col), c1 = *(const i32x4v*)(cs + col + 4);
#pragma unroll
                for (int j = 0; j < 4; ++j) { csa[bj][j] = 128.f * (float)c0[j]; csb[bj][j] = 128.f * (float)c1[j]; } } }
        u32x4 hvv[2][4][2];
#pragma unroll
        for (int ai = 0; ai < 2; ++ai)
#pragma unroll
            for (int m = 0; m < 4; ++m)
#pragma unroll
                for (int bj = 0; bj < 2; ++bj) hvv[ai][m][bj] = *(const u32x4*)(H + (size_t)(u.pm * 256 + ai * 128 + wr * 64 + m * 16 + fr) * D + u.pn * 256 + bj * 128 + wc * 32 + 8 * fq);
        extern __shared__ __attribute__((aligned(16))) unsigned char dyn_lds_epi[];
        float* rs = (float*)(dyn_lds_epi + EPI_RS_OFF) + (wr * 4 + wc) * 128;
        if constexpr (!MLP) { const int lane = fq * 16 + fr;
#pragma unroll
            for (int h = 0; h < 2; ++h) { const int j = lane + 64 * h; rs[j] = row_scale(ssq_p(P, 2 * l), u.pm * 256 + (j >> 6) * 128 + wr * 64 + (j & 63)) * QA; } }
#pragma unroll
        for (int ai = 0; ai < 2; ++ai)
#pragma unroll
            for (int m = 0; m < 4; ++m) {
                const int R = u.pm * 256 + ai * 128 + wr * 64 + m * 16 + fr; float sq = 0.f;
                float qs = 0.f; if constexpr (!MLP) qs = rs[ai * 64 + m * 16 + fr];
#pragma unroll
                for (int bj = 0; bj < 2; ++bj) {
                    const int col = u.pn * 256 + bj * 128 + wc * 32 + 8 * fq;
                    const u32x4 hv = hvv[ai][m][bj];
                    f32x4 a, b;
                    if constexpr (MLP) { a = (i2f4(acc[ai][bj][m][0]) + csa[bj]) * (1.0f / (QU * QW2)); b = (i2f4(acc[ai][bj][m][1]) + csb[bj]) * (1.0f / (QU * QW2)); }
                    else { a = acc[ai][bj][m][0]; b = acc[ai][bj][m][1]; }
                    a[0] += bf2f(hv.x & 0xffffu); a[1] += bf2f(hv.x >> 16); a[2] += bf2f(hv.y & 0xffffu); a[3] += bf2f(hv.y >> 16);
                    b[0] += bf2f(hv.z & 0xffffu); b[1] += bf2f(hv.z >> 16); b[2] += bf2f(hv.w & 0xffffu); b[3] += bf2f(hv.w >> 16);
                    sq += hsum4(a * a) + hsum4(b * b);
                    if (!last) *(u32x4*)(Hw + (size_t)R * D + col) = pack8(a, b);
                    if constexpr (MLP) { if (!last && !dry) { u32x2 o8; o8.x = pk4_fp8(a[0], a[1], a[2], a[3]); o8.y = pk4_fp8(b[0], b[1], b[2], b[3]);
                        *(u32x2*)(WSP(unsigned char, l == 0 ? OFF_H8A : OFF_H8B) + blk8(R, col, D)) = o8; } }
                    else { if (!dry) { u32x2 o8; o8.x = pk4_i8(a[0] * qs, a[1] * qs, a[2] * qs, a[3] * qs); o8.y = pk4_i8(b[0] * qs, b[1] * qs, b[2] * qs, b[3] * qs);
                        *(u32x2*)(WSP(unsigned char, OFF_HQ) + blk8(R, col, D)) = o8; } }
                    if (last) { float* op = P.out + (size_t)R * D + col; *(f32x4*)op = a; *(f32x4*)(op + 4) = b; }
                }
                sq += __shfl_xor(sq, 16); sq += __shfl_xor(sq, 32);
                if (fq == 0 && !last) ssqn[(size_t)R * 16 + 4 * u.pn + wc] = sq;
            }
    }
};
struct EpiRelu2 {
    static constexpr bool PERM = true, AFTER_DRAIN = false;
    const Ptrs& P; int l, blk;
    __device__ __forceinline__ void operator()(const f32x4 (&acc)[2][2][4][2], const pg8::Unit& u, int wr, int wc, int fr, int fq) const {
        unsigned char* U8 = WSP(unsigned char, OFF_U);
        extern __shared__ __attribute__((aligned(16))) unsigned char dyn_lds_epi[];
        float* rs = (float*)(dyn_lds_epi + EPI_RS_OFF) + (wr * 4 + wc) * 128;
        { const int lane = fq * 16 + fr; float v[2];
#pragma unroll
          for (int h = 0; h < 2; ++h) { const int j = lane + 64 * h, Rj = u.pm * 256 + (j >> 6) * 128 + wr * 64 + (j & 63);
              v[h] = row_scale(ssq_p(P, 2 * l + 1), Rj) * SQRT_QU / (row_scale(ssq_p(P, 2 * l), Rj) * (QA * QW1)); }
          rs[lane] = v[0]; rs[lane + 64] = v[1]; }
#pragma unroll
        for (int ai = 0; ai < 2; ++ai)
#pragma unroll
            for (int m = 0; m < 4; ++m) {
                const int R = u.pm * 256 + ai * 128 + wr * 64 + m * 16 + fr;
                const float sc = rs[ai * 64 + m * 16 + fr];
#pragma unroll
                for (int bj = 0; bj < 2; ++bj) {
                    const f32x4 sc4 = {sc, sc, sc, sc};
                    f32x4 a = i2f4(acc[ai][bj][m][0]) * sc4, b = i2f4(acc[ai][bj][m][1]) * sc4;
#pragma unroll
                    for (int j = 0; j < 4; ++j) { a[j] = a[j] * fabsf(a[j]); b[j] = b[j] * fabsf(b[j]); }

                    const int col = u.pn * 256 + bj * 128 + wc * 32 + 8 * fq;
                    int p0 = __builtin_amdgcn_cvt_pk_u8_f32(a[0], 0, 0); p0 = __builtin_amdgcn_cvt_pk_u8_f32(a[1], 1, p0); p0 = __builtin_amdgcn_cvt_pk_u8_f32(a[2], 2, p0); p0 = __builtin_amdgcn_cvt_pk_u8_f32(a[3], 3, p0);
                    int p1 = __builtin_amdgcn_cvt_pk_u8_f32(b[0], 0, 0); p1 = __builtin_amdgcn_cvt_pk_u8_f32(b[1], 1, p1); p1 = __builtin_amdgcn_cvt_pk_u8_f32(b[2], 2, p1); p1 = __builtin_amdgcn_cvt_pk_u8_f32(b[3], 3, p1);
                    u32x2 o; o.x = (unsigned)p0 ^ 0x80808080u; o.y = (unsigned)p1 ^ 0x80808080u;
                    __builtin_nontemporal_store(o, (u32x2*)(U8 + ((size_t)(R >> 4) * (FF / 32) + (col >> 5)) * 512 + (R & 15) * 32 + (col & 31)));
                }
            }
    }
};

#include <hip/hip_bf16.h>
#include <cmath>
namespace attn_body {
typedef unsigned u32x2_t __attribute__((ext_vector_type(2)));
constexpr int KVROWS=64+2048;
constexpr int LDS_AUX_BYTES=33*32*8;
using bf16=__hip_bfloat16;
using bf16x8=__attribute__((ext_vector_type(8)))short;
using s16x4=__attribute__((ext_vector_type(4)))short;
using f32x16=__attribute__((ext_vector_type(16)))float;
using u32x4=__attribute__((ext_vector_type(4)))unsigned;
constexpr int BATCH=16,NHEAD=16,SEQ=2048,D=64,DM=NHEAD*D;
constexpr int NW=8,QBLK=32,QB=QBLK*NW,KVBLK=64,NQB=SEQ/QB;
constexpr int ATTN_PITCH=DM, ATTN_UNIT_ROWS=QB;
__device__ __forceinline__ int crow(int r,int hi){return (r&3)+8*(r>>2)+4*hi;}
#define SBAR() __builtin_amdgcn_sched_barrier(0)
__device__ __forceinline__ void cmask(f32x16&p0,f32x16&p1,int jb,int qrel,int hi){
  const float NEG=-INFINITY; int kb=64*jb+4*hi;
  #pragma unroll
  for(int r=0;r<16;++r){int kv=kb+(r&3)+8*(r>>2); if(kv>qrel)p0[r]=NEG; if(kv+32>qrel)p1[r]=NEG;}
}

constexpr int NSLOT=3, SLOTB=8192;
constexpr int LDS_K=0, LDS_V=NSLOT*SLOTB, LDS_WS=2*NSLOT*SLOTB, LDS_OST=LDS_WS+NW*64*4, LDS_CORE=LDS_OST+NW*4096, LDS_AUX=LDS_CORE, LDS_BYTES=LDS_AUX+NW*LDS_AUX_BYTES;
constexpr float C2=0.125f*1.4426950408889634f;
__device__ __forceinline__ void glds16(const void*gsrc,unsigned lds_dst){unsigned keep;
  asm volatile("s_mov_b32 %0, m0\n\ts_mov_b32 m0, %2\n\ts_nop 0\n\tglobal_load_lds_dwordx4 %1, off\n\ts_mov_b32 m0, %0":"=&s"(keep):"v"(gsrc),"s"(lds_dst):"memory");}
__device__ __forceinline__ float max3f(float a,float b,float c){float r;asm("v_max3_f32 %0, %1, %2, %3":"=v"(r):"v"(a),"v"(b),"v"(c));return r;}
__device__ __forceinline__ float max2f(float a,float b){float r;asm("v_max_f32_e32 %0, %1, %2":"=v"(r):"v"(a),"v"(b));return r;}
__device__ __forceinline__ float fadd_s(float a,float b){float r;asm("v_add_f32_e32 %0, %1, %2":"=v"(r):"v"(a),"v"(b));return r;}
__device__ __forceinline__ float fsub_s(float a,float b){float r;asm("v_sub_f32_e32 %0, %1, %2":"=v"(r):"v"(a),"v"(b));return r;}
typedef float f32x2_t __attribute__((ext_vector_type(2))); typedef float f32x4_t __attribute__((ext_vector_type(4))); typedef __bf16 bf16x2_t __attribute__((ext_vector_type(2)));
__device__ __forceinline__ unsigned cvtpk_s(float lo,float hi){f32x2_t v={lo,hi};bf16x2_t b=__builtin_convertvector(v,bf16x2_t);return __builtin_bit_cast(unsigned,b);}
#define WAIT_BAR(N) asm volatile("s_waitcnt vmcnt(" #N ") lgkmcnt(0)\n\ts_barrier":::"memory")

__device__ __forceinline__ void qkt(f32x16&p0,f32x16&p1,const char*Kslot,const bf16x8*qr,const f32x16&negm,int r32,int hi){
  const char*kb=Kslot+hi*1024+r32*16;
  #pragma unroll
  for(int d0=0;d0<4;++d0){
    const bf16x8 b0=*reinterpret_cast<const bf16x8*>(kb+d0*2048);
    const bf16x8 b1=*reinterpret_cast<const bf16x8*>(kb+d0*2048+512);
    if(d0==0){p0=__builtin_amdgcn_mfma_f32_32x32x16_bf16(b0,qr[0],negm,0,0,0);p1=__builtin_amdgcn_mfma_f32_32x32x16_bf16(b1,qr[0],negm,0,0,0);}
    else{p0=__builtin_amdgcn_mfma_f32_32x32x16_bf16(b0,qr[d0],p0,0,0,0);p1=__builtin_amdgcn_mfma_f32_32x32x16_bf16(b1,qr[d0],p1,0,0,0);}}
}
typedef __attribute__((address_space(3))) const char* lds_cptr;
typedef __attribute__((address_space(3))) char* lds_cptr_w;
typedef short v4i16_t __attribute__((ext_vector_type(4)));
__device__ __forceinline__ void kload8(bf16x8*kf,lds_cptr kp){
  kf[0]=*(const __attribute__((address_space(3))) bf16x8*)(kp);      kf[1]=*(const __attribute__((address_space(3))) bf16x8*)(kp+512);
  kf[2]=*(const __attribute__((address_space(3))) bf16x8*)(kp+2048); kf[3]=*(const __attribute__((address_space(3))) bf16x8*)(kp+2560);
  kf[4]=*(const __attribute__((address_space(3))) bf16x8*)(kp+4096); kf[5]=*(const __attribute__((address_space(3))) bf16x8*)(kp+4608);
  kf[6]=*(const __attribute__((address_space(3))) bf16x8*)(kp+6144); kf[7]=*(const __attribute__((address_space(3))) bf16x8*)(kp+6656);
}
__device__ __forceinline__ void kload2(bf16x8*kf,lds_cptr kp,int j){ kf[2*j]=*(const __attribute__((address_space(3))) bf16x8*)(kp+j*2048); kf[2*j+1]=*(const __attribute__((address_space(3))) bf16x8*)(kp+j*2048+512); }
__device__ __forceinline__ s16x4 vtr(lds_cptr p){ return __builtin_bit_cast(s16x4,__builtin_amdgcn_ds_read_tr16_b64_v4i16((__attribute__((address_space(3))) v4i16_t*)p)); }
__device__ __forceinline__ float rowmax(const f32x16&p0,const f32x16&p1){
  float a=max3f(p0[0],p0[1],p1[0]),b=max3f(p0[2],p0[3],p1[1]);a=max3f(a,p1[2],p1[3]);
  #pragma unroll
  for(int r=4;r<16;r+=4){a=max3f(a,p0[r],p0[r+1]);b=max3f(b,p0[r+2],p0[r+3]);a=max3f(a,p1[r],p1[r+1]);b=max3f(b,p1[r+2],p1[r+3]);}
  const float m=max2f(a,b);
  auto rr=__builtin_amdgcn_permlane32_swap(__float_as_uint(m),__float_as_uint(m),false,false);
  return max2f(__uint_as_float(rr[0]),__uint_as_float(rr[1]));
}
__device__ __forceinline__ void pv(f32x16*o,int vb,bf16x8 pa0,bf16x8 pa1,bf16x8 pa2,bf16x8 pa3){
  #pragma unroll
  for(int d0=0;d0<2;++d0){s16x4 lo[4],hi[4];
    #pragma unroll
    for(int ks=0;ks<4;++ks){
      asm volatile("ds_read_b64_tr_b16 %0,%1 offset:%c2":"=&v"(lo[ks]):"v"(vb),"i"(d0*4096+ks*1024):"memory");
      asm volatile("ds_read_b64_tr_b16 %0,%1 offset:%c2":"=&v"(hi[ks]):"v"(vb),"i"(d0*4096+ks*1024+512):"memory");}
    asm volatile("s_waitcnt lgkmcnt(0)":::"memory");SBAR();
    #define PK(k) (bf16x8){lo[k][0],lo[k][1],lo[k][2],lo[k][3],hi[k][0],hi[k][1],hi[k][2],hi[k][3]}
    o[d0]=__builtin_amdgcn_mfma_f32_32x32x16_bf16(pa0,PK(0),o[d0],0,0,0);
    o[d0]=__builtin_amdgcn_mfma_f32_32x32x16_bf16(pa1,PK(1),o[d0],0,0,0);
    o[d0]=__builtin_amdgcn_mfma_f32_32x32x16_bf16(pa2,PK(2),o[d0],0,0,0);
    o[d0]=__builtin_amdgcn_mfma_f32_32x32x16_bf16(pa3,PK(3),o[d0],0,0,0);
    #undef PK
  }
}

#ifndef ATTN_STORE16
#define ATTN_STORE16(p,v) (*(u32x4*)(p)=(v))
#endif
template<int THRL,int MODE,int KVP> __device__ __forceinline__ void attn_unit(int b,int h,int hk,int qb,const bf16*Q,const bf16*__restrict__ K,const bf16*__restrict__ V,bf16*O,char*shm,const unsigned*maskg,const float*biasg,int t0  ){
  int tid_=threadIdx.x; asm volatile("":"+v"(tid_));
  const int tid=tid_,lane=tid&63,r32=lane&31,hi=lane>>5; const int wid=__builtin_amdgcn_readfirstlane(tid>>6);
  const long rowbase=(long)b*SEQ; const int q0=qb*QB;
  const bf16*Qw=Q+(rowbase+q0+wid*QBLK)*DM+h*D;
  const long kvbase=(long)b*KVROWS+(long)t0*64;
  const bf16*Kh=K+kvbase*KVP+hk*D,*Vh=V+kvbase*KVP+hk*D;
  const unsigned lds0=(unsigned)(uintptr_t)shm;
  float*wsf=(float*)(shm+LDS_WS)+wid*64;
  const bf16*ksrc=Kh+(long)lane*KVP+wid*8;
  const bf16*vsrc=Vh+(long)(16*(wid&3)+(lane>>2))*KVP+(wid>>2)*32+(lane&3)*8;
  const unsigned kdst=lds0+LDS_K+wid*1024, vdst=lds0+LDS_V+wid*1024;
  #define DMA_K(t,slot) glds16(ksrc+(long)(t)*KVBLK*KVP,(unsigned)__builtin_amdgcn_readfirstlane(kdst+(slot)))
  #define DMA_V(t,slot) glds16(vsrc+(long)(t)*KVBLK*KVP,(unsigned)__builtin_amdgcn_readfirstlane(vdst+(slot)))
  const int vb0=(int)(lds0+LDS_V)+((lane>>4)&1)*32+(lane&3)*8+(4*hi+((lane&15)>>2))*64;
  const char*Kbase=shm+LDS_K; bf16x8 kf[8];
  const lds_cptr shm3=(lds_cptr)shm; const lds_cptr kp0=shm3+LDS_K+hi*1024+r32*16; const lds_cptr vp0=shm3+LDS_V+((lane>>4)&1)*32+(lane&3)*8+(4*hi+((lane&15)>>2))*64;
  const int NT=(q0+QB)/KVBLK+1-t0;
  float nbq=0.f; if(MODE==1) nbq=biasg[64+q0+wid*QBLK+r32];
  if(MODE==2){} else if(MODE==0){
    const unsigned*mrow=maskg+((long)(rowbase+q0+wid*QBLK+r32))*66;
    __attribute__((address_space(3))) u32x2_t*mdst=(__attribute__((address_space(3))) u32x2_t*)((lds_cptr_w)shm+LDS_AUX+wid*LDS_AUX_BYTES);
    for(int t=hi;t<NT;t+=2){ const u32x2_t w=*reinterpret_cast<const u32x2_t*>(mrow+2*t); mdst[t*32+r32]=w; }
  } else {
    __attribute__((address_space(3))) float*bdst=(__attribute__((address_space(3))) float*)((lds_cptr_w)shm+LDS_AUX);
    for(int i=tid;i<NT*64;i+=NW*64)bdst[i]=biasg[t0*64+i];
  }
  asm volatile("s_waitcnt vmcnt(0) lgkmcnt(0)":::"memory");
  DMA_K(0,0);DMA_V(0,0);DMA_K(1,SLOTB);
  bf16x8 qr[4];
  #pragma unroll
  for(int d0=0;d0<4;++d0)qr[d0]=*reinterpret_cast<const bf16x8*>(&Qw[(long)r32*DM+d0*16+hi*8]);
  float mhat=0.f,l_reg=0.f;f32x16 o[2];o[0]=f32x16{};o[1]=f32x16{};const f32x16 negm=f32x16{};
  const int qrel=wid*QBLK+r32;
  if(MODE==1) mhat=nbq;
  #define CMASK(P0,P1,t) do{ if(MODE==2){ _Pragma("unroll") for(int r=0;r<16;++r){P0[r]-=mhat;P1[r]-=mhat;} int jb_=(t)-(NT-4); if(jb_>=0)cmask(P0,P1,jb_,qrel,hi); } else if(MODE==0){ const u32x2_t mw_=*((const __attribute__((address_space(3))) u32x2_t*)(shm3+LDS_AUX+wid*LDS_AUX_BYTES)+(t)*32+r32); mkx=mw_.x>>(4*hi); mky=mw_.y>>(4*hi); } \
      else { const __attribute__((address_space(3))) float*bp_=(const __attribute__((address_space(3))) float*)(shm3+LDS_AUX)+64*(t)+4*hi; \
        _Pragma("unroll") for(int g_=0;g_<4;++g_){ const f32x4_t b0_=*(const __attribute__((address_space(3))) f32x4_t*)(bp_+8*g_)-mhat, b1_=*(const __attribute__((address_space(3))) f32x4_t*)(bp_+32+8*g_)-mhat; \
          _Pragma("unroll") for(int j_=0;j_<4;++j_){ P0[4*g_+j_]+=b0_[j_]; P1[4*g_+j_]+=b1_[j_]; } SBAR(); } \
        int jb_=(t)-(NT-4); if(jb_>=0)cmask(P0,P1,jb_,qrel,hi); } }while(0)
  bool resc=false; unsigned mkx=0u,mky=0u;
  #define MSK(X,i,W) do{ float xv_=X[i]; unsigned mt_;   \
      asm volatile("v_bfe_i32 %1, %2, %3, 1\n\tv_and_b32 %0, %0, %1":"+v"(xv_),"=&v"(mt_):"v"(W),"n"(((i)&3)+8*((i)>>2))); X[i]=xv_; }while(0)
  #define START(P0,P1) do{ resc=false; \
    if(MODE==2){ const float rm=rowmax(P0,P1); const float dl=rm; mhat=fadd_s(mhat,dl); \
      _Pragma("unroll") for(int r=0;r<16;++r){P0[r]=fsub_s(P0[r],dl);P1[r]=fsub_s(P1[r],dl);} \
      } \
    _Pragma("unroll") for(int r=0;r<16;++r){P0[r]=__builtin_amdgcn_exp2f(P0[r]); if(MODE==0){MSK(P0,r,mkx);}} }while(0)
  #define RESC() do{ if(resc){ asm volatile("s_waitcnt lgkmcnt(0)":::"memory"); \
      _Pragma("unroll") for(int d_=0;d_<2;++d_) _Pragma("unroll") for(int r=0;r<16;++r)o[d_][r]*=wsf[crow(r,hi)]; } }while(0)
  f32x16 pA0,pA1,pB0,pB1;
  int sl_prev=0,sl_cur=0,sl_next=SLOTB;
  #define ROT() do{sl_prev=sl_cur;sl_cur=sl_next;sl_next=(sl_next==(NSLOT-1)*SLOTB)?0:sl_next+SLOTB;}while(0)
  DMA_K(2,2*SLOTB);
  WAIT_BAR(3);
  qkt(pA0,pA1,Kbase,qr,negm,r32,hi);asm volatile("s_nop 15\n\ts_nop 7":"+v"(pA0),"+v"(pA1));CMASK(pA0,pA1,0);
  START(pA0,pA1);
  _Pragma("unroll") for(int r=0;r<16;++r){pA1[r]=__builtin_amdgcn_exp2f(pA1[r]); if(MODE==0){MSK(pA1,r,mky);}}
  WAIT_BAR(0);
  DMA_K(3,0);DMA_V(1,SLOTB);
  ROT();
  kload8(kf,kp0+sl_cur);
  WAIT_BAR(2);
  s16x4 vlo[8],vhi[8]; u32x4 pw0,pw1,pw2,pw3;
  #define PKW(P,B) cvtpk_s(P[B],P[B+1])
  #define PAF(k) __builtin_bit_cast(bf16x8,pw##k)
  #define VFR(i) (bf16x8){vlo[i][0],vlo[i][1],vlo[i][2],vlo[i][3],vhi[i][0],vhi[i][1],vhi[i][2],vhi[i][3]}
  #define PIN(x) asm volatile("":"+v"(x))
  #define MX3(a,b,c) __builtin_fmaxf(__builtin_fmaxf((a),(b)),(c))
  #define GAPA(MF,A0,A1,A2,A3,W0,W1,PW) do{ MF; sacc+=A0; sacc+=A1; sacc+=A2; sacc+=A3; PIN(sacc); W0; W1; PIN(PW); SBAR(); }while(0)
  #define EX(v) __builtin_amdgcn_exp2f(v)
  #define GAPB(MF,X,B,W) do{ MF; X[B]=EX(X[B]); X[B+1]=EX(X[B+1]); X[B+2]=EX(X[B+2]); X[B+3]=EX(X[B+3]); if(MODE==0){MSK(X,B,W);MSK(X,(B)+1,W);MSK(X,(B)+2,W);MSK(X,(B)+3,W);} PIN(X); SBAR(); }while(0)
  #define VRD(i) do{ vlo[i]=vtr(vp_+(((i)>>2)*4096+((i)&3)*1024)); vhi[i]=vtr(vp_+(((i)>>2)*4096+((i)&3)*1024+512)); }while(0)
  #define KRD(G,j) do{ if(G){ kload2(kf,kp0+sl_next,j); SBAR(); } }while(0)
  #define STEP(C0,C1,P0,P1,t,GK,GV,GL) do{ SBAR(); \
    const lds_cptr vp_=vp0+sl_prev; \
    VRD(0); SBAR(); float sacc=(P0[0]+P0[1]); \
    GAPA(C0=__builtin_amdgcn_mfma_f32_32x32x16_bf16(kf[0],qr[0],negm,0,0,0), P0[2],P0[3],P0[4],P0[5],     pw0[0]=PKW(P0,0), pw0[1]=PKW(P0,2), pw0); \
    VRD(4); SBAR(); GAPA(C1=__builtin_amdgcn_mfma_f32_32x32x16_bf16(kf[1],qr[0],negm,0,0,0), P0[6],P0[7],P0[8],P0[9],     pw0[2]=PKW(P0,4), pw0[3]=PKW(P0,6), pw0); \
    VRD(1); SBAR(); GAPA(C0=__builtin_amdgcn_mfma_f32_32x32x16_bf16(kf[2],qr[1],C0,0,0,0),   P0[10],P0[11],P0[12],P0[13], pw1[0]=PKW(P0,8), pw1[1]=PKW(P0,10), pw1); \
    VRD(5); SBAR(); GAPA(C1=__builtin_amdgcn_mfma_f32_32x32x16_bf16(kf[3],qr[1],C1,0,0,0),   P0[14],P0[15],P1[0],P1[1],   pw1[2]=PKW(P0,12),pw1[3]=PKW(P0,14), pw1); \
    VRD(2); SBAR(); GAPA(C0=__builtin_amdgcn_mfma_f32_32x32x16_bf16(kf[4],qr[2],C0,0,0,0),   P1[2],P1[3],P1[4],P1[5],     pw2[0]=PKW(P1,0), pw2[1]=PKW(P1,2), pw2); \
    VRD(6); SBAR(); GAPA(C1=__builtin_amdgcn_mfma_f32_32x32x16_bf16(kf[5],qr[2],C1,0,0,0),   P1[6],P1[7],P1[8],P1[9],     pw2[2]=PKW(P1,4), pw2[3]=PKW(P1,6), pw2); \
    VRD(3); SBAR(); GAPA(C0=__builtin_amdgcn_mfma_f32_32x32x16_bf16(kf[6],qr[3],C0,0,0,0),   P1[10],P1[11],P1[12],P1[13], pw3[0]=PKW(P1,8), pw3[1]=PKW(P1,10), pw3); \
    VRD(7); SBAR(); GAPA(C1=__builtin_amdgcn_mfma_f32_32x32x16_bf16(kf[7],qr[3],C1,0,0,0),   P1[14],P1[15],0.f,0.f,       pw3[2]=PKW(P1,12),pw3[3]=PKW(P1,14), pw3); \
    l_reg+=sacc; \
    if(GK){DMA_K((t)+3,sl_cur);} if(GV){DMA_V((t)+1,sl_next);} \
    CMASK(C0,C1,t); \
    if(MODE==2){ float a=MX3(C0[0],C0[1],C1[0]),b=MX3(C0[2],C0[3],C1[1]); a=MX3(a,C1[2],C1[3]); \
      _Pragma("unroll") for(int r=4;r<16;r+=4){a=MX3(a,C0[r],C0[r+1]);b=MX3(b,C0[r+2],C0[r+3]);a=MX3(a,C1[r],C1[r+1]);b=MX3(b,C1[r+2],C1[r+3]);} \
      float rm=__builtin_fmaxf(a,b); { auto rr=__builtin_amdgcn_permlane32_swap(__float_as_uint(rm),__float_as_uint(rm),false,false); rm=__builtin_fmaxf(__uint_as_float(rr[0]),__uint_as_float(rr[1])); } \
      resc=false; \
      if(__builtin_expect(__any(rm>(float)THRL),0)){ const float dl=__builtin_fmaxf(rm,0.f); mhat+=dl; \
        _Pragma("unroll") for(int r=0;r<16;++r){C0[r]-=dl;C1[r]-=dl;} \
        \
        const float f=__builtin_amdgcn_exp2f(-dl); l_reg*=f; if(hi==0)wsf[r32]=f; resc=true; } } \
    SBAR(); \
    GAPB(o[0]=__builtin_amdgcn_mfma_f32_32x32x16_bf16(PAF(0),VFR(0),o[0],0,0,0), C0,0,mkx); \
    GAPB(o[1]=__builtin_amdgcn_mfma_f32_32x32x16_bf16(PAF(0),VFR(4),o[1],0,0,0), C0,4,mkx); \
    KRD(GL,0); GAPB(o[0]=__builtin_amdgcn_mfma_f32_32x32x16_bf16(PAF(1),VFR(1),o[0],0,0,0), C0,8,mkx); \
    KRD(GL,1); GAPB(o[1]=__builtin_amdgcn_mfma_f32_32x32x16_bf16(PAF(1),VFR(5),o[1],0,0,0), C0,12,mkx); \
    KRD(GL,2); GAPB(o[0]=__builtin_amdgcn_mfma_f32_32x32x16_bf16(PAF(2),VFR(2),o[0],0,0,0), C1,0,mky); \
    KRD(GL,3); GAPB(o[1]=__builtin_amdgcn_mfma_f32_32x32x16_bf16(PAF(2),VFR(6),o[1],0,0,0), C1,4,mky); \
    GAPB(o[0]=__builtin_amdgcn_mfma_f32_32x32x16_bf16(PAF(3),VFR(3),o[0],0,0,0), C1,8,mky); \
    GAPB(o[1]=__builtin_amdgcn_mfma_f32_32x32x16_bf16(PAF(3),VFR(7),o[1],0,0,0), C1,12,mky); \
    }while(0)
  int t=1;
  for(;t+5<NT;t+=2){
    STEP(pB0,pB1,pA0,pA1,t,true,true,true);     WAIT_BAR(2); RESC(); ROT();
    STEP(pA0,pA1,pB0,pB1,t+1,true,true,true);   WAIT_BAR(2); RESC(); ROT();
  }
  #define ENDW(tt) do{ if((tt)+3<NT){WAIT_BAR(2);} else if((tt)+2<NT){WAIT_BAR(1);} else {WAIT_BAR(0);} }while(0)
  for(;t+1<NT;t+=2){
    STEP(pB0,pB1,pA0,pA1,t,(t+3<NT),(t+1<NT),(t+1<NT));       ENDW(t);   RESC(); ROT();
    STEP(pA0,pA1,pB0,pB1,t+1,(t+4<NT),(t+2<NT),(t+2<NT));
    if(t+2<NT){ ENDW(t+1); RESC(); ROT(); } else { RESC(); }
  }
  { float sacc=pA0[0]+pA0[1]; _Pragma("unroll") for(int r=2;r<16;++r)sacc+=pA0[r]; _Pragma("unroll") for(int r=0;r<16;++r)sacc+=pA1[r]; l_reg+=sacc;
    pw0=(u32x4){PKW(pA0,0),PKW(pA0,2),PKW(pA0,4),PKW(pA0,6)};pw1=(u32x4){PKW(pA0,8),PKW(pA0,10),PKW(pA0,12),PKW(pA0,14)};pw2=(u32x4){PKW(pA1,0),PKW(pA1,2),PKW(pA1,4),PKW(pA1,6)};pw3=(u32x4){PKW(pA1,8),PKW(pA1,10),PKW(pA1,12),PKW(pA1,14)};
    SBAR(); pv(o,vb0+sl_cur,PAF(0),PAF(1),PAF(2),PAF(3)); }
  #undef PKW
  #undef PAF
  #undef VFR
  #undef PIN
  #undef MX3
  #undef GAPA
  #undef GAPB
  #undef MSK
  #undef EX
  #undef VRD
  #undef KRD
  #undef STEP
  #undef ENDW
  {auto rr=__builtin_amdgcn_permlane32_swap(__float_as_uint(l_reg),__float_as_uint(l_reg),false,false);l_reg=__uint_as_float(rr[0])+__uint_as_float(rr[1]);}
  if(hi==0)wsf[32+r32]=l_reg;asm volatile("s_waitcnt lgkmcnt(0)":::"memory");
  float rli[16];
  #pragma unroll
  for(int r=0;r<16;++r)rli[r]=__builtin_amdgcn_rcpf(wsf[32+crow(r,hi)]);
  bf16*Ow=O+(rowbase+q0+wid*QBLK)*DM+h*D;
  { bf16*stg=(bf16*)(shm+LDS_OST)+wid*2048;
    #pragma unroll
    for(int r=0;r<16;++r){const int orow=crow(r,hi);
      #pragma unroll
      for(int d0=0;d0<2;++d0)stg[orow*64+d0*32+r32]=__float2bfloat16(o[d0][r]*rli[r]);}
    asm volatile("s_waitcnt lgkmcnt(0)":::"memory");
    #pragma unroll
    for(int i=0;i<4;++i){const int row=i*8+(lane>>3),ch=lane&7; const u32x4 v=*(const u32x4*)(stg+row*64+ch*8); ATTN_STORE16(Ow+(long)row*DM+ch*8,v);} }
  asm volatile("s_waitcnt lgkmcnt(0)\n\ts_barrier":::"memory");
  #undef DMA_K
  #undef DMA_V
  #undef CMASK
  #undef START
  #undef RESC
  #undef ROT
}
constexpr int ATTN_LDS_BYTES=LDS_BYTES;
#undef SBAR
#undef WAIT_BAR
}

constexpr int SCHED_OFF = 156 * 1024;
constexpr int CW_ATTQ = 8192;
template <int MODE> __device__ __forceinline__ void attn_phase_fa(const Ptrs& P, char* lds, int G, int bx, bf16* Oout, int lyr) {
    typedef attn_body::bf16 abf;
    if (MODE != 1) {
#pragma unroll 1
        for (int u = bx; u < 2048; u += G) {
            const int bh = (G == 256) ? ((u & 7) * 32 + ((u & 255) >> 3)) : (u & 255), qb = 7 - (u >> 8), b = bh >> 4, h = bh & 15;
            if (MODE == 2) attn_body::attn_unit<8, 2, 1024>(b, h, h, qb, (const abf*)WSP(bf16, OFF_QO), (const abf*)WSP(bf16, OFF_QO), (const abf*)WSP(bf16, OFF_QO), (abf*)Oout, lds, nullptr, nullptr, 0);
            else attn_body::attn_unit<8, 0, 256>(b, h, h >> 2, qb, (const abf*)WSP(bf16, OFF_QO), (const abf*)WSP(bf16, OFF_KA), (const abf*)WSP(bf16, OFF_VA), (abf*)Oout, lds, WSP(unsigned, OFF_MASK), nullptr, 0);
        }
    } else {
        volatile LAS unsigned* sch = (volatile LAS unsigned*)((LAS unsigned char*)lds + SCHED_OFF);
        unsigned* qhead = (unsigned*)(P.ws + OFF_CTL) + CW_ATTQ + 64 * (lyr & 1) + 128 * (Oout != WSP(bf16, OFF_QO));
#pragma unroll 1
        for (;;) {
            int tid_q = threadIdx.x; asm volatile("" : "+v"(tid_q));
            const int lane = tid_q & 63, wave = __builtin_amdgcn_readfirstlane(tid_q >> 6);
            if (wave == 0) {
                unsigned u = 0;
                if (lane == 0) u = __hip_atomic_fetch_add(qhead, 1u, __ATOMIC_RELAXED, __HIP_MEMORY_SCOPE_AGENT);
                u = (unsigned)__builtin_amdgcn_readfirstlane((int)u);
                unsigned t0 = 0;
                if (u < 2048u) {
                    const int bh = u & 255, qb = 7 - (int)(u >> 8);
                    const float* nb = WSP(float, OFF_NB) + (size_t)bh * KROWS;
                    const float lim = nb[PRE + 256 * qb] - WSP(float, OFF_GT)[GT_SKIP];
                    const int cand = 2 * lane;
                    const bool ok = cand <= 4 * qb && (cand == 0 || nb[64 * cand - 1] <= lim);
                    const unsigned long long m = __ballot(ok);
                    t0 = 2u * (unsigned)(63 - __builtin_clzll(m));
                }
                if (lane == 0) { sch[0] = u; sch[1] = t0; }
            }
            asm volatile("s_waitcnt vmcnt(0) lgkmcnt(0)\n\ts_barrier" ::: "memory");
            const unsigned u = sch[0], t0 = sch[1];
            if (u >= 2048u) break;
            const int bh = u & 255, qb = 7 - (int)(u >> 8), b = bh >> 4, h = bh & 15;
            attn_body::attn_unit<8, 1, 1024>(b, h, h, qb, (const abf*)WSP(bf16, OFF_QO), (const abf*)WSP(bf16, OFF_KB), (const abf*)WSP(bf16, OFF_VB), (abf*)Oout, lds, nullptr, WSP(float, OFF_NB) + (size_t)bh * KROWS, (int)t0);
        }
    }
}

typedef GAS unsigned gu32;
#define RLX_AGENT __ATOMIC_RELAXED, __HIP_MEMORY_SCOPE_AGENT
#define XB_TMO      128
#define XB_XCNT(j)  (256  + 64 * (j))
#define XB_XSUB(j)  (1280 + 64 * (j))
#define XB_XGEN(j)  (2304 + 64 * (j))
#define XB_TOP      3328
#define XB_TOPGEN   3392
#define XCD_BAR_WORDS 3456
#define XB_SPIN_CAP (1u << 18)

__device__ __forceinline__ unsigned xb_ld(unsigned* p)              { return __hip_atomic_load(p, __ATOMIC_RELAXED, __HIP_MEMORY_SCOPE_AGENT); }
__device__ __forceinline__ unsigned xb_add(unsigned* p, unsigned v) { return __hip_atomic_fetch_add(p, v, __ATOMIC_RELAXED, __HIP_MEMORY_SCOPE_AGENT); }
__device__ __forceinline__ unsigned xb_xcc_id() { return (unsigned)__builtin_amdgcn_s_getreg((3 << 11) | 20) & 0xFu; }
#define XB_SPIN(cond, bar) do { unsigned _sp = 0; while (cond) { __builtin_amdgcn_s_sleep(1); \
    if ((++_sp & 255u) == 0u) { if (xb_ld(&(bar)[XB_TMO])) break; if (_sp > XB_SPIN_CAP) { atomicAdd(&(bar)[XB_TMO], 1u); break; } } } } while (0)

struct XcdBarrier {
    unsigned* bar; unsigned x;
    volatile LAS unsigned* st;
};

__device__ __forceinline__ XcdBarrier xcd_barrier_post(unsigned* bar, volatile LAS unsigned* st) {
    XcdBarrier b; b.bar = bar; b.x = xb_xcc_id(); b.st = st;
    if (threadIdx.x == 0) (void)xb_add(&bar[XB_XCNT(b.x)], 1u);
    return b;
}
__device__ __forceinline__ void xcd_barrier_complete(unsigned* bar, unsigned x, unsigned& nloc, unsigned& nx) {
    const unsigned G = gridDim.x * gridDim.y * gridDim.z;
    unsigned sum, cnt, mine, sp = 0u;
    for (;;) {
        sum = 0u; cnt = 0u; mine = 0u;
#pragma unroll
        for (unsigned j = 0; j < 16; ++j) { const unsigned c = xb_ld(&bar[XB_XCNT(j)]); sum += c; cnt += (c > 0u) ? 1u : 0u; mine = (j == x) ? c : mine; }
        if (sum == G) break;
        __builtin_amdgcn_s_sleep(1);
        if ((++sp & 255u) == 0u) { if (xb_ld(&bar[XB_TMO])) break; if (sp > XB_SPIN_CAP) { atomicAdd(&bar[XB_TMO], 1u); break; } }
    }
    nloc = mine > 0u ? mine : 1u; nx = cnt > 0u ? cnt : 1u;
}

__device__ __forceinline__ void xcd_barrier(const XcdBarrier& b) {
    asm volatile("s_waitcnt vmcnt(0)" ::: "memory");
    __syncthreads();
    if (threadIdx.x == 0) {
        unsigned* bar = b.bar;
        __builtin_amdgcn_s_waitcnt(0);
        unsigned nloc = b.st[0], nx = b.st[1];
        if (nloc == 0u) { xcd_barrier_complete(bar, b.x, nloc, nx); b.st[0] = nloc; b.st[1] = nx; }
        const unsigned old = xb_add(&bar[XB_XSUB(b.x)], 1u);
        const unsigned gen = old / nloc;
        if (old + 1u == (gen + 1u) * nloc) {
            __builtin_amdgcn_fence(__ATOMIC_RELEASE, "agent");
            asm volatile("s_waitcnt vmcnt(0)" ::: "memory");
            const unsigned og = xb_add(&bar[XB_TOP], 1u);
            const unsigned tg = og / nx;
            if (og + 1u == (tg + 1u) * nx) xb_add(&bar[XB_TOPGEN], 1u);
            else XB_SPIN(xb_ld(&bar[XB_TOPGEN]) == tg, bar);
            __builtin_amdgcn_fence(__ATOMIC_ACQUIRE, "agent");
            xb_add(&bar[XB_XGEN(b.x)], 1u);
            asm volatile("s_waitcnt vmcnt(0)" ::: "memory");
        } else {
            XB_SPIN(xb_ld(&bar[XB_XGEN(b.x)]) == gen, bar);
            __builtin_amdgcn_fence(__ATOMIC_ACQUIRE, "agent");
            asm volatile("s_waitcnt vmcnt(0)" ::: "memory");
        }
    }
    __syncthreads();
}


constexpr int NWAVES = 8;
constexpr int LDS_BYTES = 160 * 1024;
constexpr int MISC_OFF = LDS_BYTES - 256;
constexpr int CW_BAR = 4096;

struct Args { Ptrs P; int ph_lo, ph_hi; };
constexpr int N_PHASES = 1 + 8 * 4;
#ifndef PROBE_ID
#define PROBE_ID 0
#endif
#ifndef PROBE_DRY
#define PROBE_DRY 0
#endif
#ifndef PROBE_REPS
#define PROBE_REPS 3
#endif

#define SITE_IDS() int tid_s = threadIdx.x; asm volatile("" : "+v"(tid_s)); const int lane = tid_s & 63; const int wave = __builtin_amdgcn_readfirstlane(tid_s >> 6); \
    const int gw = bx * NWAVES + wave; (void)gw; (void)lane
__global__ void __launch_bounds__(NWAVES * 64, 2) mega_fwd(Args args) {
    extern __shared__ __attribute__((aligned(16))) unsigned char lds[];
    const Ptrs& P = args.P;
    const int G = gridDim.x, bx = blockIdx.x, ngw = G * NWAVES;
    volatile LAS unsigned* MISC = (volatile LAS unsigned*)((LAS unsigned char*)lds + MISC_OFF);
    for (int u = threadIdx.x; u < 64; u += NWAVES * 64) MISC[u] = 0u;
    __syncthreads();
    XcdBarrier bar = xcd_barrier_post((unsigned*)(P.ws + OFF_CTL) + CW_BAR, MISC + 8);
    const int lo = args.ph_lo, hi = args.ph_hi;
#define IN(k) (lo <= (k) && (k) < hi)
#define SEAM(k) do { if (IN(k) && IN((k) + 1)) xcd_barrier(bar); } while (0)
#define WSCR() ((float*)lds + wave * (64 * 65))

#define REPS(id) ((PROBE_ID == (id)) ? PROBE_REPS : 1)
#pragma unroll 1
    for (int rp = REPS(9); rp > 0; --rp) { if (IN(0)) { SITE_IDS(); prologue_work(P, gw, ngw, WSCR(), lane); } SEAM(0); }
#pragma unroll 1
    for (int l = 0; l < 4; ++l) {
        const int pb = 1 + 8 * l;
        if (l < 2) {
#pragma unroll 1
            for (int rp = REPS(1); rp > 0; --rp) {
            if (IN(pb + 0)) {
                { SITE_IDS(); if (l == 0 && rp == 1) for (int j = gw; j < 4 * D; j += ngw) colsum_job(P, j, lane);
                  for (int j = bx; j < 33; j += G) strip_job(P, SP_INA, l, M / 16, j, lane, 8, wave, (float*)lds);
                  for (int j = gw; j < M / 16; j += ngw) strip_job(P, SP_INA, l, j, 32, lane); }
                { pg8::Gemm g{WSP(bf16, OFF_H8A), WSP(bf16, OFF_WIN8 + l * SZ_WIN8), M, 1536, D / 2}; pg8::StaticOrder So; So.init(M, 1536, G, bx);
                  EpiInA E{P, l, 1, 0};
                  pg8::gemm_phase<EpiInA, pg8::StaticOrder, true, true, 1, true>((LAS unsigned char*)lds, g, So, E); }
                { pg8::Gemm g{WSP(bf16, OFF_H), WSP(bf16, OFF_WIN + l * SZ_WIN) + (size_t)1536 * D, M, 512, D}; pg8::StaticOrder So; So.init(M, 512, G, bx);
                  EpiInA E{P, l, 0, 6};
                  pg8::gemm_phase<EpiInA, pg8::StaticOrder, true, true>((LAS unsigned char*)lds, g, So, E); }
                { SITE_IDS(); zero_pads(P, gw, ngw, lane); }
            }
            SEAM(pb + 0); }
#pragma unroll 1
            for (int rp = REPS(2); rp > 0; --rp) {
            if (IN(pb + 1)) { SITE_IDS();
                const int itv = (G == 256) ? ((bx & 7) * 256 + (bx >> 3) * 8 + wave) : gw;
                for (int it = itv; it < NB * 128; it += ngw) { const int b = it >> 7, w = it & 127;
#pragma unroll 1
                    for (int j = 0; j < 8; ++j) { const int g2 = 128 * j + ((j & 1) ? 127 - w : w); indexer_pass(P, b, g2, lane, (LAS unsigned*)lds + wave * (IDX_LDS_PER_WAVE / 4), rp > 1 ? PROBE_DRY : 0); } } }
            SEAM(pb + 1); }
#pragma unroll 1
            for (int rp = REPS(3); rp > 0; --rp) {
            if (IN(pb + 2)) {
                { SITE_IDS(); attn_naive_work<0>(P, gw, ngw, WSCR(), lane, M, MR); }
                __syncthreads();
                if (PROBE_DRY && rp > 1) attn_phase_fa<2>(P, (char*)lds, G, bx, (bf16*)P.out, l); else
                attn_phase_fa<0>(P, (char*)lds, G, bx, rp > 1 ? (bf16*)P.out : WSP(bf16, OFF_QO), l);
            }
            SEAM(pb + 2); }
        } else {
#pragma unroll 1
            for (int rp = REPS(7); rp > 0; --rp) {
            if (IN(pb + 0)) {
                if (l == 2) { SITE_IDS(); for (int j = bx; j < 33; j += G) strip_job(P, SP_QKVB, l, M / 16, 16 + j, lane, 8, wave, (float*)lds);
                  for (int j = gw; j < M / 16; j += ngw) strip_job(P, SP_QKVB, l, j, 48, lane); }
                pg8::Gemm g{WSP(bf16, OFF_H8B), WSP(bf16, OFF_WQKV8 + (l == 2 ? 0 : size_t(3072) * D)), M, l == 2 ? 3072 : 1024, D / 2}; pg8::StaticOrder So; So.init(M, g.N, G, bx);
                EpiInB E{P, l};
                pg8::gemm_phase<EpiInB, pg8::StaticOrder, true, true, 1, true>((LAS unsigned char*)lds, g, So, E);
            }
            SEAM(pb + 0); }
            if (IN(pb + 1) && l == 2) { SITE_IDS(); for (int bh = bx; bh < 256; bh += G) scan_work(P, bh, (float*)lds, tid_s); }
            SEAM(pb + 1);
#pragma unroll 1
            for (int rp = REPS(8); rp > 0; --rp) {
            if (IN(pb + 2)) attn_phase_fa<1>(P, (char*)lds, G, bx, rp > 1 ? (bf16*)P.out : WSP(bf16, OFF_QO), l);
            SEAM(pb + 2); }
        }
#pragma unroll 1
        for (int rp = REPS(4); rp > 0; --rp) {
        if (IN(pb + 3)) {
            if (l < 2 && rp == 1) { SITE_IDS(); for (int j = bx; j < 16; j += G) strip_job(P, SP_RES_O, l, M / 16, j, lane, 8, wave, (float*)lds); }
            pg8::Gemm g{WSP(bf16, OFF_QO), wo_t(P, l), M, D, D}; pg8::StaticOrder So; So.init(M, D, G, bx);
            EpiRes<false> E{P, l, rp > 1};
            pg8::gemm_phase<EpiRes<false>, pg8::StaticOrder, true, true>((LAS unsigned char*)lds, g, So, E);
        }
        SEAM(pb + 3); }
#pragma unroll 1
        for (int rp = REPS(5); rp > 0; --rp) {
        if (IN(pb + 4)) {
            if (l < 2) { SITE_IDS(); for (int j = bx; j < 64; j += G) strip_job(P, SP_MLP1, l, M / 16, j, lane, 8, wave, (float*)lds); }
            pg8::Gemm g{WSP(bf16, OFF_HQ), WSP(bf16, OFF_W18 + l * SZ_W28), M, FF, D / 2}; pg8::StaticOrder So; So.init(M, FF, G, bx);
            EpiRelu2 E{P, l, (PROBE_DRY && rp > 1) ? 1 : 0};
            pg8::gemm_phase<EpiRelu2, pg8::StaticOrder, true, true, 2, true>((LAS unsigned char*)lds, g, So, E);
        }
        SEAM(pb + 4); }
#pragma unroll 1
        for (int rp = REPS(6); rp > 0; --rp) {
        if (IN(pb + 5)) {
            if (l < 2 && rp == 1) { SITE_IDS(); for (int j = bx; j < 16; j += G) strip_job(P, SP_RES_M, l, M / 16, j, lane, 8, wave, (float*)lds); }
            pg8::StaticOrder So; So.init(M, D, G, bx); EpiRes<true> E{P, l, rp > 1};
            pg8::Gemm g{WSP(bf16, OFF_U), WSP(bf16, OFF_W28 + l * SZ_W28), M, D, FF / 2};
            pg8::gemm_phase<EpiRes<true>, pg8::StaticOrder, true, true, 2, true>((LAS unsigned char*)lds, g, So, E);
        }
        if (rp > 1 || (l < 3 && IN(pb + 5) && IN(pb + 8))) xcd_barrier(bar); }
    }
#undef IN
#undef SEAM
}

#ifndef MK_ONE_LAUNCH
#define MK_ONE_LAUNCH 1
#endif
extern "C" void kernel_launch(void* const* d_in, const int* in_sizes, int n_in, void* d_out, int out_size, void* d_ws, size_t ws_size, hipStream_t stream) {
    static int grid = 0;
    if (grid == 0) {
        if (n_in != 17 || in_sizes[0] != M * D || out_size != M * D || ws_size < WS_END) {
            fprintf(stderr, "kernel_launch: unexpected shapes (n_in %d, in0 %d, out %d, ws %zu, need %zu)\n", n_in, n_in > 0 ? in_sizes[0] : -1, out_size, ws_size, (size_t)WS_END); grid = -1; return; }
        int dev = 0, cus = 0, per_cu = 0;
        if (hipGetDevice(&dev) != hipSuccess || hipDeviceGetAttribute(&cus, hipDeviceAttributeMultiprocessorCount, dev) != hipSuccess) { grid = -1; return; }
        if (hipFuncSetAttribute((const void*)mega_fwd, hipFuncAttributeMaxDynamicSharedMemorySize, LDS_BYTES) != hipSuccess) { fprintf(stderr, "kernel_launch: hipFuncSetAttribute failed\n"); grid = -1; return; }
        if (hipOccupancyMaxActiveBlocksPerMultiprocessor(&per_cu, (const void*)mega_fwd, NWAVES * 64, LDS_BYTES) != hipSuccess || per_cu < 1)
            fprintf(stderr, "kernel_launch: note: occupancy query reports %d workgroups per CU\n", per_cu);
        (void)hipGetLastError();
        grid = cus;
    }
    if (grid < 0) return;
    (void)hipMemsetAsync((char*)d_ws + OFF_CTL, 0, 65536, stream);
    Args a{};
    for (int i = 0; i < 17; ++i) a.P.in[i] = (const float*)d_in[i];
    a.P.out = (float*)d_out; a.P.ws = (unsigned char*)d_ws;
#if MK_ONE_LAUNCH
    a.ph_lo = 0; a.ph_hi = N_PHASES;
    hipLaunchKernelGGL(mega_fwd, dim3(grid), dim3(NWAVES * 64), LDS_BYTES, stream, a);
#else
    for (int ph = 0; ph < N_PHASES; ++ph) { a.ph_lo = ph; a.ph_hi = ph + 1; hipLaunchKernelGGL(mega_fwd, dim3(grid), dim3(NWAVES * 64), LDS_BYTES, stream, a); }
#endif
}
```

```cpp
#include <hip/hip_runtime.h>
#include <cstdint>
#include <cstdio>

typedef unsigned short bf16;
typedef short bf16x8 __attribute__((ext_vector_type(8)));
typedef float f32x4 __attribute__((ext_vector_type(4)));
typedef float f32x16 __attribute__((ext_vector_type(16)));
typedef unsigned u32x4 __attribute__((ext_vector_type(4)));

constexpr int NB = 16, S = 2048, D = 1024, NMETA = 16, HD = 64, FF = 4096;
constexpr int M = NB * S, MR = M + NMETA;
constexpr int PRE = 64, KROWS = PRE + S;
constexpr int NWORDS = KROWS / 32;
constexpr int NPOS = S + NMETA;
constexpr int WIN_ROWS = 2048 + 96, WKV_ROWS = 2048 + 32;
constexpr float EPS = 1e-6f;
constexpr float LOG2E = 1.4426950408889634f;
constexpr float C2 = 0.125f * LOG2E;
constexpr int TOPK = 256;

constexpr size_t al4k(size_t x) { return (x + 4095) & ~size_t(4095); }
constexpr size_t OFF_CTL = 0, SZ_CTL = size_t(4) << 20;
constexpr size_t OFF_ROPE = OFF_CTL + SZ_CTL, SZ_ROPE = al4k(size_t(2) * NPOS * 32 * 4);
constexpr size_t OFF_SSQ = OFF_ROPE + SZ_ROPE, SZ_SSQ1 = al4k(size_t(MR) * 16 * 4);
constexpr size_t OFF_GT = OFF_SSQ + 2 * SZ_SSQ1, SZ_GT = 4096;
constexpr int GT_AQG = 0, GT_AKG = 128, GT_KFB = 256, GT_KKG = 272, GT_BQG = 336, GT_N = 464, GT_SKIP = 464;
constexpr size_t OFF_W1B = OFF_GT + SZ_GT;
constexpr size_t SZ_W1 = size_t(FF) * D * 2, SZ_W2 = SZ_W1, SZ_SQ = size_t(D) * D * 2;
constexpr size_t OFF_W2B = OFF_W1B + 2 * SZ_W1;
constexpr size_t OFF_WOB = OFF_W2B + 2 * SZ_W2;
constexpr size_t OFF_WQ1 = OFF_WOB + 2 * SZ_SQ;
constexpr size_t OFF_WQ0 = OFF_WQ1 + SZ_SQ;
constexpr size_t OFF_WKV = OFF_WQ0 + SZ_SQ, SZ_WKV = al4k(size_t(WKV_ROWS) * D * 2);
constexpr size_t OFF_H = OFF_WKV + SZ_WKV, SZ_H = al4k(size_t(MR) * D * 2);
constexpr size_t OFF_SCR = OFF_H + SZ_H;
constexpr size_t OFF_U = OFF_SCR, SZ_U = al4k(size_t(MR) * FF * 2);
constexpr size_t OFF_QO = OFF_SCR, SZ_QO = al4k(size_t(MR) * D * 2);
constexpr size_t OFF_KA = OFF_QO + SZ_QO, SZ_KA = al4k(size_t(NB) * KROWS * 256 * 2 + 65536);
constexpr size_t OFF_VA = OFF_KA + SZ_KA;
constexpr size_t OFF_KI = OFF_VA + SZ_KA, SZ_KI = al4k(size_t(NB) * KROWS * 64 * 2 + 65536);
constexpr size_t OFF_QI = OFF_KI + SZ_KI, SZ_QI = al4k(size_t(MR) * 512 * 2);
constexpr size_t OFF_WI = OFF_QI + SZ_QI, SZ_WI = al4k(size_t(MR) * 8 * 4);
constexpr size_t OFF_MASK = OFF_WI + SZ_WI, SZ_MASK = al4k(size_t(M) * NWORDS * 4);
constexpr size_t OFF_LF = OFF_MASK + SZ_MASK, SZ_LF = al4k(size_t(MR) * 16 * 4);
constexpr size_t OFF_UM = OFF_U + size_t(M) * FF * 2;
constexpr size_t OFF_W28 = OFF_W2B, SZ_W28 = size_t(D) * FF;
constexpr size_t OFF_W18 = OFF_W1B;
static_assert(OFF_LF + SZ_LF <= OFF_U + SZ_U && OFF_UM + size_t(16) * FF * 2 <= OFF_U + SZ_U && 4 * SZ_W28 <= 2 * SZ_W2, "mixer scratch / hidden / fp8 W2 fit");
constexpr size_t OFF_X = OFF_SCR + SZ_U;
constexpr size_t SZ_WIN = al4k(size_t(WIN_ROWS) * D * 2);
constexpr size_t OFF_WIN = OFF_X;
constexpr size_t OFF_WOA = OFF_WIN + 2 * SZ_WIN;
constexpr size_t OFF_W1A = OFF_WOA + 2 * SZ_SQ;
constexpr size_t OFF_W2A = OFF_W1A + 2 * SZ_W1;
constexpr size_t OFF_KB = OFF_X, SZ_KB = al4k(size_t(NB) * KROWS * D * 2 + 262144);
constexpr size_t OFF_VB = OFF_KB + SZ_KB;
constexpr size_t OFF_NB = OFF_VB + SZ_KB, SZ_NB = al4k(size_t(NB) * 16 * KROWS * 4);
constexpr size_t WS_END = OFF_NB + SZ_NB;
constexpr size_t SZ_H8 = size_t(M) * D, OFF_H8A = OFF_X + (size_t(48) << 20), OFF_H8B = OFF_SCR + (size_t(160) << 20);
constexpr size_t SZ_WIN8 = size_t(2048) * D, OFF_WIN8 = OFF_H8A + SZ_H8;
constexpr size_t OFF_WQKV8 = WS_END;
constexpr size_t OFF_HQ = OFF_SCR + (size_t(192) << 20);
constexpr int EPI_RS_OFF = 132 * 1024;
constexpr int CW_CS = 12288;
constexpr float QA = 127.f / 4.25f, QW1 = 127.f * 32.f / 4.f, QU = 255.f / 20.f, QW2 = 127.f * 64.f / 4.f, SQRT_QU = 3.5707142143f;
constexpr float IN_F8S = 32.f;
static_assert(OFF_W2A + 2 * SZ_W2 <= OFF_H8A && OFF_WIN8 + 2 * SZ_WIN8 <= WS_END && OFF_LF + SZ_LF <= OFF_H8B && size_t(M) * FF <= (size_t(160) << 20) && OFF_H8B + SZ_H8 <= OFF_HQ && OFF_HQ + SZ_H8 <= OFF_UM && OFF_WQKV8 + size_t(4096) * D <= (size_t(512) << 20), "8-bit buffers fit");
static_assert(OFF_W2A + 2 * SZ_W2 <= WS_END, "A weights fit in region X");
static_assert(WS_END <= (size_t(512) << 20), "d_ws map fits 512 MiB");

#define GAS __attribute__((address_space(1)))
#define LAS __attribute__((address_space(3)))
__device__ __forceinline__ unsigned f2bf(float f) { unsigned u = __builtin_bit_cast(unsigned, f); return (u + 0x7fffu + ((u >> 16) & 1u)) >> 16; }
__device__ __forceinline__ float bf2f(unsigned h) { return __builtin_bit_cast(float, h << 16); }
__device__ __forceinline__ unsigned pk2(float lo, float hi) { return f2bf(lo) | (f2bf(hi) << 16); }
typedef unsigned u32x2 __attribute__((ext_vector_type(2)));
__device__ __forceinline__ size_t blk8(int R, int c, int rowlen) { return ((size_t)(R >> 4) * (rowlen / 32) + (c >> 5)) * 512 + (R & 15) * 32 + (c & 31); }
typedef int i32x4v __attribute__((ext_vector_type(4)));
__device__ __forceinline__ unsigned pk4_fp8(float a, float b, float c, float d) {
    a = fminf(fmaxf(a, -448.f), 448.f); b = fminf(fmaxf(b, -448.f), 448.f); c = fminf(fmaxf(c, -448.f), 448.f); d = fminf(fmaxf(d, -448.f), 448.f);
    int p = __builtin_amdgcn_cvt_pk_fp8_f32(a, b, 0, false); p = __builtin_amdgcn_cvt_pk_fp8_f32(c, d, p, true); return (unsigned)p; }
__device__ __forceinline__ unsigned pk4_i8(float a, float b, float c, float d) {
    a += 128.f; b += 128.f; c += 128.f; d += 128.f;
    int p = __builtin_amdgcn_cvt_pk_u8_f32(a, 0, 0); p = __builtin_amdgcn_cvt_pk_u8_f32(b, 1, p); p = __builtin_amdgcn_cvt_pk_u8_f32(c, 2, p); p = __builtin_amdgcn_cvt_pk_u8_f32(d, 3, p);
    return (unsigned)p ^ 0x80808080u; }
__device__ __forceinline__ float red16(float v) { v += __shfl_xor(v, 1); v += __shfl_xor(v, 2); v += __shfl_xor(v, 4); v += __shfl_xor(v, 8); return v; }
__device__ __forceinline__ float wave_sum(float v) {
#pragma unroll
    for (int o = 1; o < 64; o <<= 1) v += __shfl_xor(v, o);
    return v;
}
__device__ __forceinline__ float wave_max(float v) {
#pragma unroll
    for (int o = 1; o < 64; o <<= 1) v = fmaxf(v, __shfl_xor(v, o));
    return v;
}

struct Ptrs {
    const float* in[17]; float* out; unsigned char* ws;
};
#define WSP(T, off) ((T*)(P.ws + (off)))
__device__ __forceinline__ bf16* w1_t(const Ptrs& P, int l) { return l < 2 ? WSP(bf16, OFF_W1A + l * SZ_W1) : WSP(bf16, OFF_W1B + (l - 2) * SZ_W1); }
__device__ __forceinline__ bf16* w2_t(const Ptrs& P, int l) { return l < 2 ? WSP(bf16, OFF_W2A + l * SZ_W2) : WSP(bf16, OFF_W2B + (l - 2) * SZ_W2); }
__device__ __forceinline__ bf16* wo_t(const Ptrs& P, int l) { return l < 2 ? WSP(bf16, OFF_WOA + l * SZ_SQ) : WSP(bf16, OFF_WOB + (l - 2) * SZ_SQ); }
__device__ __forceinline__ float* ssq_p(const Ptrs& P, int k) { return WSP(float, OFF_SSQ + (size_t)(k & 1) * SZ_SSQ1); }

struct MatDesc { const float* W; int pitch, K, col0, ncols, nblk; const float* gain; bf16* WT; int dst0, perm; unsigned char* WT8; float s8; int q8; int* cs; };
__device__ __forceinline__ bool get_mat(const Ptrs& P, int id, MatDesc& d) {
    d.gain = nullptr; d.perm = 0; d.dst0 = 0; d.col0 = 0; d.WT8 = nullptr; d.s8 = IN_F8S; d.q8 = 0; d.cs = nullptr;
    if (id < 2) { d.W = P.in[6] + (size_t)id * D * 2120; d.pitch = 2120; d.K = D; d.ncols = 2048; d.nblk = 64; d.gain = P.in[2] + id * D; d.WT = WSP(bf16, OFF_WIN + id * SZ_WIN); d.perm = 1; d.WT8 = WSP(unsigned char, OFF_WIN8 + id * SZ_WIN8); return true; }
    if (id < 4) { const int l = id - 2; d.W = P.in[6] + (size_t)l * D * 2120; d.pitch = 2120; d.K = D; d.col0 = 2048; d.ncols = 72; d.nblk = 3; d.gain = P.in[2] + l * D; d.WT = WSP(bf16, OFF_WIN + l * SZ_WIN); d.dst0 = 2048; return true; }
    if (id < 6) { const int l = id - 4; d.W = P.in[9] + (size_t)l * D * D; d.pitch = D; d.K = D; d.ncols = D; d.nblk = 32; d.WT = WSP(bf16, OFF_WOA + l * SZ_SQ); return true; }
    if (id < 10) { const int l = id - 6; d.W = P.in[4] + (size_t)l * D * FF; d.pitch = FF; d.K = D; d.ncols = FF; d.nblk = 128; d.gain = P.in[3] + l * D; d.WT = l < 2 ? w1_t(P, l) : nullptr; d.WT8 = WSP(unsigned char, OFF_W18 + l * SZ_W28); d.s8 = QW1; d.q8 = 1; return true; }
    if (id < 14) { const int l = id - 10; d.W = P.in[5] + (size_t)l * FF * D; d.pitch = D; d.K = FF; d.ncols = D; d.nblk = 32; d.WT = l < 2 ? w2_t(P, l) : nullptr; d.WT8 = WSP(unsigned char, OFF_W28 + l * SZ_W28); d.s8 = QW2; d.q8 = 1; return true; }
    if (id == 14) { d.W = P.in[11]; d.pitch = 2064; d.K = D; d.col0 = 0; d.ncols = 1024; d.nblk = 32; d.gain = P.in[10]; d.WT = WSP(bf16, OFF_WKV); d.perm = 1; d.WT8 = WSP(unsigned char, OFF_WQKV8 + size_t(1024) * D); return true; }
    if (id == 15) { d.W = P.in[11]; d.pitch = 2064; d.K = D; d.col0 = 1024; d.ncols = 1024; d.nblk = 32; d.gain = P.in[10]; d.WT = WSP(bf16, OFF_WKV); d.perm = 1; d.dst0 = 1024; d.WT8 = WSP(unsigned char, OFF_WQKV8 + size_t(1024) * D); return true; }
    if (id == 16) { d.W = P.in[11]; d.pitch = 2064; d.K = D; d.col0 = 2048; d.ncols = 16; d.nblk = 1; d.gain = P.in[10]; d.WT = WSP(bf16, OFF_WKV); d.dst0 = 2048; return true; }
    if (id < 19) { const int j = id - 17; d.W = P.in[14] + (size_t)j * D * D; d.pitch = D; d.K = D; d.ncols = D; d.nblk = 32; d.gain = P.in[2] + (2 + j) * D; d.WT = WSP(bf16, j == 0 ? OFF_WQ0 : OFF_WQ1); d.perm = 1; d.WT8 = WSP(unsigned char, OFF_WQKV8 + (j == 0 ? 0 : size_t(3072) * D)); return true; }
    if (id < 21) { const int j = id - 19; d.W = P.in[16] + (size_t)j * D * D; d.pitch = D; d.K = D; d.ncols = D; d.nblk = 32; d.WT = WSP(bf16, OFF_WOB + j * SZ_SQ); return true; }
    return false;
}
constexpr int NMAT = 21;
__device__ __forceinline__ void transpose_block(const MatDesc& d, int item, float* scr, int lane) {
    const int nb64 = (d.nblk + 1) >> 1, kb = item / nb64, nb = item % nb64, k0 = 64 * kb, n0 = 64 * nb;
    const int c4 = lane & 15; const bool okc = (n0 + 4 * c4) < d.ncols;
#pragma unroll 8
    for (int i = 0; i < 16; ++i) { const int kk = 4 * i + (lane >> 4);
        f32x4 v = okc ? *(const f32x4*)(d.W + (size_t)(k0 + kk) * d.pitch + d.col0 + n0 + 4 * c4) : (f32x4){0.f, 0.f, 0.f, 0.f};
        if (d.gain) v = v * d.gain[k0 + kk];
        float* sp = scr + kk * 65 + 4 * c4; sp[0] = v[0]; sp[1] = v[1]; sp[2] = v[2]; sp[3] = v[3]; }
    __builtin_amdgcn_s_waitcnt(0xc07f); asm volatile("" ::: "memory");
    const int c = lane & 7;
#pragma unroll
    for (int hb = 0; hb < 2; ++hb) {
        const int nn0 = n0 + 32 * hb; if (nn0 >= 32 * d.nblk) break;
        int drow0;
        if (d.perm) { const int pn = nn0 >> 8, wc = (nn0 & 255) >> 6, bj = (nn0 & 63) >> 5; drow0 = d.dst0 + 256 * pn + 128 * bj + 32 * wc; }
        else drow0 = d.dst0 + nn0;
#pragma unroll
        for (int j = 0; j < 4; ++j) { const int n = (lane >> 3) + 8 * j; const float* sq = scr + (8 * c) * 65 + 32 * hb + n;
            u32x4 o; o.x = pk2(sq[0 * 65], sq[1 * 65]); o.y = pk2(sq[2 * 65], sq[3 * 65]); o.z = pk2(sq[4 * 65], sq[5 * 65]); o.w = pk2(sq[6 * 65], sq[7 * 65]);
            if (d.WT) *(u32x4*)(d.WT + (size_t)(drow0 + n) * d.K + k0 + 8 * c) = o;
            if (d.WT8) { u32x2 o8;
                if (d.q8) { o8.x = pk4_i8(sq[0 * 65] * d.s8, sq[1 * 65] * d.s8, sq[2 * 65] * d.s8, sq[3 * 65] * d.s8); o8.y = pk4_i8(sq[4 * 65] * d.s8, sq[5 * 65] * d.s8, sq[6 * 65] * d.s8, sq[7 * 65] * d.s8); }
                else { o8.x = pk4_fp8(sq[0 * 65] * d.s8, sq[1 * 65] * d.s8, sq[2 * 65] * d.s8, sq[3 * 65] * d.s8); o8.y = pk4_fp8(sq[4 * 65] * d.s8, sq[5 * 65] * d.s8, sq[6 * 65] * d.s8, sq[7 * 65] * d.s8); }
                *(u32x2*)(d.WT8 + (size_t)(drow0 + n) * d.K + k0 + 8 * c) = o8; } }
    }
    __builtin_amdgcn_s_waitcnt(0xc07f); asm volatile("" ::: "memory");
}
__device__ __forceinline__ void prologue_work(const Ptrs& P, int gw, int ngw, float* scr, int lane) {
    int base = 0;
    for (int id = 0; id < NMAT; ++id) {
        MatDesc d; get_mat(P, id, d);
        const int nit = (d.K / 64) * ((d.nblk + 1) >> 1);
        int first = (gw - base % ngw + ngw) % ngw;
        for (int it = first; it < nit; it += ngw) transpose_block(d, it, scr, lane);
        base += nit;
    }
    bf16* H = WSP(bf16, OFF_H); float* ssq0 = ssq_p(P, 0);
    for (int r = gw; r < MR; r += ngw) {
        const float* src = r < M ? P.in[0] + (size_t)r * D : P.in[1] + (size_t)(r - M) * D;
        float s = 0.f;
#pragma unroll
        for (int j = 0; j < 4; ++j) { const f32x4 v = *(const f32x4*)(src + 256 * j + 4 * lane); s += v.x * v.x + v.y * v.y + v.z * v.z + v.w * v.w;
            uint2 o; o.x = pk2(v.x, v.y); o.y = pk2(v.z, v.w); *(uint2*)(H + (size_t)r * D + 256 * j + 4 * lane) = o;
            if (r < M) *(unsigned*)(WSP(unsigned char, OFF_H8A) + blk8(r, 256 * j + 4 * lane, D)) = pk4_fp8(v.x, v.y, v.z, v.w); }
        s = wave_sum(s); if (lane < 16) ssq0[(size_t)r * 16 + lane] = lane == 0 ? s : 0.f;
    }
    if (gw == 0) { float* GT = WSP(float, OFF_GT);
        for (int e = lane; e < GT_N; e += 64) { float v;
            if (e < GT_AKG) v = P.in[7][e]; else if (e < GT_KFB) v = P.in[8][e - GT_AKG]; else if (e < GT_KKG) v = P.in[12][e - GT_KFB]; else if (e < GT_BQG) v = P.in[13][e - GT_KKG]; else v = P.in[15][e - GT_BQG];
            GT[e] = v; }
        { float gq = 0.f, gk = 0.f;
          for (int e = lane; e < 128; e += 64) gq = fmaxf(gq, fabsf(P.in[15][e]));
          gk = fabsf(P.in[13][lane]);
          gq = wave_max(gq); gk = wave_max(gk);
          if (lane == 0) GT[GT_SKIP] = 2.0f * 64.0f * C2 * gq * gk + 24.0f; } }
    float* COS = WSP(float, OFF_ROPE); float* SIN = COS + NPOS * 32;
    for (int e = gw * 64 + lane; e < NPOS * 32; e += ngw * 64) { const int pos = e >> 5, i = e & 31;
        const float inv = 1.0f / powf(10000.0f, (float)(2 * i) / 64.0f); const float ang = (float)pos * inv;
        COS[e] = (float)cos((double)ang); SIN[e] = (float)sin((double)ang); }
}
__device__ __forceinline__ void zero_pads(const Ptrs& P, int gw, int ngw, int lane) {
    bf16* KA = WSP(bf16, OFF_KA); bf16* VA = WSP(bf16, OFF_VA); bf16* KI = WSP(bf16, OFF_KI);
    unsigned zz = 0u; asm volatile("" : "+v"(zz));
    for (int e = gw * 64 + lane; e < NB * 48 * 32; e += ngw * 64) { const int b = e / (48 * 32), r = (e / 32) % 48 + 16, c = e % 32;
        const u32x4 z = {zz, zz, zz, zz};
        *(u32x4*)(KA + ((size_t)b * KROWS + r) * 256 + c * 8) = z; *(u32x4*)(VA + ((size_t)b * KROWS + r) * 256 + c * 8) = z;
        if (c < 8) *(u32x4*)(KI + ((size_t)b * KROWS + r) * 64 + c * 8) = z; }
}
__device__ __forceinline__ void colsum_job(const Ptrs& P, int j, int lane) {
    const u32x4* src = (const u32x4*)(WSP(unsigned char, OFF_W28) + (size_t)j * FF); int t = 0;
#pragma unroll
    for (int i = 0; i < 4; ++i) { const u32x4 v = src[i * 64 + lane];
        t = __builtin_amdgcn_sdot4((int)v.x, 0x01010101, t, false); t = __builtin_amdgcn_sdot4((int)v.y, 0x01010101, t, false); t = __builtin_amdgcn_sdot4((int)v.z, 0x01010101, t, false); t = __builtin_amdgcn_sdot4((int)v.w, 0x01010101, t, false); }
#pragma unroll
    for (int o = 1; o < 64; o <<= 1) t += __shfl_xor(t, o);
    if (lane == 0) ((int*)(P.ws + OFF_CTL) + CW_CS)[j] = t;
}
template <int NCT>
__device__ __forceinline__ bool strip_mma(const bf16* A, int lda, const bf16* Bt, const int* brow, int K, f32x4 (&acc)[NCT], int lane, int ks = 1, int wave = 0, float* red = nullptr) {
    const int fr = lane & 15, fq = lane >> 4;
    const int kb = ks == 1 ? 0 : wave * (K / 8), ke = ks == 1 ? K : kb + K / 8;
    const bf16* ap = A + (size_t)fr * lda + 8 * fq;
    const bf16* bp[NCT];
#pragma unroll
    for (int j = 0; j < NCT; ++j) { bp[j] = Bt + (size_t)(brow[j] + fr) * K + 8 * fq; acc[j] = (f32x4){0.f, 0.f, 0.f, 0.f}; }
    bf16x8 ca[2], cb[2][NCT], na[2], nb[2][NCT];
#define SM_LOAD(da, db, k0_) do { _Pragma("unroll") for (int h_ = 0; h_ < 2; ++h_) { da[h_] = *(const bf16x8*)(ap + (k0_) + 32 * h_); \
        _Pragma("unroll") for (int j_ = 0; j_ < NCT; ++j_) db[h_][j_] = *(const bf16x8*)(bp[j_] + (k0_) + 32 * h_); } } while (0)
    SM_LOAD(ca, cb, kb);
#pragma unroll 1
    for (int k0 = kb; k0 < ke; k0 += 64) {
        const int kn = k0 + 64 < ke ? k0 + 64 : k0;
        SM_LOAD(na, nb, kn);
#pragma unroll
        for (int h = 0; h < 2; ++h)
#pragma unroll
            for (int j = 0; j < NCT; ++j) acc[j] = __builtin_amdgcn_mfma_f32_16x16x32_bf16(ca[h], cb[h][j], acc[j], 0, 0, 0);
#pragma unroll
        for (int h = 0; h < 2; ++h) { ca[h] = na[h];
#pragma unroll
            for (int j = 0; j < NCT; ++j) cb[h][j] = nb[h][j]; }
    }
#undef SM_LOAD
    if (ks == 1) return true;
#pragma unroll
    for (int j = 0; j < NCT; ++j)
#pragma unroll
        for (int r = 0; r < 4; ++r) red[(wave * NCT * 4 + j * 4 + r) * 64 + lane] = acc[j][r];
    __syncthreads();
    if (wave == 0) {
#pragma unroll
        for (int j = 0; j < NCT; ++j)
#pragma unroll
            for (int r = 0; r < 4; ++r) { float t = 0.f;
#pragma unroll
                for (int w = 0; w < 8; ++w) t += red[(w * NCT * 4 + j * 4 + r) * 64 + lane];
                acc[j][r] = t; }
    }
    __syncthreads();
    return wave == 0;
}
__device__ __forceinline__ int row_pos(int R) { return R < M ? (R & (S - 1)) + NMETA : R - M; }
__device__ __forceinline__ float row_scale(const float* ssq, int R) {
    const f32x4* p = (const f32x4*)(ssq + (size_t)R * 16); const f32x4 a = p[0], b = p[1], c = p[2], d = p[3];
    const float t = ((a.x + a.y) + (a.z + a.w)) + ((b.x + b.y) + (b.z + b.w)) + ((c.x + c.y) + (c.z + c.w)) + ((d.x + d.y) + (d.z + d.w));
    return rsqrtf(t * (1.0f / D) + EPS);
}

__device__ __forceinline__ size_t ki_off(size_t grow, int d) { return (grow >> 4) * 1024 + (size_t)((d >> 5) * 512 + ((d >> 3) & 3) * 128 + (int)(grow & 15) * 8 + (d & 7)); }
__device__ __forceinline__ void store_ki(bf16* KI, int R, int d, unsigned v) {
    if (R < M) { const int b = R >> 11, i = R & (S - 1); KI[ki_off((size_t)b * KROWS + PRE + i, d)] = (bf16)v; }
    else { const int j = R - M;
#pragma unroll 4
        for (int b = 0; b < NB; ++b) KI[ki_off((size_t)b * KROWS + j, d)] = (bf16)v; }
}
struct HeadEpi { bf16* dst; int ldd, col0; const float* gain; int norm, rope, kvmap; float scale; const float* ssq; };
__device__ __forceinline__ void store_mapped(bf16* dst, int ldd, int R, int col, unsigned v, int kvmap) {
    if (!kvmap) { dst[(size_t)R * ldd + col] = (bf16)v; return; }
    if (R < M) { const int b = R >> 11, i = R & (S - 1); dst[((size_t)b * KROWS + PRE + i) * ldd + col] = (bf16)v; }
    else { const int j = R - M;
#pragma unroll 4
        for (int b = 0; b < NB; ++b) dst[((size_t)b * KROWS + j) * ldd + col] = (bf16)v; }
}
__device__ __forceinline__ void epi_head(const Ptrs& P, const HeadEpi& E, const f32x4 (&acc)[4], int R0, int lane) {
    const int fr = lane & 15, fq = lane >> 4;
    const float* COS = WSP(float, OFF_ROPE); const float* SIN = COS + NPOS * 32;
#pragma unroll
    for (int reg = 0; reg < 4; ++reg) {
        const int R = R0 + 4 * fq + reg; const float rr = row_scale(E.ssq, R);
        float x[4];
#pragma unroll
        for (int j = 0; j < 4; ++j) x[j] = acc[j][reg] * rr;
        if (E.norm) { float ss = x[0] * x[0] + x[1] * x[1] + x[2] * x[2] + x[3] * x[3]; ss = red16(ss); const float rn = rsqrtf(ss * (1.0f / 64.0f) + EPS);
#pragma unroll
            for (int j = 0; j < 4; ++j) x[j] *= rn * E.gain[16 * j + fr]; }
        if (E.rope) { const int pos = row_pos(R);
#pragma unroll
            for (int j = 0; j < 2; ++j) { const float c = COS[pos * 32 + 16 * j + fr], s = SIN[pos * 32 + 16 * j + fr]; const float a = x[j], b = x[j + 2]; x[j] = a * c - b * s; x[j + 2] = a * s + b * c; } }
#pragma unroll
        for (int j = 0; j < 4; ++j) store_mapped(E.dst, E.ldd, R, E.col0 + 16 * j + fr, f2bf(x[j] * E.scale), E.kvmap);
    }
}
enum { SP_INA = 0, SP_RES_O = 1, SP_MLP1 = 2, SP_RES_M = 3, SP_QKVB = 4, SP_QB = 5 };
__device__ __forceinline__ int strips_of(int ph) { return ph == SP_INA ? 33 : ph == SP_RES_O ? 16 : ph == SP_MLP1 ? 64 : ph == SP_RES_M ? 16 : ph == SP_QKVB ? 49 : 16; }
__device__ __forceinline__ void perm_rows(int base, int pn, int wc, int* brow) { const int b0 = base + 256 * pn + 32 * wc; brow[0] = b0; brow[1] = b0 + 16; brow[2] = b0 + 128; brow[3] = b0 + 144; }

__device__ __forceinline__ void strip_job(const Ptrs& P, int ph, int l, int rg, int s, int lane, int ks = 1, int wave = 0, float* red = nullptr) {
    asm volatile("" : "+s"(rg), "+s"(s), "+v"(lane));
    const int R0 = rg * 16; const int fr = lane & 15, fq = lane >> 4;
    bf16* H = WSP(bf16, OFF_H); bf16* QO = WSP(bf16, OFF_QO); bf16* UM = WSP(bf16, OFF_UM);
    int brow[5];
    if (ph == SP_INA) {
        const bf16* Bt = WSP(bf16, OFF_WIN + l * SZ_WIN); const float* ssq = ssq_p(P, 2 * l);
        if (s < 32) {
            f32x4 acc[4]; HeadEpi E; E.ssq = ssq; E.kvmap = 0; E.norm = 1; E.rope = 1; E.scale = 1.f; E.gain = nullptr;
            if (s < 16) { perm_rows(0, s >> 2, s & 3, brow); E.dst = QO; E.ldd = D; E.col0 = 64 * s; E.gain = WSP(float, OFF_GT) + GT_AQG + l * 64; E.scale = C2; }
            else if (s < 20) { const int kh = s - 16; perm_rows(0, 4, kh, brow); E.dst = WSP(bf16, OFF_KA); E.ldd = 256; E.col0 = 64 * kh; E.gain = WSP(float, OFF_GT) + GT_AKG + l * 64; E.kvmap = 1; }
            else if (s < 24) { const int vh = s - 20; perm_rows(0, 5, vh, brow); E.dst = WSP(bf16, OFF_VA); E.ldd = 256; E.col0 = 64 * vh; E.norm = 0; E.rope = 0; E.kvmap = 1; }
            else { const int qh = s - 24; perm_rows(0, 6 + (qh >> 2), qh & 3, brow); E.dst = WSP(bf16, OFF_QI); E.ldd = 512; E.col0 = 64 * qh; E.norm = 0; }
            if (strip_mma<4>(H + (size_t)R0 * D, D, Bt, brow, D, acc, lane, ks, wave, red))
            epi_head(P, E, acc, R0, lane);
        } else {
            f32x4 acc[5];
#pragma unroll
            for (int j = 0; j < 5; ++j) brow[j] = 2048 + 16 * j;
            if (!strip_mma<5>(H + (size_t)R0 * D, D, Bt, brow, D, acc, lane, ks, wave, red)) return;
            const float* COS = WSP(float, OFF_ROPE); const float* SIN = COS + NPOS * 32; bf16* KI = WSP(bf16, OFF_KI); float* WI = WSP(float, OFF_WI);
#pragma unroll
            for (int reg = 0; reg < 4; ++reg) { const int R = R0 + 4 * fq + reg; const float rr = row_scale(ssq, R); const int pos = row_pos(R);
                float x[4];
#pragma unroll
                for (int j = 0; j < 4; ++j) x[j] = acc[j][reg] * rr;
#pragma unroll
                for (int j = 0; j < 2; ++j) { const float c = COS[pos * 32 + 16 * j + fr], sn = SIN[pos * 32 + 16 * j + fr]; const float a = x[j], b = x[j + 2]; x[j] = a * c - b * sn; x[j + 2] = a * sn + b * c; }
#pragma unroll
                for (int j = 0; j < 4; ++j) store_ki(KI, R, 16 * j + fr, f2bf(x[j]));
                if (fr < 8) WI[(size_t)R * 8 + fr] = acc[4][reg] * rr * 0.044194173824159216f; }
        }
    } else if (ph == SP_RES_O || ph == SP_RES_M) {
        const bool mlp = ph == SP_RES_M; const int K = mlp ? FF : D;
        const bf16* A = mlp ? UM + (size_t)(R0 - M) * FF : QO + (size_t)R0 * D; const bf16* Bt = mlp ? w2_t(P, l) : wo_t(P, l);
        float* ssqn = ssq_p(P, 2 * l + (mlp ? 2 : 1)); const bool last = mlp && l == 3; const float* ssqm = ssq_p(P, 2 * l + 1);
        f32x4 acc[4];
#pragma unroll
        for (int j = 0; j < 4; ++j) brow[j] = 64 * s + 16 * j;
        if (!strip_mma<4>(A, K, Bt, brow, K, acc, lane, ks, wave, red)) return;
#pragma unroll
        for (int reg = 0; reg < 4; ++reg) { const int R = R0 + 4 * fq + reg; float sq = 0.f; float r2 = 1.f; if (mlp) { const float rr = row_scale(ssqm, R); r2 = rr * rr; }
#pragma unroll
            for (int j = 0; j < 4; ++j) { const int col = 64 * s + 16 * j + fr; const float hv = bf2f(H[(size_t)R * D + col]) + acc[j][reg] * r2; H[(size_t)R * D + col] = (bf16)f2bf(hv); sq += hv * hv;
                if (last && R < M) P.out[(size_t)R * D + col] = hv; }
            sq = red16(sq); if (fr == 0) ssqn[(size_t)R * 16 + s] = sq; }
    } else if (ph == SP_MLP1) {
        f32x4 acc[4];
#pragma unroll
        for (int j = 0; j < 4; ++j) brow[j] = 64 * s + 16 * j;
        if (!strip_mma<4>(H + (size_t)R0 * D, D, w1_t(P, l), brow, D, acc, lane, ks, wave, red)) return;
#pragma unroll
        for (int reg = 0; reg < 4; ++reg) { const int R = R0 + 4 * fq + reg;
#pragma unroll
            for (int j = 0; j < 4; ++j) { const float v = fmaxf(acc[j][reg], 0.f); UM[(size_t)(R - M) * FF + 64 * s + 16 * j + fr] = (bf16)f2bf(v * v); } }
    } else {
        const int jb = l - 2; const float* ssq = ssq_p(P, 2 * l);
        if (s < 48) {
            f32x4 acc[4]; HeadEpi E; E.ssq = ssq; E.rope = 0; E.norm = 1; E.kvmap = 0; E.scale = 1.f; const bf16* Bt;
            if (s < 16) { Bt = WSP(bf16, jb == 0 ? OFF_WQ0 : OFF_WQ1); perm_rows(0, s >> 2, s & 3, brow); E.dst = QO; E.ldd = D; E.col0 = 64 * s; E.gain = WSP(float, OFF_GT) + GT_BQG + jb * 64; E.scale = C2; }
            else if (s < 32) { const int kh = s - 16; Bt = WSP(bf16, OFF_WKV); perm_rows(0, kh >> 2, kh & 3, brow); E.dst = WSP(bf16, OFF_KB); E.ldd = D; E.col0 = 64 * kh; E.gain = WSP(float, OFF_GT) + GT_KKG; E.kvmap = 1; }
            else { const int vh = s - 32; Bt = WSP(bf16, OFF_WKV); perm_rows(1024, vh >> 2, vh & 3, brow); E.dst = WSP(bf16, OFF_VB); E.ldd = D; E.col0 = 64 * vh; E.norm = 0; E.gain = nullptr; E.kvmap = 1; }
            if (strip_mma<4>(H + (size_t)R0 * D, D, Bt, brow, D, acc, lane, ks, wave, red))
            epi_head(P, E, acc, R0, lane);
        } else {
            f32x4 acc[1]; brow[0] = 2048;
            if (!strip_mma<1>(H + (size_t)R0 * D, D, WSP(bf16, OFF_WKV), brow, D, acc, lane, ks, wave, red)) return;
            float* LF = WSP(float, OFF_LF); const float bias = WSP(float, OFF_GT)[GT_KFB + fr];
#pragma unroll
            for (int reg = 0; reg < 4; ++reg) { const int R = R0 + 4 * fq + reg; const float z = acc[0][reg] * row_scale(ssq, R) + bias;
                LF[(size_t)R * 16 + fr] = fminf(z, 0.f) - log1pf(expf(-fabsf(z))); }
        }
    }
}
__device__ __forceinline__ unsigned okey(float f) { const unsigned u = __builtin_bit_cast(unsigned, f); return (u & 0x80000000u) ? ~u : (u | 0x80000000u); }
__device__ __forceinline__ unsigned half_sum(unsigned v) {
    v += __shfl_xor(v, 1); v += __shfl_xor(v, 2); v += __shfl_xor(v, 4); v += __shfl_xor(v, 8); v += __shfl_xor(v, 16); return v;
}
constexpr int NKT = 65;
constexpr int IDX_LDS_PER_WAVE = NKT * 64 * 4;
__device__ __forceinline__ float swap16_sum(float x) {
    auto s2 = __builtin_amdgcn_permlane16_swap(__float_as_uint(x), __float_as_uint(x), false, false);
    return __uint_as_float(s2[0]) + __uint_as_float(s2[1]);
}
template <int CTRL> __device__ __forceinline__ unsigned dppu(unsigned x) { return (unsigned)__builtin_amdgcn_mov_dpp((int)x, CTRL, 0xf, 0xf, true); }
__device__ __forceinline__ unsigned half_sum_dpp(unsigned v) {
    v += dppu<0xB1>(v); v += dppu<0x4E>(v); v += dppu<0x141>(v); v += dppu<0x128>(v);
    auto s2 = __builtin_amdgcn_permlane16_swap(v, v, false, false);
    return s2[0] + s2[1];
}
__device__ __forceinline__ void count4_ge(unsigned& cnt, unsigned a, unsigned b, unsigned c4, unsigned d, unsigned c) {
    asm volatile("v_cmp_ge_u32_e64 s[20:21], %1, %5\n\tv_cmp_ge_u32_e64 s[22:23], %2, %5\n\tv_cmp_ge_u32_e64 s[24:25], %3, %5\n\tv_cmp_ge_u32_e64 s[26:27], %4, %5\n\t"
                 "v_addc_co_u32_e64 %0, s[20:21], %0, 0, s[20:21]\n\tv_addc_co_u32_e64 %0, s[22:23], %0, 0, s[22:23]\n\tv_addc_co_u32_e64 %0, s[24:25], %0, 0, s[24:25]\n\tv_addc_co_u32_e64 %0, s[26:27], %0, 0, s[26:27]"
                 : "+v"(cnt) : "v"(a), "v"(b), "v"(c4), "v"(d), "v"(c) : "s20", "s21", "s22", "s23", "s24", "s25", "s26", "s27");
}
__device__ __forceinline__ void indexer_pass(const Ptrs& P, int b, int g2, int lane, LAS unsigned* stg  , int dry = 0  ) {
    const bf16* QI = WSP(bf16, OFF_QI); const bf16* KI = WSP(bf16, OFF_KI) + (size_t)b * KROWS * 64; const float* WI = WSP(float, OFF_WI);
    unsigned* MASK = WSP(unsigned, OFF_MASK);
    const int i0 = 2 * g2, n = lane & 31, gg = lane >> 5, fr = lane & 15, fq = lane >> 4;
    const size_t row0 = (size_t)b * S + i0;
    const int ntile = 2 + ((i0 + 1) >> 5);
    const unsigned lt = (1u << n) - 1u;
    const __amdgpu_buffer_rsrc_t krs = __builtin_amdgcn_make_buffer_rsrc((void*)KI, 0, KROWS * 128, 0x00020000);
    const int iq = i0 + gg;
    bf16x8 af[2];
    { const bf16* qp = QI + (row0 + (fr >> 3)) * 512 + (fr & 7) * 64 + 8 * fq;
      af[0] = *(const bf16x8*)(qp); af[1] = *(const bf16x8*)(qp + 32); }
    const f32x4 w4 = *(const f32x4*)(WI + (row0 + (fq >> 1)) * 8 + 4 * (fq & 1));
    const unsigned loff = (unsigned)(16 * lane);
    bf16x8 b0[2][2], b1[2][2], b2[2][2], b3[2][2];
#define IDX_TBASE(t_) (((t_) == 0 ? 0 : PRE + 32 * ((t_) - 1)) * 128)
#define IDX_LOADB(dst, t_) do { const int tt_ = (t_) < ntile ? (t_) : ntile - 1; const int bo_ = IDX_TBASE(tt_); _Pragma("unroll") for (int u_ = 0; u_ < 2; ++u_) _Pragma("unroll") for (int ks_ = 0; ks_ < 2; ++ks_) \
        dst[u_][ks_] = __builtin_bit_cast(bf16x8, __builtin_amdgcn_raw_buffer_load_b128(krs, loff + 2048 * u_ + 1024 * ks_, bo_, 0)); } while (0)
#define IDX_TILE(bb, t_) do { float pu_[2]; \
        _Pragma("unroll") for (int u_ = 0; u_ < 2; ++u_) { f32x4 acc_ = {0.f, 0.f, 0.f, 0.f}; \
            acc_ = __builtin_amdgcn_mfma_f32_16x16x32_bf16(af[0], bb[u_][0], acc_, 0, 0, 0); acc_ = __builtin_amdgcn_mfma_f32_16x16x32_bf16(af[1], bb[u_][1], acc_, 0, 0, 0); \
            float x_ = w4[0] * __builtin_amdgcn_fmed3f(acc_[0], 0.f, 3.0e38f); x_ += w4[1] * __builtin_amdgcn_fmed3f(acc_[1], 0.f, 3.0e38f); \
            x_ += w4[2] * __builtin_amdgcn_fmed3f(acc_[2], 0.f, 3.0e38f); x_ += w4[3] * __builtin_amdgcn_fmed3f(acc_[3], 0.f, 3.0e38f); pu_[u_] = swap16_sum(x_); } \
        const float sc_ = (fq & 1) ? pu_[1] : pu_[0]; \
        const bool v_ = (t_) == 0 ? (n < NMETA) : ((32 * ((t_) - 1) + n) <= iq); \
        stg[(t_) * 64 + lane] = v_ ? okey(sc_) : 0x007FFFFFu; } while (0)
    IDX_LOADB(b0, 0); IDX_LOADB(b1, 1); IDX_LOADB(b2, 2); IDX_LOADB(b3, 3);
#pragma unroll 1
    for (int t = 0; t < ntile; t += 4) {
        const int t1 = t + 1 < ntile ? t + 1 : ntile - 1, t2 = t + 2 < ntile ? t + 2 : ntile - 1, t3 = t + 3 < ntile ? t + 3 : ntile - 1;
        IDX_TILE(b0, t); IDX_LOADB(b0, t + 4);
        IDX_TILE(b1, t1); IDX_LOADB(b1, t + 5);
        IDX_TILE(b2, t2); IDX_LOADB(b2, t + 6);
        IDX_TILE(b3, t3); IDX_LOADB(b3, t + 7);
    }
#undef IDX_LOADB
#undef IDX_TILE
#undef IDX_TBASE
    if (dry) return;
#pragma unroll 1
    for (int t = ntile; t < NKT; ++t) stg[t * 64 + lane] = 0x007FFFFFu;
    unsigned k[NKT];
#pragma unroll
    for (int T = 0; T < NKT; ++T) k[T] = stg[T * 64 + lane];
    unsigned thr = 0u; bool done = (NMETA + iq + 1) <= TOPK;
    if (done) thr = 0x00800000u;
#pragma unroll 1
    for (int bit = 31; bit >= 0; --bit) {
        if (__all(done)) break;
        const unsigned c = thr | (1u << bit);
        unsigned cnt = (k[NKT - 1] >= c) ? 1u : 0u;
#pragma unroll
        for (int T = 0; T + 3 < NKT; T += 4) count4_ge(cnt, k[T], k[T + 1], k[T + 2], k[T + 3], c);
        cnt = half_sum_dpp(cnt);
        if (!done && cnt >= (unsigned)TOPK) { thr = c; if (cnt == (unsigned)TOPK) done = true; }
    }
    const bool slow = !__all(done);
    unsigned* mp = MASK + row0 * NWORDS;
    unsigned m0 = 0u, m1 = 0u, m2 = 0u, m3 = 0u;
#define IDX_PUT(bs_, widx_) do { const unsigned lo_ = (unsigned)(bs_), hi_ = (unsigned)((bs_) >> 32);   \
        if ((widx_) < 64) asm volatile("s_nop 1\n\tv_writelane_b32 %0, %2, %4\n\tv_writelane_b32 %1, %3, %4" : "+v"(m0), "+v"(m2) : "s"(lo_), "s"(hi_), "n"((widx_) & 63)); \
        else asm volatile("s_nop 1\n\tv_writelane_b32 %0, %2, %4\n\tv_writelane_b32 %1, %3, %4" : "+v"(m1), "+v"(m3) : "s"(lo_), "s"(hi_), "n"((widx_) & 63)); } while (0)
    if (!slow) {
#pragma unroll
        for (int T = 0; T < NKT; ++T) { const unsigned long long bs = __ballot(k[T] >= thr); IDX_PUT(bs, T == 0 ? 0 : T + 1); }
    } else {
        unsigned gcnt = 0;
#pragma unroll
        for (int T = 0; T < NKT; ++T) gcnt += (k[T] > thr) ? 1u : 0u;
        gcnt = half_sum_dpp(gcnt);
        const unsigned need = done ? 0x7fffffffu : (unsigned)TOPK - gcnt;
        unsigned base = 0;
#pragma unroll
        for (int T = 0; T < NKT; ++T) {
            const bool eq = k[T] == thr;
            const unsigned long long be = __ballot(eq);
            const unsigned hh = gg ? (unsigned)(be >> 32) : (unsigned)be;
            const bool sel = (k[T] > thr) || (eq && (base + (unsigned)__builtin_popcount(hh & lt)) < need);
            base += (unsigned)__builtin_popcount(hh);
            const unsigned long long bs = __ballot(sel); IDX_PUT(bs, T == 0 ? 0 : T + 1);
            __builtin_amdgcn_sched_barrier(0);
        }
    }
#undef IDX_PUT
    mp[lane] = m0; mp[NWORDS + lane] = m2;
    if (lane < NWORDS - 64) { mp[64 + lane] = m1; mp[NWORDS + 64 + lane] = m3; }
}

template <int MODE>
__device__ __forceinline__ void attn_naive_work(const Ptrs& P, int gw, int ngw, float* sc, int lane, int row_lo, int row_hi) {
    bf16* QO = WSP(bf16, OFF_QO);
    for (int job = gw; job < (row_hi - row_lo) * 16; job += ngw) {
        const int R = row_lo + (job >> 4), h = job & 15;
        const bool meta = R >= M; const int b = meta ? 0 : R >> 11, i = R & (S - 1);
        const int kmax = meta ? (R - M) : PRE + i;
        const bf16* Kb; const bf16* Vb; int ldk;
        if (MODE == 0) { Kb = WSP(bf16, OFF_KA) + (size_t)b * KROWS * 256 + 64 * (h >> 2); Vb = WSP(bf16, OFF_VA) + (size_t)b * KROWS * 256 + 64 * (h >> 2); ldk = 256; }
        else { Kb = WSP(bf16, OFF_KB) + (size_t)b * KROWS * D + 64 * h; Vb = WSP(bf16, OFF_VB) + (size_t)b * KROWS * D + 64 * h; ldk = D; }
        const unsigned* mrow = WSP(unsigned, OFF_MASK) + (size_t)(meta ? 0 : R) * NWORDS;
        const float* nb = WSP(float, OFF_NB) + ((size_t)b * 16 + h) * KROWS;
        float q[64];
        { const bf16* qp = QO + (size_t)R * D + 64 * h;
#pragma unroll
          for (int c = 0; c < 8; ++c) { const u32x4 v = *(const u32x4*)(qp + 8 * c);
              q[8 * c + 0] = bf2f(v.x & 0xffffu); q[8 * c + 1] = bf2f(v.x >> 16); q[8 * c + 2] = bf2f(v.y & 0xffffu); q[8 * c + 3] = bf2f(v.y >> 16);
              q[8 * c + 4] = bf2f(v.z & 0xffffu); q[8 * c + 5] = bf2f(v.z >> 16); q[8 * c + 6] = bf2f(v.w & 0xffffu); q[8 * c + 7] = bf2f(v.w >> 16); } }
        float mx = -INFINITY;
        for (int kr = lane; kr <= kmax; kr += 64) {
            bool sel;
            if (MODE == 0) sel = meta ? true : ((mrow[kr >> 5] >> (kr & 31)) & 1u) != 0u;
            else sel = (kr < NMETA) || (kr >= PRE);
            float s = -INFINITY;
            if (sel) { const bf16* kp = Kb + (size_t)kr * ldk; float a = 0.f;
#pragma unroll
                for (int c = 0; c < 8; ++c) { const u32x4 v = *(const u32x4*)(kp + 8 * c);
                    a += q[8 * c + 0] * bf2f(v.x & 0xffffu) + q[8 * c + 1] * bf2f(v.x >> 16) + q[8 * c + 2] * bf2f(v.y & 0xffffu) + q[8 * c + 3] * bf2f(v.y >> 16)
                       + q[8 * c + 4] * bf2f(v.z & 0xffffu) + q[8 * c + 5] * bf2f(v.z >> 16) + q[8 * c + 6] * bf2f(v.w & 0xffffu) + q[8 * c + 7] * bf2f(v.w >> 16); }
                s = a; if (MODE == 1) s += nb[kr]; }
            sc[kr] = s; mx = fmaxf(mx, s);
        }
        mx = wave_max(mx);
        float ls = 0.f;
        for (int kr = lane; kr <= kmax; kr += 64) { const float p = exp2f(sc[kr] - mx); sc[kr] = p; ls += p; }
        ls = wave_sum(ls);
        __builtin_amdgcn_s_waitcnt(0xc07f); asm volatile("" ::: "memory");
        float o = 0.f;
        for (int kr = 0; kr <= kmax; ++kr) { const float p = sc[kr]; if (p != 0.f) o += p * bf2f(Vb[(size_t)kr * ldk + lane]); }
        QO[(size_t)R * D + 64 * h + lane] = (bf16)f2bf(o / ls);
        __builtin_amdgcn_s_waitcnt(0xc07f); asm volatile("" ::: "memory");
    }
}

__device__ __forceinline__ void scan_work(const Ptrs& P, int bh, float* part  , int t) {
    const int b = bh >> 4, h = bh & 15; const bool act = t < 256;
    const float* LF = WSP(float, OFF_LF); float* NBp = WSP(float, OFF_NB) + ((size_t)b * 16 + h) * KROWS;
    float cm = 0.f;
    for (int j = 0; j < NMETA; ++j) { cm += LF[(size_t)(M + j) * 16 + h]; if (t == 0) NBp[j] = -cm * LOG2E; }
    if (t >= NMETA && t < PRE) NBp[t] = -INFINITY;
    float v[8]; float run = 0.f;
    if (act) {
#pragma unroll
        for (int e = 0; e < 8; ++e) { run += LF[((size_t)b * S + 8 * t + e) * 16 + h]; v[e] = run; }
        part[t] = run; }
    __syncthreads();
    for (int o = 1; o < 256; o <<= 1) { float x = 0.f; if (act && t >= o) x = part[t - o]; __syncthreads(); if (act) part[t] += x; __syncthreads(); }
    if (act) { const float off = cm + (t ? part[t - 1] : 0.f);
#pragma unroll
        for (int e = 0; e < 8; ++e) NBp[PRE + 8 * t + e] = -(off + v[e]) * LOG2E; }
    bf16* KB = WSP(bf16, OFF_KB); bf16* VB = WSP(bf16, OFF_VB);
    for (int e = t; e < 48 * 8; e += 512) { const int r = 16 + e / 8, c = e % 8; const u32x4 z = {0u, 0u, 0u, 0u};
        *(u32x4*)(KB + ((size_t)b * KROWS + r) * D + 64 * h + 8 * c) = z; *(u32x4*)(VB + ((size_t)b * KROWS + r) * D + 64 * h + 8 * c) = z; }
    __syncthreads();
}


namespace pg8 {
#define PG8_LAS __attribute__((address_space(3)))
typedef unsigned short bf16_t;
typedef short bf16x8 __attribute__((ext_vector_type(8)));
typedef float f32x4 __attribute__((ext_vector_type(4)));
typedef unsigned u32x4 __attribute__((ext_vector_type(4)));
constexpr int BM = 256, BK = 64, HALF = 128, HTB = HALF * BK * 2  , STAGE_BYTES = 8 * HTB, NXCD = 8, WGM = 4;

__host__ __device__ __forceinline__ int lds_byte(int r, int c) { const int st = (r >> 4) * 2 + (c >> 5), rr = r & 15, cc = c & 31, ob = rr * 64 + cc * 2; return st * 1024 + (ob ^ (((ob >> 9) & 1) << 5)); }
__host__ __device__ __forceinline__ void stage_rc(int b, int& R, int& C) { const int st = b / 1024, sb = b % 1024, swz = sb ^ (((sb >> 9) & 1) << 5); R = (st >> 1) * 16 + swz / 64; C = (st & 1) * 32 + (swz % 64) / 2; }
__host__ __device__ __forceinline__ int perm32(int rho) { const int n = rho >> 4, i = rho & 15; return 8 * (i >> 2) + 4 * n + (i & 3); }

struct Unit { int pm, pn; };
struct Gemm { const bf16_t* A; const bf16_t* Bt; int M, N, K; };

struct StaticOrder {
    int nM, nN, nwg, G, c;
    __host__ __device__ void init(int M, int N, int G_, int c_) { nM = M / BM; nN = N / BM; nwg = nM * nN; G = G_; c = c_; }
    __host__ __device__ bool next(int i, Unit& u) const {
        const long L = (long)i * G + c; if (L >= nwg) return false;
        int wgid = (int)L; { const int q = nwg / NXCD, r = nwg % NXCD, xcd = wgid % NXCD, off = wgid / NXCD; wgid = (xcd < r ? xcd * (q + 1) : r * (q + 1) + (xcd - r) * q) + off; }
        const int nig = WGM * nN, gid = wgid / nig, fm = gid * WGM, gsz = (nM - fm) < WGM ? (nM - fm) : WGM;
        u.pm = fm + ((wgid % nig) % gsz); u.pn = (wgid % nig) / gsz; return true;
    }
    __device__ __forceinline__ void a_ready(const Unit&) const {}
    __device__ __forceinline__ void done(const Unit&) const {}
};

__device__ __forceinline__ unsigned cvt_pk_bf16(float lo, float hi) { unsigned r; asm volatile("v_cvt_pk_bf16_f32 %0, %1, %2" : "=v"(r) : "v"(lo), "v"(hi)); return r; }
typedef float f32x2 __attribute__((ext_vector_type(2)));
typedef int i32x4 __attribute__((ext_vector_type(4)));
template <class Epi, class Sched, bool ALIGN_EPI = false, bool SP2 = false, int QM = 0, bool ABLK = false>
__device__ __forceinline__ void gemm_phase(PG8_LAS unsigned char* lds, const Gemm g, const Sched& S, const Epi& E) {
    int tid = threadIdx.x; asm volatile("" : "+v"(tid));
    const int wid = __builtin_amdgcn_readfirstlane(tid >> 6), lane = tid & 63, wr = wid >> 2, wc = wid & 3, fr = lane & 15, fq = lane >> 4;
    constexpr bool F8 = QM == 1, I8 = QM == 2;
    const int K = g.K, nt = K / BK;
    unsigned voffA[2], voffB[2];
#pragma unroll
    for (int i = 0; i < 2; ++i) { int R, C; stage_rc(tid * 16 + i * 8192, R, C); const int Rb = Epi::PERM ? ((R & ~31) + perm32(R & 31)) : R;
        voffA[i] = ABLK ? (unsigned)(((R >> 4) * (K * 2 / 32) + (C * 2 >> 5)) * 512 + (R & 15) * 32 + (C * 2 & 31)) : (unsigned)(R * K + C) * 2u; voffB[i] = (unsigned)(Rb * K + C) * 2u; }
    const size_t kstepA = ABLK ? (size_t)2048 : (size_t)(BK * 2);
    const size_t kstep = (size_t)(BK * 2);
    const size_t hstep = (size_t)HALF * K * 2;
    const size_t tstep = 2 * hstep;
    const unsigned ldsw = (unsigned)wid * 1024u;
    const int aoff = lds_byte(wr * 64 + fr, fq * 8), boff = lds_byte(wc * 32 + fr, fq * 8);
#define PG8_SA(b, h) (((b) * 2 + (h)) * HTB)
#define PG8_SB(b, h) ((4 + (b) * 2 + (h)) * HTB)
#define PG8_STAGE(bufoff, gbase, voff) do { _Pragma("unroll") for (int _i = 0; _i < 2; ++_i) \
        __builtin_amdgcn_global_load_lds((const unsigned*)((const char*)(gbase) + (voff)[_i]), (PG8_LAS unsigned*)(lds + (bufoff) + ldsw + _i * 8192), 16, 0, 0); } while (0)
#define PG8_LDA(dst, b, h) do { _Pragma("unroll") for (int m = 0; m < 4; ++m) _Pragma("unroll") for (int k = 0; k < 2; ++k) dst[m][k] = *(const PG8_LAS bf16x8*)(lds + PG8_SA(b, h) + aoff + m * 2048 + k * 1024); } while (0)
#define PG8_LDB(dst, b, h) do { _Pragma("unroll") for (int n = 0; n < 2; ++n) _Pragma("unroll") for (int k = 0; k < 2; ++k) dst[n][k] = *(const PG8_LAS bf16x8*)(lds + PG8_SB(b, h) + boff + n * 2048 + k * 1024); } while (0)
#define PG8_CAT8(x) __builtin_shufflevector(__builtin_bit_cast(i32x4, (x)[0]), __builtin_bit_cast(i32x4, (x)[1]), 0, 1, 2, 3, 4, 5, 6, 7)
#define PG8_MMA(ai, bj, At, Bt) do { __builtin_amdgcn_s_setprio(1); _Pragma("unroll") for (int m = 0; m < 4; ++m) _Pragma("unroll") for (int n = 0; n < 2; ++n) { \
        if constexpr (F8) asm volatile("v_mfma_f32_16x16x128_f8f6f4 %0, %1, %2, %0" : "+v"(acc[ai][bj][m][n]) : "v"(PG8_CAT8(Bt[n])), "v"(PG8_CAT8(At[m])));   \
        else if constexpr (I8) { _Pragma("unroll") for (int k = 0; k < 2; ++k) acc[ai][bj][m][n] = __builtin_bit_cast(f32x4, __builtin_amdgcn_mfma_i32_16x16x64_i8(__builtin_bit_cast(i32x4, Bt[n][k]), __builtin_bit_cast(i32x4, At[m][k]), __builtin_bit_cast(i32x4, acc[ai][bj][m][n]), 0, 0, 0)); } \
        else { _Pragma("unroll") for (int k = 0; k < 2; ++k) acc[ai][bj][m][n] = __builtin_amdgcn_mfma_f32_16x16x32_bf16(Bt[n][k], At[m][k], acc[ai][bj][m][n], 0, 0, 0); } } __builtin_amdgcn_s_setprio(0); } while (0)
#define PG8_WAIT_V(n) asm volatile("s_waitcnt vmcnt(" #n ")" ::: "memory")
#define PG8_WAIT_L(n) asm volatile("s_waitcnt lgkmcnt(" #n ")" ::: "memory")
#define PG8_BAR __builtin_amdgcn_s_barrier()
#define PG8_SCHED __builtin_amdgcn_sched_barrier(0)
    Unit cur, nxt; int ui = 0;
    if (!S.next(0, cur)) return;
    f32x4 acc[2][2][4][2];
    float zf = 0.f; asm volatile("" : "+v"(zf));
#pragma unroll
    for (int a = 0; a < 2; ++a)
#pragma unroll
        for (int b = 0; b < 2; ++b)
#pragma unroll
            for (int m = 0; m < 4; ++m)
#pragma unroll
                for (int n = 0; n < 2; ++n) acc[a][b][m][n] = (f32x4){zf, zf, zf, zf};
    bf16x8 At[4][2], B0[2][2], B1[2][2];
    const char* cA = (const char*)g.A + (size_t)cur.pm * tstep; const char* cB = (const char*)g.Bt + (size_t)cur.pn * tstep;
    S.a_ready(cur);
    if constexpr (SP2) {
        PG8_STAGE(PG8_SB(0, 0), cB, voffB); PG8_STAGE(PG8_SB(0, 1), cB + hstep, voffB); PG8_STAGE(PG8_SA(0, 0), cA, voffA); PG8_STAGE(PG8_SA(0, 1), cA + hstep, voffA);
        if (wr == 1) PG8_BAR;
        PG8_WAIT_V(2); PG8_BAR;
        PG8_STAGE(PG8_SB(1, 0), cB + kstep, voffB); PG8_STAGE(PG8_SA(1, 0), cA + kstepA, voffA); PG8_STAGE(PG8_SB(1, 1), cB + hstep + kstep, voffB);
        PG8_WAIT_V(6); PG8_BAR;
    } else {
        PG8_STAGE(PG8_SB(0, 0), cB, voffB); PG8_STAGE(PG8_SA(0, 0), cA, voffA); PG8_STAGE(PG8_SB(0, 1), cB + hstep, voffB); PG8_STAGE(PG8_SA(0, 1), cA + hstep, voffA);
        if (wr == 1) PG8_BAR;
        PG8_WAIT_V(4); PG8_BAR;
        PG8_STAGE(PG8_SB(1, 0), cB + kstep, voffB); PG8_STAGE(PG8_SA(1, 0), cA + kstepA, voffA); PG8_STAGE(PG8_SB(1, 1), cB + hstep + kstep, voffB);
        PG8_WAIT_V(6); PG8_BAR;
    }
    for (;;) {
        const bool has_next = S.next(ui + 1, nxt);
        const char* nA = has_next ? (const char*)g.A + (size_t)nxt.pm * tstep : cA; const char* nB = has_next ? (const char*)g.Bt + (size_t)nxt.pn * tstep : cB;
        for (int t = 0; t < nt; t += 2) {
            const bool last = (t == nt - 2);
            const char* a1 = cA + (size_t)(t + 1) * kstepA;
            const char* a2 = last ? nA : cA + (size_t)(t + 2) * kstepA; const char* b2 = last ? nB : cB + (size_t)(t + 2) * kstep;
            const char* a3 = a2 + kstepA; const char* b3 = b2 + kstep;
            if (last && has_next) S.a_ready(nxt);
            if constexpr (SP2) {
            PG8_LDB(B0, 0, 0); PG8_LDB(B1, 0, 1); PG8_SCHED; PG8_LDA(At, 0, 0); PG8_STAGE(PG8_SA(1, 1), a1 + hstep, voffA);
            PG8_WAIT_V(8); PG8_WAIT_L(0); PG8_BAR; PG8_MMA(0, 0, At, B0); PG8_MMA(0, 1, At, B1); PG8_BAR; PG8_SCHED;
            PG8_LDA(At, 0, 1); PG8_STAGE(PG8_SB(0, 0), b2, voffB); PG8_STAGE(PG8_SB(0, 1), b2 + hstep, voffB); PG8_STAGE(PG8_SA(0, 0), a2, voffA);
            PG8_WAIT_V(8); PG8_WAIT_L(0); PG8_BAR; PG8_MMA(1, 0, At, B0); PG8_MMA(1, 1, At, B1); PG8_BAR; PG8_SCHED;
            PG8_LDB(B0, 1, 0); PG8_LDB(B1, 1, 1); PG8_SCHED; PG8_LDA(At, 1, 0); PG8_STAGE(PG8_SA(0, 1), a2 + hstep, voffA);
            PG8_WAIT_V(8); PG8_WAIT_L(0); PG8_BAR; PG8_MMA(0, 0, At, B0); PG8_MMA(0, 1, At, B1); PG8_BAR; PG8_SCHED;
            PG8_LDA(At, 1, 1); PG8_STAGE(PG8_SB(1, 0), b3, voffB); PG8_STAGE(PG8_SB(1, 1), b3 + hstep, voffB); PG8_STAGE(PG8_SA(1, 0), a3, voffA);
            PG8_WAIT_V(8); PG8_WAIT_L(0); PG8_BAR; PG8_MMA(1, 0, At, B0); PG8_MMA(1, 1, At, B1); PG8_BAR; PG8_SCHED;
            } else {
            PG8_LDB(B0, 0, 0); PG8_SCHED; PG8_LDA(At, 0, 0); PG8_STAGE(PG8_SA(1, 1), a1 + hstep, voffA);
            PG8_WAIT_L(8); PG8_BAR; PG8_WAIT_L(0); PG8_MMA(0, 0, At, B0); PG8_BAR; PG8_SCHED;
            PG8_LDB(B1, 0, 1); PG8_STAGE(PG8_SB(0, 0), b2, voffB);
            PG8_BAR; PG8_WAIT_L(0); PG8_MMA(0, 1, At, B1); PG8_BAR;
            PG8_LDA(At, 0, 1); PG8_STAGE(PG8_SA(0, 0), a2, voffA);
            PG8_BAR; PG8_WAIT_L(0); PG8_MMA(1, 0, At, B0); PG8_BAR; PG8_SCHED;
            PG8_STAGE(PG8_SB(0, 1), b2 + hstep, voffB);
            PG8_WAIT_V(6); PG8_BAR; PG8_MMA(1, 1, At, B1); PG8_BAR;
            PG8_LDB(B0, 1, 0); PG8_SCHED; PG8_LDA(At, 1, 0); PG8_STAGE(PG8_SA(0, 1), a2 + hstep, voffA);
            PG8_WAIT_L(8); PG8_BAR; PG8_WAIT_L(0); PG8_MMA(0, 0, At, B0); PG8_BAR; PG8_SCHED;
            PG8_LDB(B1, 1, 1); PG8_STAGE(PG8_SB(1, 0), b3, voffB);
            PG8_BAR; PG8_WAIT_L(0); PG8_MMA(0, 1, At, B1); PG8_BAR;
            PG8_LDA(At, 1, 1); PG8_STAGE(PG8_SA(1, 0), a3, voffA);
            PG8_BAR; PG8_WAIT_L(0); PG8_MMA(1, 0, At, B0); PG8_BAR; PG8_SCHED;
            PG8_STAGE(PG8_SB(1, 1), b3 + hstep, voffB);
            PG8_WAIT_V(6); PG8_BAR; PG8_MMA(1, 1, At, B1); PG8_BAR;
            }
        }
        if constexpr (ALIGN_EPI) { if (wr == 0) PG8_BAR; }
        if constexpr (F8) asm volatile("s_nop 15\n\ts_nop 7" ::: "memory");
        if constexpr (!Epi::AFTER_DRAIN) { E(acc, cur, wr, wc, fr, fq); S.done(cur); }
        if (!has_next) break;
#pragma unroll
        for (int a = 0; a < 2; ++a)
#pragma unroll
            for (int b = 0; b < 2; ++b)
#pragma unroll
                for (int m = 0; m < 4; ++m)
#pragma unroll
                    for (int n = 0; n < 2; ++n) acc[a][b][m][n] = (f32x4){0.f, 0.f, 0.f, 0.f};
        cur = nxt; cA = nA; cB = nB; ++ui;
        if constexpr (ALIGN_EPI) { if (wr == 1) PG8_BAR; }
    }
    PG8_WAIT_V(0);
    if constexpr (!ALIGN_EPI) { if (wr == 0) PG8_BAR; }
    PG8_BAR;
    if constexpr (Epi::AFTER_DRAIN) { E.fused(acc, cur, wr, wc, fr, fq, lds, wid, lane); S.done(cur); }
#undef PG8_SA
#undef PG8_SB
#undef PG8_STAGE
#undef PG8_LDA
#undef PG8_LDB
#undef PG8_MMA
#undef PG8_WAIT_V
#undef PG8_WAIT_L
#undef PG8_BAR
#undef PG8_SCHED
}
}

__device__ __forceinline__ u32x4 pack8(const f32x4& a, const f32x4& b) { u32x4 w; w.x = pg8::cvt_pk_bf16(a[0], a[1]); w.y = pg8::cvt_pk_bf16(a[2], a[3]); w.z = pg8::cvt_pk_bf16(b[0], b[1]); w.w = pg8::cvt_pk_bf16(b[2], b[3]); return w; }
__device__ __forceinline__ float hsum4(const f32x4& a) { return (a[0] + a[1]) + (a[2] + a[3]); }

struct HeadTile { bf16* dst; int ldd, col0, mode; const float* gain; float scale, ascale; };
__device__ __forceinline__ void epi_heads(const Ptrs& P, const HeadTile& T, const float* ssq, const f32x4 (&acc)[2][2][4][2], const pg8::Unit& u, int wr, int wc, int fr, int fq) {
    const float* COS = WSP(float, OFF_ROPE); const float* SIN = COS + NPOS * 32;
    f32x4 g[2][2];
#pragma unroll
    for (int bj = 0; bj < 2; ++bj)
#pragma unroll
        for (int n = 0; n < 2; ++n) g[bj][n] = (T.mode & 1) ? *(const f32x4*)(T.gain + 32 * bj + 8 * fq + 4 * n) : (f32x4){1.f, 1.f, 1.f, 1.f};
    extern __shared__ __attribute__((aligned(16))) unsigned char dyn_lds_epi[];
    float* rs = (float*)(dyn_lds_epi + EPI_RS_OFF) + (wr * 4 + wc) * 128;
    { const int lane = fq * 16 + fr;
#pragma unroll
      for (int h = 0; h < 2; ++h) { const int j = lane + 64 * h; rs[j] = row_scale(ssq, u.pm * 256 + (j >> 6) * 128 + wr * 64 + (j & 63)) * T.ascale; } }
    f32x4 cN[2], sN[2];
    { const int pos0 = ((u.pm * 256 + wr * 64 + fr) & (S - 1)) + NMETA;
#pragma unroll
      for (int n = 0; n < 2; ++n) { cN[n] = *(const f32x4*)(COS + pos0 * 32 + 8 * fq + 4 * n); sN[n] = *(const f32x4*)(SIN + pos0 * 32 + 8 * fq + 4 * n); } }
#pragma unroll
    for (int ai = 0; ai < 2; ++ai)
#pragma unroll
        for (int m = 0; m < 4; ++m) {
            const int R = u.pm * 256 + ai * 128 + wr * 64 + m * 16 + fr;
            const float rr = rs[ai * 64 + m * 16 + fr];
            const f32x4 cC[2] = {cN[0], cN[1]}, sC[2] = {sN[0], sN[1]};
            if (ai * 4 + m < 7) { const int in = ai * 4 + m + 1, posn = ((u.pm * 256 + (in >> 2) * 128 + wr * 64 + (in & 3) * 16 + fr) & (S - 1)) + NMETA;
#pragma unroll
                for (int n = 0; n < 2; ++n) { cN[n] = *(const f32x4*)(COS + posn * 32 + 8 * fq + 4 * n); sN[n] = *(const f32x4*)(SIN + posn * 32 + 8 * fq + 4 * n); } }
            f32x4 x[2][2];
#pragma unroll
            for (int bj = 0; bj < 2; ++bj)
#pragma unroll
                for (int n = 0; n < 2; ++n) x[bj][n] = acc[ai][bj][m][n] * rr;
            if (T.mode & 1) {
                float ss = (hsum4(x[0][0] * x[0][0]) + hsum4(x[0][1] * x[0][1])) + (hsum4(x[1][0] * x[1][0]) + hsum4(x[1][1] * x[1][1]));
                ss += __shfl_xor(ss, 16); ss += __shfl_xor(ss, 32);
                const float rn = rsqrtf(ss * (1.0f / 64.0f) + EPS);
#pragma unroll
                for (int bj = 0; bj < 2; ++bj)
#pragma unroll
                    for (int n = 0; n < 2; ++n) x[bj][n] = x[bj][n] * (g[bj][n] * rn);
            }
            if (T.mode & 2) {
#pragma unroll
                for (int n = 0; n < 2; ++n) { const f32x4 c = cC[n], sn = sC[n];
                    const f32x4 lo = x[0][n], hi = x[1][n]; x[0][n] = lo * c - hi * sn; x[1][n] = lo * sn + hi * c; }
            }
            const size_t drow = (T.mode & 4) ? (size_t)(R >> 11) * KROWS + PRE + (R & (S - 1)) : (size_t)R;
            bf16* dp = T.dst + drow * T.ldd + T.col0 + 8 * fq;
            *(u32x4*)(dp) = pack8(x[0][0] * T.scale, x[0][1] * T.scale);
            *(u32x4*)(dp + 32) = pack8(x[1][0] * T.scale, x[1][1] * T.scale);
        }
}
struct EpiInA {
    static constexpr bool PERM = true, AFTER_DRAIN = false;
    const Ptrs& P; int l; int f8, pn0;
    __device__ __forceinline__ void operator()(const f32x4 (&acc)[2][2][4][2], const pg8::Unit& u, int wr, int wc, int fr, int fq) const {
        HeadTile T; const int pn = u.pn + pn0; T.ascale = f8 ? 1.0f / IN_F8S : 1.0f;
        if (pn < 4) { T.dst = WSP(bf16, OFF_QO); T.ldd = D; T.col0 = 64 * (4 * pn + wc); T.mode = 3; T.gain = WSP(float, OFF_GT) + GT_AQG + l * 64; T.scale = C2; }
        else if (pn == 4) { T.dst = WSP(bf16, OFF_KA); T.ldd = 256; T.col0 = 64 * wc; T.mode = 7; T.gain = WSP(float, OFF_GT) + GT_AKG + l * 64; T.scale = 1.f; }
        else if (pn == 5) { T.dst = WSP(bf16, OFF_VA); T.ldd = 256; T.col0 = 64 * wc; T.mode = 4; T.gain = nullptr; T.scale = 1.f; }
        else { T.dst = WSP(bf16, OFF_QI); T.ldd = 512; T.col0 = 64 * (4 * (pn - 6) + wc); T.mode = 2; T.gain = nullptr; T.scale = 1.f; }
        epi_heads(P, T, ssq_p(P, 2 * l), acc, u, wr, wc, fr, fq);
    }
};
struct EpiInB {
    static constexpr bool PERM = true, AFTER_DRAIN = false;
    const Ptrs& P; int l;
    __device__ __forceinline__ void operator()(const f32x4 (&acc)[2][2][4][2], const pg8::Unit& u, int wr, int wc, int fr, int fq) const {
        HeadTile T; const int pn = u.pn; T.ascale = 1.0f / IN_F8S;
        if (pn < 4) { T.dst = WSP(bf16, OFF_QO); T.ldd = D; T.col0 = 64 * (4 * pn + wc); T.mode = 1; T.gain = WSP(float, OFF_GT) + GT_BQG + (l - 2) * 64; T.scale = C2; }
        else if (pn < 8) { T.dst = WSP(bf16, OFF_KB); T.ldd = D; T.col0 = 64 * (4 * (pn - 4) + wc); T.mode = 5; T.gain = WSP(float, OFF_GT) + GT_KKG; T.scale = 1.f; }
        else { T.dst = WSP(bf16, OFF_VB); T.ldd = D; T.col0 = 64 * (4 * (pn - 8) + wc); T.mode = 4; T.gain = nullptr; T.scale = 1.f; }
        epi_heads(P, T, ssq_p(P, 2 * l), acc, u, wr, wc, fr, fq);
    }
};
__device__ __forceinline__ f32x4 i2f4(const f32x4& v) { f32x4 r; r[0] = (float)__float_as_int(v[0]); r[1] = (float)__float_as_int(v[1]); r[2] = (float)__float_as_int(v[2]); r[3] = (float)__float_as_int(v[3]); return r; }
template <bool MLP>
struct EpiRes {
    static constexpr bool PERM = true, AFTER_DRAIN = false;
    const Ptrs& P; int l, dry;
    __device__ __forceinline__ void operator()(const f32x4 (&acc)[2][2][4][2], const pg8::Unit& u, int wr, int wc, int fr, int fq) const {
        constexpr int mlp = MLP ? 1 : 0;
        const bf16* H = WSP(bf16, OFF_H); bf16* Hw = dry ? (bf16*)P.out : WSP(bf16, OFF_H); float* ssqn = dry ? P.out + (size_t)20 * 1024 * 1024 : ssq_p(P, 2 * l + (mlp ? 2 : 1)); const bool last = mlp && l == 3 && !dry;
        f32x4 csa[2], csb[2];
        if constexpr (MLP) { const int* cs = (const int*)(P.ws + OFF_CTL) + CW_CS + l * D;
#pragma unroll
            for (int bj = 0; bj < 2; ++bj) { const int col = u.pn * 256 + bj * 128 + wc * 32 + 8 * fq; const i32x4v c0 = *(const i32x4v*)(cs + col), c1 = *(const i32x4v*)(cs + col + 4);
#pragma unroll
                for (int j = 0; j < 4; ++j) { csa[bj][j] = 128.f * (float)c0[j]; csb[bj][j] = 128.f * (float)c1[j]; } } }
        u32x4 hvv[2][4][2];
#pragma unroll
        for (int ai = 0; ai < 2; ++ai)
#pragma unroll
            for (int m = 0; m < 4; ++m)
#pragma unroll
                for (int bj = 0; bj < 2; ++bj) hvv[ai][m][bj] = *(const u32x4*)(H + (size_t)(u.pm * 256 + ai * 128 + wr * 64 + m * 16 + fr) * D + u.pn * 256 + bj * 128 + wc * 32 + 8 * fq);
        extern __shared__ __attribute__((aligned(16))) unsigned char dyn_lds_epi[];
        float* rs = (float*)(dyn_lds_epi + EPI_RS_OFF) + (wr * 4 + wc) * 128;
        if constexpr (!MLP) { const int lane = fq * 16 + fr;
#pragma unroll
            for (int h = 0; h < 2; ++h) { const int j = lane + 64 * h; rs[j] = row_scale(ssq_p(P, 2 * l), u.pm * 256 + (j >> 6) * 128 + wr * 64 + (j & 63)) * QA; } }
#pragma unroll
        for (int ai = 0; ai < 2; ++ai)
#pragma unroll
            for (int m = 0; m < 4; ++m) {
                const int R = u.pm * 256 + ai * 128 + wr * 64 + m * 16 + fr; float sq = 0.f;
                float qs = 0.f; if constexpr (!MLP) qs = rs[ai * 64 + m * 16 + fr];
#pragma unroll
                for (int bj = 0; bj < 2; ++bj) {
                    const int col = u.pn * 256 + bj * 128 + wc * 32 + 8 * fq;
                    const u32x4 hv = hvv[ai][m][bj];
                    f32x4 a, b;
                    if constexpr (MLP) { a = (i2f4(acc[ai][bj][m][0]) + csa[bj]) * (1.0f / (QU * QW2)); b = (i2f4(acc[ai][bj][m][1]) + csb[bj]) * (1.0f / (QU * QW2)); }
                    else { a = acc[ai][bj][m][0]; b = acc[ai][bj][m][1]; }
                    a[0] += bf2f(hv.x & 0xffffu); a[1] += bf2f(hv.x >> 16); a[2] += bf2f(hv.y & 0xffffu); a[3] += bf2f(hv.y >> 16);
                    b[0] += bf2f(hv.z & 0xffffu); b[1] += bf2f(hv.z >> 16); b[2] += bf2f(hv.w & 0xffffu); b[3] += bf2f(hv.w >> 16);
                    sq += hsum4(a * a) + hsum4(b * b);
                    if (!last) *(u32x4*)(Hw + (size_t)R * D + col) = pack8(a, b);
                    if constexpr (MLP) { if (!last && !dry) { u32x2 o8; o8.x = pk4_fp8(a[0], a[1], a[2], a[3]); o8.y = pk4_fp8(b[0], b[1], b[2], b[3]);
                        *(u32x2*)(WSP(unsigned char, l == 0 ? OFF_H8A : OFF_H8B) + blk8(R, col, D)) = o8; } }
                    else { if (!dry) { u32x2 o8; o8.x = pk4_i8(a[0] * qs, a[1] * qs, a[2] * qs, a[3] * qs); o8.y = pk4_i8(b[0] * qs, b[1] * qs, b[2] * qs, b[3] * qs);
                        *(u32x2*)(WSP(unsigned char, OFF_HQ) + blk8(R, col, D)) = o8; } }
                    if (last) { float* op = P.out + (size_t)R * D + col; *(f32x4*)op = a; *(f32x4*)(op + 4) = b; }
                }
                sq += __shfl_xor(sq, 16); sq += __shfl_xor(sq, 32);
                if (fq == 0 && !last) ssqn[(size_t)R * 16 + 4 * u.pn + wc] = sq;
            }
    }
};
struct EpiRelu2 {
    static constexpr bool PERM = true, AFTER_DRAIN = false;
    const Ptrs& P; int l, blk;
    __device__ __forceinline__ void operator()(const f32x4 (&acc)[2][2][4][2], const pg8::Unit& u, int wr, int wc, int fr, int fq) const {
        unsigned char* U8 = WSP(unsigned char, OFF_U);
        extern __shared__ __attribute__((aligned(16))) unsigned char dyn_lds_epi[];
        float* rs = (float*)(dyn_lds_epi + EPI_RS_OFF) + (wr * 4 + wc) * 128;
        { const int lane = fq * 16 + fr; float v[2];
#pragma unroll
          for (int h = 0; h < 2; ++h) { const int j = lane + 64 * h, Rj = u.pm * 256 + (j >> 6) * 128 + wr * 64 + (j & 63);
              v[h] = row_scale(ssq_p(P, 2 * l + 1), Rj) * SQRT_QU / (row_scale(ssq_p(P, 2 * l), Rj) * (QA * QW1)); }
          rs[lane] = v[0]; rs[lane + 64] = v[1]; }
#pragma unroll
        for (int ai = 0; ai < 2; ++ai)
#pragma unroll
            for (int m = 0; m < 4; ++m) {
                const int R = u.pm * 256 + ai * 128 + wr * 64 + m * 16 + fr;
                const float sc = rs[ai * 64 + m * 16 + fr];
#pragma unroll
                for (int bj = 0; bj < 2; ++bj) {
                    const f32x4 sc4 = {sc, sc, sc, sc};
                    f32x4 a = i2f4(acc[ai][bj][m][0]) * sc4, b = i2f4(acc[ai][bj][m][1]) * sc4;
#pragma unroll
                    for (int j = 0; j < 4; ++j) { a[j] = a[j] * fabsf(a[j]); b[j] = b[j] * fabsf(b[j]); }

                    const int col = u.pn * 256 + bj * 128 + wc * 32 + 8 * fq;
                    int p0 = __builtin_amdgcn_cvt_pk_u8_f32(a[0], 0, 0); p0 = __builtin_amdgcn_cvt_pk_u8_f32(a[1], 1, p0); p0 = __builtin_amdgcn_cvt_pk_u8_f32(a[2], 2, p0); p0 = __builtin_amdgcn_cvt_pk_u8_f32(a[3], 3, p0);
                    int p1 = __builtin_amdgcn_cvt_pk_u8_f32(b[0], 0, 0); p1 = __builtin_amdgcn_cvt_pk_u8_f32(b[1], 1, p1); p1 = __builtin_amdgcn_cvt_pk_u8_f32(b[2], 2, p1); p1 = __builtin_amdgcn_cvt_pk_u8_f32(b[3], 3, p1);
                    u32x2 o; o.x = (unsigned)p0 ^ 0x80808080u; o.y = (unsigned)p1 ^ 0x80808080u;
                    __builtin_nontemporal_store(o, (u32x2*)(U8 + ((size_t)(R >> 4) * (FF / 32) + (col >> 5)) * 512 + (R & 15) * 32 + (col & 31)));
                }
            }
    }
};

#include <hip/hip_bf16.h>
#include <cmath>
namespace attn_body {
typedef unsigned u32x2_t __attribute__((ext_vector_type(2)));
constexpr int KVROWS=64+2048;
constexpr int LDS_AUX_BYTES=33*32*8;
using bf16=__hip_bfloat16;
using bf16x8=__attribute__((ext_vector_type(8)))short;
using s16x4=__attribute__((ext_vector_type(4)))short;
using f32x16=__attribute__((ext_vector_type(16)))float;
using u32x4=__attribute__((ext_vector_type(4)))unsigned;
constexpr int BATCH=16,NHEAD=16,SEQ=2048,D=64,DM=NHEAD*D;
constexpr int NW=8,QBLK=32,QB=QBLK*NW,KVBLK=64,NQB=SEQ/QB;
constexpr int ATTN_PITCH=DM, ATTN_UNIT_ROWS=QB;
__device__ __forceinline__ int crow(int r,int hi){return (r&3)+8*(r>>2)+4*hi;}
#define SBAR() __builtin_amdgcn_sched_barrier(0)
__device__ __forceinline__ void cmask(f32x16&p0,f32x16&p1,int jb,int qrel,int hi){
  const float NEG=-INFINITY; int kb=64*jb+4*hi;
  #pragma unroll
  for(int r=0;r<16;++r){int kv=kb+(r&3)+8*(r>>2); if(kv>qrel)p0[r]=NEG; if(kv+32>qrel)p1[r]=NEG;}
}

constexpr int NSLOT=3, SLOTB=8192;
constexpr int LDS_K=0, LDS_V=NSLOT*SLOTB, LDS_WS=2*NSLOT*SLOTB, LDS_OST=LDS_WS+NW*64*4, LDS_CORE=LDS_OST+NW*4096, LDS_AUX=LDS_CORE, LDS_BYTES=LDS_AUX+NW*LDS_AUX_BYTES;
constexpr float C2=0.125f*1.4426950408889634f;
__device__ __forceinline__ void glds16(const void*gsrc,unsigned lds_dst){unsigned keep;
  asm volatile("s_mov_b32 %0, m0\n\ts_mov_b32 m0, %2\n\ts_nop 0\n\tglobal_load_lds_dwordx4 %1, off\n\ts_mov_b32 m0, %0":"=&s"(keep):"v"(gsrc),"s"(lds_dst):"memory");}
__device__ __forceinline__ float max3f(float a,float b,float c){float r;asm("v_max3_f32 %0, %1, %2, %3":"=v"(r):"v"(a),"v"(b),"v"(c));return r;}
__device__ __forceinline__ float max2f(float a,float b){float r;asm("v_max_f32_e32 %0, %1, %2":"=v"(r):"v"(a),"v"(b));return r;}
__device__ __forceinline__ float fadd_s(float a,float b){float r;asm("v_add_f32_e32 %0, %1, %2":"=v"(r):"v"(a),"v"(b));return r;}
__device__ __forceinline__ float fsub_s(float a,float b){float r;asm("v_sub_f32_e32 %0, %1, %2":"=v"(r):"v"(a),"v"(b));return r;}
typedef float f32x2_t __attribute__((ext_vector_type(2))); typedef float f32x4_t __attribute__((ext_vector_type(4))); typedef __bf16 bf16x2_t __attribute__((ext_vector_type(2)));
__device__ __forceinline__ unsigned cvtpk_s(float lo,float hi){f32x2_t v={lo,hi};bf16x2_t b=__builtin_convertvector(v,bf16x2_t);return __builtin_bit_cast(unsigned,b);}
#define WAIT_BAR(N) asm volatile("s_waitcnt vmcnt(" #N ") lgkmcnt(0)\n\ts_barrier":::"memory")

__device__ __forceinline__ void qkt(f32x16&p0,f32x16&p1,const char*Kslot,const bf16x8*qr,const f32x16&negm,int r32,int hi){
  const char*kb=Kslot+hi*1024+r32*16;
  #pragma unroll
  for(int d0=0;d0<4;++d0){
    const bf16x8 b0=*reinterpret_cast<const bf16x8*>(kb+d0*2048);
    const bf16x8 b1=*reinterpret_cast<const bf16x8*>(kb+d0*2048+512);
    if(d0==0){p0=__builtin_amdgcn_mfma_f32_32x32x16_bf16(b0,qr[0],negm,0,0,0);p1=__builtin_amdgcn_mfma_f32_32x32x16_bf16(b1,qr[0],negm,0,0,0);}
    else{p0=__builtin_amdgcn_mfma_f32_32x32x16_bf16(b0,qr[d0],p0,0,0,0);p1=__builtin_amdgcn_mfma_f32_32x32x16_bf16(b1,qr[d0],p1,0,0,0);}}
}
typedef __attribute__((address_space(3))) const char* lds_cptr;
typedef __attribute__((address_space(3))) char* lds_cptr_w;
typedef short v4i16_t __attribute__((ext_vector_type(4)));
__device__ __forceinline__ void kload8(bf16x8*kf,lds_cptr kp){
  kf[0]=*(const __attribute__((address_space(3))) bf16x8*)(kp);      kf[1]=*(const __attribute__((address_space(3))) bf16x8*)(kp+512);
  kf[2]=*(const __attribute__((address_space(3))) bf16x8*)(kp+2048); kf[3]=*(const __attribute__((address_space(3))) bf16x8*)(kp+2560);
  kf[4]=*(const __attribute__((address_space(3))) bf16x8*)(kp+4096); kf[5]=*(const __attribute__((address_space(3))) bf16x8*)(kp+4608);
  kf[6]=*(const __attribute__((address_space(3))) bf16x8*)(kp+6144); kf[7]=*(const __attribute__((address_space(3))) bf16x8*)(kp+6656);
}
__device__ __forceinline__ void kload2(bf16x8*kf,lds_cptr kp,int j){ kf[2*j]=*(const __attribute__((address_space(3))) bf16x8*)(kp+j*2048); kf[2*j+1]=*(const __attribute__((address_space(3))) bf16x8*)(kp+j*2048+512); }
__device__ __forceinline__ s16x4 vtr(lds_cptr p){ return __builtin_bit_cast(s16x4,__builtin_amdgcn_ds_read_tr16_b64_v4i16((__attribute__((address_space(3))) v4i16_t*)p)); }
__device__ __forceinline__ float rowmax(const f32x16&p0,const f32x16&p1){
  float a=max3f(p0[0],p0[1],p1[0]),b=max3f(p0[2],p0[3],p1[1]);a=max3f(a,p1[2],p1[3]);
  #pragma unroll
  for(int r=4;r<16;r+=4){a=max3f(a,p0[r],p0[r+1]);b=max3f(b,p0[r+2],p0[r+3]);a=max3f(a,p1[r],p1[r+1]);b=max3f(b,p1[r+2],p1[r+3]);}
  const float m=max2f(a,b);
  auto rr=__builtin_amdgcn_permlane32_swap(__float_as_uint(m),__float_as_uint(m),false,false);
  return max2f(__uint_as_float(rr[0]),__uint_as_float(rr[1]));
}
__device__ __forceinline__ void pv(f32x16*o,int vb,bf16x8 pa0,bf16x8 pa1,bf16x8 pa2,bf16x8 pa3){
  #pragma unroll
  for(int d0=0;d0<2;++d0){s16x4 lo[4],hi[4];
    #pragma unroll
    for(int ks=0;ks<4;++ks){
      asm volatile("ds_read_b64_tr_b16 %0,%1 offset:%c2":"=&v"(lo[ks]):"v"(vb),"i"(d0*4096+ks*1024):"memory");
      asm volatile("ds_read_b64_tr_b16 %0,%1 offset:%c2":"=&v"(hi[ks]):"v"(vb),"i"(d0*4096+ks*1024+512):"memory");}
    asm volatile("s_waitcnt lgkmcnt(0)":::"memory");SBAR();
    #define PK(k) (bf16x8){lo[k][0],lo[k][1],lo[k][2],lo[k][3],hi[k][0],hi[k][1],hi[k][2],hi[k][3]}
    o[d0]=__builtin_amdgcn_mfma_f32_32x32x16_bf16(pa0,PK(0),o[d0],0,0,0);
    o[d0]=__builtin_amdgcn_mfma_f32_32x32x16_bf16(pa1,PK(1),o[d0],0,0,0);
    o[d0]=__builtin_amdgcn_mfma_f32_32x32x16_bf16(pa2,PK(2),o[d0],0,0,0);
    o[d0]=__builtin_amdgcn_mfma_f32_32x32x16_bf16(pa3,PK(3),o[d0],0,0,0);
    #undef PK
  }
}

#ifndef ATTN_STORE16
#define ATTN_STORE16(p,v) (*(u32x4*)(p)=(v))
#endif
template<int THRL,int MODE,int KVP> __device__ __forceinline__ void attn_unit(int b,int h,int hk,int qb,const bf16*Q,const bf16*__restrict__ K,const bf16*__restrict__ V,bf16*O,char*shm,const unsigned*maskg,const float*biasg,int t0  ){
  int tid_=threadIdx.x; asm volatile("":"+v"(tid_));
  const int tid=tid_,lane=tid&63,r32=lane&31,hi=lane>>5; const int wid=__builtin_amdgcn_readfirstlane(tid>>6);
  const long rowbase=(long)b*SEQ; const int q0=qb*QB;
  const bf16*Qw=Q+(rowbase+q0+wid*QBLK)*DM+h*D;
  const long kvbase=(long)b*KVROWS+(long)t0*64;
  const bf16*Kh=K+kvbase*KVP+hk*D,*Vh=V+kvbase*KVP+hk*D;
  const unsigned lds0=(unsigned)(uintptr_t)shm;
  float*wsf=(float*)(shm+LDS_WS)+wid*64;
  const bf16*ksrc=Kh+(long)lane*KVP+wid*8;
  const bf16*vsrc=Vh+(long)(16*(wid&3)+(lane>>2))*KVP+(wid>>2)*32+(lane&3)*8;
  const unsigned kdst=lds0+LDS_K+wid*1024, vdst=lds0+LDS_V+wid*1024;
  #define DMA_K(t,slot) glds16(ksrc+(long)(t)*KVBLK*KVP,(unsigned)__builtin_amdgcn_readfirstlane(kdst+(slot)))
  #define DMA_V(t,slot) glds16(vsrc+(long)(t)*KVBLK*KVP,(unsigned)__builtin_amdgcn_readfirstlane(vdst+(slot)))
  const int vb0=(int)(lds0+LDS_V)+((lane>>4)&1)*32+(lane&3)*8+(4*hi+((lane&15)>>2))*64;
  const char*Kbase=shm+LDS_K; bf16x8 kf[8];
  const lds_cptr shm3=(lds_cptr)shm; const lds_cptr kp0=shm3+LDS_K+hi*1024+r32*16; const lds_cptr vp0=shm3+LDS_V+((lane>>4)&1)*32+(lane&3)*8+(4*hi+((lane&15)>>2))*64;
  const int NT=(q0+QB)/KVBLK+1-t0;
  float nbq=0.f; if(MODE==1) nbq=biasg[64+q0+wid*QBLK+r32];
  if(MODE==2){} else if(MODE==0){
    const unsigned*mrow=maskg+((long)(rowbase+q0+wid*QBLK+r32))*66;
    __attribute__((address_space(3))) u32x2_t*mdst=(__attribute__((address_space(3))) u32x2_t*)((lds_cptr_w)shm+LDS_AUX+wid*LDS_AUX_BYTES);
    for(int t=hi;t<NT;t+=2){ const u32x2_t w=*reinterpret_cast<const u32x2_t*>(mrow+2*t); mdst[t*32+r32]=w; }
  } else {
    __attribute__((address_space(3))) float*bdst=(__attribute__((address_space(3))) float*)((lds_cptr_w)shm+LDS_AUX);
    for(int i=tid;i<NT*64;i+=NW*64)bdst[i]=biasg[t0*64+i];
  }
  asm volatile("s_waitcnt vmcnt(0) lgkmcnt(0)":::"memory");
  DMA_K(0,0);DMA_V(0,0);DMA_K(1,SLOTB);
  bf16x8 qr[4];
  #pragma unroll
  for(int d0=0;d0<4;++d0)qr[d0]=*reinterpret_cast<const bf16x8*>(&Qw[(long)r32*DM+d0*16+hi*8]);
  float mhat=0.f,l_reg=0.f;f32x16 o[2];o[0]=f32x16{};o[1]=f32x16{};const f32x16 negm=f32x16{};
  const int qrel=wid*QBLK+r32;
  if(MODE==1) mhat=nbq;
  #define CMASK(P0,P1,t) do{ if(MODE==2){ _Pragma("unroll") for(int r=0;r<16;++r){P0[r]-=mhat;P1[r]-=mhat;} int jb_=(t)-(NT-4); if(jb_>=0)cmask(P0,P1,jb_,qrel,hi); } else if(MODE==0){ const u32x2_t mw_=*((const __attribute__((address_space(3))) u32x2_t*)(shm3+LDS_AUX+wid*LDS_AUX_BYTES)+(t)*32+r32); mkx=mw_.x>>(4*hi); mky=mw_.y>>(4*hi); } \
      else { const __attribute__((address_space(3))) float*bp_=(const __attribute__((address_space(3))) float*)(shm3+LDS_AUX)+64*(t)+4*hi; \
        _Pragma("unroll") for(int g_=0;g_<4;++g_){ const f32x4_t b0_=*(const __attribute__((address_space(3))) f32x4_t*)(bp_+8*g_)-mhat, b1_=*(const __attribute__((address_space(3))) f32x4_t*)(bp_+32+8*g_)-mhat; \
          _Pragma("unroll") for(int j_=0;j_<4;++j_){ P0[4*g_+j_]+=b0_[j_]; P1[4*g_+j_]+=b1_[j_]; } SBAR(); } \
        int jb_=(t)-(NT-4); if(jb_>=0)cmask(P0,P1,jb_,qrel,hi); } }while(0)
  bool resc=false; unsigned mkx=0u,mky=0u;
  #define MSK(X,i,W) do{ float xv_=X[i]; unsigned mt_;   \
      asm volatile("v_bfe_i32 %1, %2, %3, 1\n\tv_and_b32 %0, %0, %1":"+v"(xv_),"=&v"(mt_):"v"(W),"n"(((i)&3)+8*((i)>>2))); X[i]=xv_; }while(0)
  #define START(P0,P1) do{ resc=false; \
    if(MODE==2){ const float rm=rowmax(P0,P1); const float dl=rm; mhat=fadd_s(mhat,dl); \
      _Pragma("unroll") for(int r=0;r<16;++r){P0[r]=fsub_s(P0[r],dl);P1[r]=fsub_s(P1[r],dl);} \
      } \
    _Pragma("unroll") for(int r=0;r<16;++r){P0[r]=__builtin_amdgcn_exp2f(P0[r]); if(MODE==0){MSK(P0,r,mkx);}} }while(0)
  #define RESC() do{ if(resc){ asm volatile("s_waitcnt lgkmcnt(0)":::"memory"); \
      _Pragma("unroll") for(int d_=0;d_<2;++d_) _Pragma("unroll") for(int r=0;r<16;++r)o[d_][r]*=wsf[crow(r,hi)]; } }while(0)
  f32x16 pA0,pA1,pB0,pB1;
  int sl_prev=0,sl_cur=0,sl_next=SLOTB;
  #define ROT() do{sl_prev=sl_cur;sl_cur=sl_next;sl_next=(sl_next==(NSLOT-1)*SLOTB)?0:sl_next+SLOTB;}while(0)
  DMA_K(2,2*SLOTB);
  WAIT_BAR(3);
  qkt(pA0,pA1,Kbase,qr,negm,r32,hi);asm volatile("s_nop 15\n\ts_nop 7":"+v"(pA0),"+v"(pA1));CMASK(pA0,pA1,0);
  START(pA0,pA1);
  _Pragma("unroll") for(int r=0;r<16;++r){pA1[r]=__builtin_amdgcn_exp2f(pA1[r]); if(MODE==0){MSK(pA1,r,mky);}}
  WAIT_BAR(0);
  DMA_K(3,0);DMA_V(1,SLOTB);
  ROT();
  kload8(kf,kp0+sl_cur);
  WAIT_BAR(2);
  s16x4 vlo[8],vhi[8]; u32x4 pw0,pw1,pw2,pw3;
  #define PKW(P,B) cvtpk_s(P[B],P[B+1])
  #define PAF(k) __builtin_bit_cast(bf16x8,pw##k)
  #define VFR(i) (bf16x8){vlo[i][0],vlo[i][1],vlo[i][2],vlo[i][3],vhi[i][0],vhi[i][1],vhi[i][2],vhi[i][3]}
  #define PIN(x) asm volatile("":"+v"(x))
  #define MX3(a,b,c) __builtin_fmaxf(__builtin_fmaxf((a),(b)),(c))
  #define GAPA(MF,A0,A1,A2,A3,W0,W1,PW) do{ MF; sacc+=A0; sacc+=A1; sacc+=A2; sacc+=A3; PIN(sacc); W0; W1; PIN(PW); SBAR(); }while(0)
  #define EX(v) __builtin_amdgcn_exp2f(v)
  #define GAPB(MF,X,B,W) do{ MF; X[B]=EX(X[B]); X[B+1]=EX(X[B+1]); X[B+2]=EX(X[B+2]); X[B+3]=EX(X[B+3]); if(MODE==0){MSK(X,B,W);MSK(X,(B)+1,W);MSK(X,(B)+2,W);MSK(X,(B)+3,W);} PIN(X); SBAR(); }while(0)
  #define VRD(i) do{ vlo[i]=vtr(vp_+(((i)>>2)*4096+((i)&3)*1024)); vhi[i]=vtr(vp_+(((i)>>2)*4096+((i)&3)*1024+512)); }while(0)
  #define KRD(G,j) do{ if(G){ kload2(kf,kp0+sl_next,j); SBAR(); } }while(0)
  #define STEP(C0,C1,P0,P1,t,GK,GV,GL) do{ SBAR(); \
    const lds_cptr vp_=vp0+sl_prev; \
    VRD(0); SBAR(); float sacc=(P0[0]+P0[1]); \
    GAPA(C0=__builtin_amdgcn_mfma_f32_32x32x16_bf16(kf[0],qr[0],negm,0,0,0), P0[2],P0[3],P0[4],P0[5],     pw0[0]=PKW(P0,0), pw0[1]=PKW(P0,2), pw0); \
    VRD(4); SBAR(); GAPA(C1=__builtin_amdgcn_mfma_f32_32x32x16_bf16(kf[1],qr[0],negm,0,0,0), P0[6],P0[7],P0[8],P0[9],     pw0[2]=PKW(P0,4), pw0[3]=PKW(P0,6), pw0); \
    VRD(1); SBAR(); GAPA(C0=__builtin_amdgcn_mfma_f32_32x32x16_bf16(kf[2],qr[1],C0,0,0,0),   P0[10],P0[11],P0[12],P0[13], pw1[0]=PKW(P0,8), pw1[1]=PKW(P0,10), pw1); \
    VRD(5); SBAR(); GAPA(C1=__builtin_amdgcn_mfma_f32_32x32x16_bf16(kf[3],qr[1],C1,0,0,0),   P0[14],P0[15],P1[0],P1[1],   pw1[2]=PKW(P0,12),pw1[3]=PKW(P0,14), pw1); \
    VRD(2); SBAR(); GAPA(C0=__builtin_amdgcn_mfma_f32_32x32x16_bf16(kf[4],qr[2],C0,0,0,0),   P1[2],P1[3],P1[4],P1[5],     pw2[0]=PKW(P1,0), pw2[1]=PKW(P1,2), pw2); \
    VRD(6); SBAR(); GAPA(C1=__builtin_amdgcn_mfma_f32_32x32x16_bf16(kf[5],qr[2],C1,0,0,0),   P1[6],P1[7],P1[8],P1[9],     pw2[2]=PKW(P1,4), pw2[3]=PKW(P1,6), pw2); \
    VRD(3); SBAR(); GAPA(C0=__builtin_amdgcn_mfma_f32_32x32x16_bf16(kf[6],qr[3],C0,0,0,0),   P1[10],P1[11],P1[12],P1[13], pw3[0]=PKW(P1,8), pw3[1]=PKW(P1,10), pw3); \
    VRD(7); SBAR(); GAPA(C1=__builtin_amdgcn_mfma_f32_32x32x16_bf16(kf[7],qr[3],C1,0,0,0),   P1[14],P1[15],0.f,0.f,       pw3[2]=PKW(P1,12),pw3[3]=PKW(P1,14), pw3); \
    l_reg+=sacc; \
    if(GK){DMA_K((t)+3,sl_cur);} if(GV){DMA_V((t)+1,sl_next);} \
    CMASK(C0,C1,t); \
    if(MODE==2){ float a=MX3(C0[0],C0[1],C1[0]),b=MX3(C0[2],C0[3],C1[1]); a=MX3(a,C1[2],C1[3]); \
      _Pragma("unroll") for(int r=4;r<16;r+=4){a=MX3(a,C0[r],C0[r+1]);b=MX3(b,C0[r+2],C0[r+3]);a=MX3(a,C1[r],C1[r+1]);b=MX3(b,C1[r+2],C1[r+3]);} \
      float rm=__builtin_fmaxf(a,b); { auto rr=__builtin_amdgcn_permlane32_swap(__float_as_uint(rm),__float_as_uint(rm),false,false); rm=__builtin_fmaxf(__uint_as_float(rr[0]),__uint_as_float(rr[1])); } \
      resc=false; \
      if(__builtin_expect(__any(rm>(float)THRL),0)){ const float dl=__builtin_fmaxf(rm,0.f); mhat+=dl; \
        _Pragma("unroll") for(int r=0;r<16;++r){C0[r]-=dl;C1[r]-=dl;} \
        \
        const float f=__builtin_amdgcn_exp2f(-dl); l_reg*=f; if(hi==0)wsf[r32]=f; resc=true; } } \
    SBAR(); \
    GAPB(o[0]=__builtin_amdgcn_mfma_f32_32x32x16_bf16(PAF(0),VFR(0),o[0],0,0,0), C0,0,mkx); \
    GAPB(o[1]=__builtin_amdgcn_mfma_f32_32x32x16_bf16(PAF(0),VFR(4),o[1],0,0,0), C0,4,mkx); \
    KRD(GL,0); GAPB(o[0]=__builtin_amdgcn_mfma_f32_32x32x16_bf16(PAF(1),VFR(1),o[0],0,0,0), C0,8,mkx); \
    KRD(GL,1); GAPB(o[1]=__builtin_amdgcn_mfma_f32_32x32x16_bf16(PAF(1),VFR(5),o[1],0,0,0), C0,12,mkx); \
    KRD(GL,2); GAPB(o[0]=__builtin_amdgcn_mfma_f32_32x32x16_bf16(PAF(2),VFR(2),o[0],0,0,0), C1,0,mky); \
    KRD(GL,3); GAPB(o[1]=__builtin_amdgcn_mfma_f32_32x32x16_bf16(PAF(2),VFR(6),o[1],0,0,0), C1,4,mky); \
    GAPB(o[0]=__builtin_amdgcn_mfma_f32_32x32x16_bf16(PAF(3),VFR(3),o[0],0,0,0), C1,8,mky); \
    GAPB(o[1]=__builtin_amdgcn_mfma_f32_32x32x16_bf16(PAF(3),VFR(7),o[1],0,0,0), C1,12,mky); \
    }while(0)
  int t=1;
  for(;t+5<NT;t+=2){
    STEP(pB0,pB1,pA0,pA1,t,true,true,true);     WAIT_BAR(2); RESC(); ROT();
    STEP(pA0,pA1,pB0,pB1,t+1,true,true,true);   WAIT_BAR(2); RESC(); ROT();
  }
  #define ENDW(tt) do{ if((tt)+3<NT){WAIT_BAR(2);} else if((tt)+2<NT){WAIT_BAR(1);} else {WAIT_BAR(0);} }while(0)
  for(;t+1<NT;t+=2){
    STEP(pB0,pB1,pA0,pA1,t,(t+3<NT),(t+1<NT),(t+1<NT));       ENDW(t);   RESC(); ROT();
    STEP(pA0,pA1,pB0,pB1,t+1,(t+4<NT),(t+2<NT),(t+2<NT));
    if(t+2<NT){ ENDW(t+1); RESC(); ROT(); } else { RESC(); }
  }
  { float sacc=pA0[0]+pA0[1]; _Pragma("unroll") for(int r=2;r<16;++r)sacc+=pA0[r]; _Pragma("unroll") for(int r=0;r<16;++r)sacc+=pA1[r]; l_reg+=sacc;
    pw0=(u32x4){PKW(pA0,0),PKW(pA0,2),PKW(pA0,4),PKW(pA0,6)};pw1=(u32x4){PKW(pA0,8),PKW(pA0,10),PKW(pA0,12),PKW(pA0,14)};pw2=(u32x4){PKW(pA1,0),PKW(pA1,2),PKW(pA1,4),PKW(pA1,6)};pw3=(u32x4){PKW(pA1,8),PKW(pA1,10),PKW(pA1,12),PKW(pA1,14)};
    SBAR(); pv(o,vb0+sl_cur,PAF(0),PAF(1),PAF(2),PAF(3)); }
  #undef PKW
  #undef PAF
  #undef VFR
  #undef PIN
  #undef MX3
  #undef GAPA
  #undef GAPB
  #undef MSK
  #undef EX
  #undef VRD
  #undef KRD
  #undef STEP
  #undef ENDW
  {auto rr=__builtin_amdgcn_permlane32_swap(__float_as_uint(l_reg),__float_as_uint(l_reg),false,false);l_reg=__uint_as_float(rr[0])+__uint_as_float(rr[1]);}
  if(hi==0)wsf[32+r32]=l_reg;asm volatile("s_waitcnt lgkmcnt(0)":::"memory");
  float rli[16];
  #pragma unroll
  for(int r=0;r<16;++r)rli[r]=__builtin_amdgcn_rcpf(wsf[32+crow(r,hi)]);
  bf16*Ow=O+(rowbase+q0+wid*QBLK)*DM+h*D;
  { bf16*stg=(bf16*)(shm+LDS_OST)+wid*2048;
    #pragma unroll
    for(int r=0;r<16;++r){const int orow=crow(r,hi);
      #pragma unroll
      for(int d0=0;d0<2;++d0)stg[orow*64+d0*32+r32]=__float2bfloat16(o[d0][r]*rli[r]);}
    asm volatile("s_waitcnt lgkmcnt(0)":::"memory");
    #pragma unroll
    for(int i=0;i<4;++i){const int row=i*8+(lane>>3),ch=lane&7; const u32x4 v=*(const u32x4*)(stg+row*64+ch*8); ATTN_STORE16(Ow+(long)row*DM+ch*8,v);} }
  asm volatile("s_waitcnt lgkmcnt(0)\n\ts_barrier":::"memory");
  #undef DMA_K
  #undef DMA_V
  #undef CMASK
  #undef START
  #undef RESC
  #undef ROT
}
constexpr int ATTN_LDS_BYTES=LDS_BYTES;
#undef SBAR
#undef WAIT_BAR
}

constexpr int SCHED_OFF = 156 * 1024;
constexpr int CW_ATTQ = 8192;
template <int MODE> __device__ __forceinline__ void attn_phase_fa(const Ptrs& P, char* lds, int G, int bx, bf16* Oout, int lyr) {
    typedef attn_body::bf16 abf;
    if (MODE != 1) {
#pragma unroll 1
        for (int u = bx; u < 2048; u += G) {
            const int bh = (G == 256) ? ((u & 7) * 32 + ((u & 255) >> 3)) : (u & 255), qb = 7 - (u >> 8), b = bh >> 4, h = bh & 15;
            if (MODE == 2) attn_body::attn_unit<8, 2, 1024>(b, h, h, qb, (const abf*)WSP(bf16, OFF_QO), (const abf*)WSP(bf16, OFF_QO), (const abf*)WSP(bf16, OFF_QO), (abf*)Oout, lds, nullptr, nullptr, 0);
            else attn_body::attn_unit<8, 0, 256>(b, h, h >> 2, qb, (const abf*)WSP(bf16, OFF_QO), (const abf*)WSP(bf16, OFF_KA), (const abf*)WSP(bf16, OFF_VA), (abf*)Oout, lds, WSP(unsigned, OFF_MASK), nullptr, 0);
        }
    } else {
        volatile LAS unsigned* sch = (volatile LAS unsigned*)((LAS unsigned char*)lds + SCHED_OFF);
        unsigned* qhead = (unsigned*)(P.ws + OFF_CTL) + CW_ATTQ + 64 * (lyr & 1) + 128 * (Oout != WSP(bf16, OFF_QO));
#pragma unroll 1
        for (;;) {
            int tid_q = threadIdx.x; asm volatile("" : "+v"(tid_q));
            const int lane = tid_q & 63, wave = __builtin_amdgcn_readfirstlane(tid_q >> 6);
            if (wave == 0) {
                unsigned u = 0;
                if (lane == 0) u = __hip_atomic_fetch_add(qhead, 1u, __ATOMIC_RELAXED, __HIP_MEMORY_SCOPE_AGENT);
                u = (unsigned)__builtin_amdgcn_readfirstlane((int)u);
                unsigned t0 = 0;
                if (u < 2048u) {
                    const int bh = u & 255, qb = 7 - (int)(u >> 8);
                    const float* nb = WSP(float, OFF_NB) + (size_t)bh * KROWS;
                    const float lim = nb[PRE + 256 * qb] - WSP(float, OFF_GT)[GT_SKIP];
                    const int cand = 2 * lane;
                    const bool ok = cand <= 4 * qb && (cand == 0 || nb[64 * cand - 1] <= lim);
                    const unsigned long long m = __ballot(ok);
                    t0 = 2u * (unsigned)(63 - __builtin_clzll(m));
                }
                if (lane == 0) { sch[0] = u; sch[1] = t0; }
            }
            asm volatile("s_waitcnt vmcnt(0) lgkmcnt(0)\n\ts_barrier" ::: "memory");
            const unsigned u = sch[0], t0 = sch[1];
            if (u >= 2048u) break;
            const int bh = u & 255, qb = 7 - (int)(u >> 8), b = bh >> 4, h = bh & 15;
            attn_body::attn_unit<8, 1, 1024>(b, h, h, qb, (const abf*)WSP(bf16, OFF_QO), (const abf*)WSP(bf16, OFF_KB), (const abf*)WSP(bf16, OFF_VB), (abf*)Oout, lds, nullptr, WSP(float, OFF_NB) + (size_t)bh * KROWS, (int)t0);
        }
    }
}

typedef GAS unsigned gu32;
#define RLX_AGENT __ATOMIC_RELAXED, __HIP_MEMORY_SCOPE_AGENT
#define XB_TMO      128
#define XB_XCNT(j)  (256  + 64 * (j))
#define XB_XSUB(j)  (1280 + 64 * (j))
#define XB_XGEN(j)  (2304 + 64 * (j))
#define XB_TOP      3328
#define XB_TOPGEN   3392
#define XCD_BAR_WORDS 3456
#define XB_SPIN_CAP (1u << 18)

__device__ __forceinline__ unsigned xb_ld(unsigned* p)              { return __hip_atomic_load(p, __ATOMIC_RELAXED, __HIP_MEMORY_SCOPE_AGENT); }
__device__ __forceinline__ unsigned xb_add(unsigned* p, unsigned v) { return __hip_atomic_fetch_add(p, v, __ATOMIC_RELAXED, __HIP_MEMORY_SCOPE_AGENT); }
__device__ __forceinline__ unsigned xb_xcc_id() { return (unsigned)__builtin_amdgcn_s_getreg((3 << 11) | 20) & 0xFu; }
#define XB_SPIN(cond, bar) do { unsigned _sp = 0; while (cond) { __builtin_amdgcn_s_sleep(1); \
    if ((++_sp & 255u) == 0u) { if (xb_ld(&(bar)[XB_TMO])) break; if (_sp > XB_SPIN_CAP) { atomicAdd(&(bar)[XB_TMO], 1u); break; } } } } while (0)

struct XcdBarrier {
    unsigned* bar; unsigned x;
    volatile LAS unsigned* st;
};

__device__ __forceinline__ XcdBarrier xcd_barrier_post(unsigned* bar, volatile LAS unsigned* st) {
    XcdBarrier b; b.bar = bar; b.x = xb_xcc_id(); b.st = st;
    if (threadIdx.x == 0) (void)xb_add(&bar[XB_XCNT(b.x)], 1u);
    return b;
}
__device__ __forceinline__ void xcd_barrier_complete(unsigned* bar, unsigned x, unsigned& nloc, unsigned& nx) {
    const unsigned G = gridDim.x * gridDim.y * gridDim.z;
    unsigned sum, cnt, mine, sp = 0u;
    for (;;) {
        sum = 0u; cnt = 0u; mine = 0u;
#pragma unroll
        for (unsigned j = 0; j < 16; ++j) { const unsigned c = xb_ld(&bar[XB_XCNT(j)]); sum += c; cnt += (c > 0u) ? 1u : 0u; mine = (j == x) ? c : mine; }
        if (sum == G) break;
        __builtin_amdgcn_s_sleep(1);
        if ((++sp & 255u) == 0u) { if (xb_ld(&bar[XB_TMO])) break; if (sp > XB_SPIN_CAP) { atomicAdd(&bar[XB_TMO], 1u); break; } }
    }
    nloc = mine > 0u ? mine : 1u; nx = cnt > 0u ? cnt : 1u;
}

__device__ __forceinline__ void xcd_barrier(const XcdBarrier& b) {
    asm volatile("s_waitcnt vmcnt(0)" ::: "memory");
    __syncthreads();
    if (threadIdx.x == 0) {
        unsigned* bar = b.bar;
        __builtin_amdgcn_s_waitcnt(0);
        unsigned nloc = b.st[0], nx = b.st[1];
        if (nloc == 0u) { xcd_barrier_complete(bar, b.x, nloc, nx); b.st[0] = nloc; b.st[1] = nx; }
        const unsigned old = xb_add(&bar[XB_XSUB(b.x)], 1u);
        const unsigned gen = old / nloc;
        if (old + 1u == (gen + 1u) * nloc) {
            __builtin_amdgcn_fence(__ATOMIC_RELEASE, "agent");
            asm volatile("s_waitcnt vmcnt(0)" ::: "memory");
            const unsigned og = xb_add(&bar[XB_TOP], 1u);
            const unsigned tg = og / nx;
            if (og + 1u == (tg + 1u) * nx) xb_add(&bar[XB_TOPGEN], 1u);
            else XB_SPIN(xb_ld(&bar[XB_TOPGEN]) == tg, bar);
            __builtin_amdgcn_fence(__ATOMIC_ACQUIRE, "agent");
            xb_add(&bar[XB_XGEN(b.x)], 1u);
            asm volatile("s_waitcnt vmcnt(0)" ::: "memory");
        } else {
            XB_SPIN(xb_ld(&bar[XB_XGEN(b.x)]) == gen, bar);
            __builtin_amdgcn_fence(__ATOMIC_ACQUIRE, "agent");
            asm volatile("s_waitcnt vmcnt(0)" ::: "memory");
        }
    }
    __syncthreads();
}


constexpr int NWAVES = 8;
constexpr int LDS_BYTES = 160 * 1024;
constexpr int MISC_OFF = LDS_BYTES - 256;
constexpr int CW_BAR = 4096;

struct Args { Ptrs P; int ph_lo, ph_hi; };
constexpr int N_PHASES = 1 + 8 * 4;
#ifndef PROBE_ID
#define PROBE_ID 0
#endif
#ifndef PROBE_DRY
#define PROBE_DRY 0
#endif
#ifndef PROBE_REPS
#define PROBE_REPS 3
#endif

#define SITE_IDS() int tid_s = threadIdx.x; asm volatile("" : "+v"(tid_s)); const int lane = tid_s & 63; const int wave = __builtin_amdgcn_readfirstlane(tid_s >> 6); \
    const int gw = bx * NWAVES + wave; (void)gw; (void)lane
__global__ void __launch_bounds__(NWAVES * 64, 2) mega_fwd(Args args) {
    extern __shared__ __attribute__((aligned(16))) unsigned char lds[];
    const Ptrs& P = args.P;
    const int G = gridDim.x, bx = blockIdx.x, ngw = G * NWAVES;
    volatile LAS unsigned* MISC = (volatile LAS unsigned*)((LAS unsigned char*)lds + MISC_OFF);
    for (int u = threadIdx.x; u < 64; u += NWAVES * 64) MISC[u] = 0u;
    __syncthreads();
    XcdBarrier bar = xcd_barrier_post((unsigned*)(P.ws + OFF_CTL) + CW_BAR, MISC + 8);
    const int lo = args.ph_lo, hi = args.ph_hi;
#define IN(k) (lo <= (k) && (k) < hi)
#define SEAM(k) do { if (IN(k) && IN((k) + 1)) xcd_barrier(bar); } while (0)
#define WSCR() ((float*)lds + wave * (64 * 65))

#define REPS(id) ((PROBE_ID == (id)) ? PROBE_REPS : 1)
#pragma unroll 1
    for (int rp = REPS(9); rp > 0; --rp) { if (IN(0)) { SITE_IDS(); prologue_work(P, gw, ngw, WSCR(), lane); } SEAM(0); }
#pragma unroll 1
    for (int l = 0; l < 4; ++l) {
        const int pb = 1 + 8 * l;
        if (l < 2) {
#pragma unroll 1
            for (int rp = REPS(1); rp > 0; --rp) {
            if (IN(pb + 0)) {
                { SITE_IDS(); if (l == 0 && rp == 1) for (int j = gw; j < 4 * D; j += ngw) colsum_job(P, j, lane);
                  for (int j = bx; j < 33; j += G) strip_job(P, SP_INA, l, M / 16, j, lane, 8, wave, (float*)lds);
                  for (int j = gw; j < M / 16; j += ngw) strip_job(P, SP_INA, l, j, 32, lane); }
                { pg8::Gemm g{WSP(bf16, OFF_H8A), WSP(bf16, OFF_WIN8 + l * SZ_WIN8), M, 1536, D / 2}; pg8::StaticOrder So; So.init(M, 1536, G, bx);
                  EpiInA E{P, l, 1, 0};
                  pg8::gemm_phase<EpiInA, pg8::StaticOrder, true, true, 1, true>((LAS unsigned char*)lds, g, So, E); }
                { pg8::Gemm g{WSP(bf16, OFF_H), WSP(bf16, OFF_WIN + l * SZ_WIN) + (size_t)1536 * D, M, 512, D}; pg8::StaticOrder So; So.init(M, 512, G, bx);
                  EpiInA E{P, l, 0, 6};
                  pg8::gemm_phase<EpiInA, pg8::StaticOrder, true, true>((LAS unsigned char*)lds, g, So, E); }
                { SITE_IDS(); zero_pads(P, gw, ngw, lane); }
            }
            SEAM(pb + 0); }
#pragma unroll 1
            for (int rp = REPS(2); rp > 0; --rp) {
            if (IN(pb + 1)) { SITE_IDS();
                const int itv = (G == 256) ? ((bx & 7) * 256 + (bx >> 3) * 8 + wave) : gw;
                for (int it = itv; it < NB * 128; it += ngw) { const int b = it >> 7, w = it & 127;
#pragma unroll 1
                    for (int j = 0; j < 8; ++j) { const int g2 = 128 * j + ((j & 1) ? 127 - w : w); indexer_pass(P, b, g2, lane, (LAS unsigned*)lds + wave * (IDX_LDS_PER_WAVE / 4), rp > 1 ? PROBE_DRY : 0); } } }
            SEAM(pb + 1); }
#pragma unroll 1
            for (int rp = REPS(3); rp > 0; --rp) {
            if (IN(pb + 2)) {
                { SITE_IDS(); attn_naive_work<0>(P, gw, ngw, WSCR(), lane, M, MR); }
                __syncthreads();
                if (PROBE_DRY && rp > 1) attn_phase_fa<2>(P, (char*)lds, G, bx, (bf16*)P.out, l); else
                attn_phase_fa<0>(P, (char*)lds, G, bx, rp > 1 ? (bf16*)P.out : WSP(bf16, OFF_QO), l);
            }
            SEAM(pb + 2); }
        } else {
#pragma unroll 1
            for (int rp = REPS(7); rp > 0; --rp) {
            if (IN(pb + 0)) {
                if (l == 2) { SITE_IDS(); for (int j = bx; j < 33; j += G) strip_job(P, SP_QKVB, l, M / 16, 16 + j, lane, 8, wave, (float*)lds);
                  for (int j = gw; j < M / 16; j += ngw) strip_job(P, SP_QKVB, l, j, 48, lane); }
                pg8::Gemm g{WSP(bf16, OFF_H8B), WSP(bf16, OFF_WQKV8 + (l == 2 ? 0 : size_t(3072) * D)), M, l == 2 ? 3072 : 1024, D / 2}; pg8::StaticOrder So; So.init(M, g.N, G, bx);
                EpiInB E{P, l};
                pg8::gemm_phase<EpiInB, pg8::StaticOrder, true, true, 1, true>((LAS unsigned char*)lds, g, So, E);
            }
            SEAM(pb + 0); }
            if (IN(pb + 1) && l == 2) { SITE_IDS(); for (int bh = bx; bh < 256; bh += G) scan_work(P, bh, (float*)lds, tid_s); }
            SEAM(pb + 1);
#pragma unroll 1
            for (int rp = REPS(8); rp > 0; --rp) {
            if (IN(pb + 2)) attn_phase_fa<1>(P, (char*)lds, G, bx, rp > 1 ? (bf16*)P.out : WSP(bf16, OFF_QO), l);
            SEAM(pb + 2); }
        }
#pragma unroll 1
        for (int rp = REPS(4); rp > 0; --rp) {
        if (IN(pb + 3)) {
            if (l < 2 && rp == 1) { SITE_IDS(); for (int j = bx; j < 16; j += G) strip_job(P, SP_RES_O, l, M / 16, j, lane, 8, wave, (float*)lds); }
            pg8::Gemm g{WSP(bf16, OFF_QO), wo_t(P, l), M, D, D}; pg8::StaticOrder So; So.init(M, D, G, bx);
            EpiRes<false> E{P, l, rp > 1};
            pg8::gemm_phase<EpiRes<false>, pg8::StaticOrder, true, true>((LAS unsigned char*)lds, g, So, E);
        }
        SEAM(pb + 3); }
#pragma unroll 1
        for (int rp = REPS(5); rp > 0; --rp) {
        if (IN(pb + 4)) {
            if (l < 2) { SITE_IDS(); for (int j = bx; j < 64; j += G) strip_job(P, SP_MLP1, l, M / 16, j, lane, 8, wave, (float*)lds); }
            pg8::Gemm g{WSP(bf16, OFF_HQ), WSP(bf16, OFF_W18 + l * SZ_W28), M, FF, D / 2}; pg8::StaticOrder So; So.init(M, FF, G, bx);
            EpiRelu2 E{P, l, (PROBE_DRY && rp > 1) ? 1 : 0};
            pg8::gemm_phase<EpiRelu2, pg8::StaticOrder, true, true, 2, true>((LAS unsigned char*)lds, g, So, E);
        }
        SEAM(pb + 4); }
#pragma unroll 1
        for (int rp = REPS(6); rp > 0; --rp) {
        if (IN(pb + 5)) {
            if (l < 2 && rp == 1) { SITE_IDS(); for (int j = bx; j < 16; j += G) strip_job(P, SP_RES_M, l, M / 16, j, lane, 8, wave, (float*)lds); }
            pg8::StaticOrder So; So.init(M, D, G, bx); EpiRes<true> E{P, l, rp > 1};
            pg8::Gemm g{WSP(bf16, OFF_U), WSP(bf16, OFF_W28 + l * SZ_W28), M, D, FF / 2};
            pg8::gemm_phase<EpiRes<true>, pg8::StaticOrder, true, true, 2, true>((LAS unsigned char*)lds, g, So, E);
        }
        if (rp > 1 || (l < 3 && IN(pb + 5) && IN(pb + 8))) xcd_barrier(bar); }
    }
#undef IN
#undef SEAM
}

#ifndef MK_ONE_LAUNCH
#define MK_ONE_LAUNCH 1
#endif
extern "C" void kernel_launch(void* const* d_in, const int* in_sizes, int n_in, void* d_out, int out_size, void* d_ws, size_t ws_size, hipStream_t stream) {
    static int grid = 0;
    if (grid == 0) {
        if (n_in != 17 || in_sizes[0] != M * D || out_size != M * D || ws_size < WS_END) {
            fprintf(stderr, "kernel_launch: unexpected shapes (n_in %d, in0 %d, out %d, ws %zu, need %zu)\n", n_in, n_in > 0 ? in_sizes[0] : -1, out_size, ws_size, (size_t)WS_END); grid = -1; return; }
        int dev = 0, cus = 0, per_cu = 0;
        if (hipGetDevice(&dev) != hipSuccess || hipDeviceGetAttribute(&cus, hipDeviceAttributeMultiprocessorCount, dev) != hipSuccess) { grid = -1; return; }
        if (hipFuncSetAttribute((const void*)mega_fwd, hipFuncAttributeMaxDynamicSharedMemorySize, LDS_BYTES) != hipSuccess) { fprintf(stderr, "kernel_launch: hipFuncSetAttribute failed\n"); grid = -1; return; }
        if (hipOccupancyMaxActiveBlocksPerMultiprocessor(&per_cu, (const void*)mega_fwd, NWAVES * 64, LDS_BYTES) != hipSuccess || per_cu < 1)
            fprintf(stderr, "kernel_launch: note: occupancy query reports %d workgroups per CU\n", per_cu);
        (void)hipGetLastError();
        grid = cus;
    }
    if (grid < 0) return;
    (void)hipMemsetAsync((char*)d_ws + OFF_CTL, 0, 65536, stream);
    Args a{};
    for (int i = 0; i < 17; ++i) a.P.in[i] = (const float*)d_in[i];
    a.P.out = (float*)d_out; a.P.ws = (unsigned char*)d_ws;
#if MK_ONE_LAUNCH
    a.ph_lo = 0; a.ph_hi = N_PHASES;
    hipLaunchKernelGGL(mega_fwd, dim3(grid), dim3(NWAVES * 64), LDS_BYTES, stream, a);
#else
    for (int ph = 0; ph < N_PHASES; ++ph) { a.ph_lo = ph; a.ph_hi = ph + 1; hipLaunchKernelGGL(mega_fwd, dim3(grid), dim3(NWAVES * 64), LDS_BYTES, stream, a); }
#endif
}
```

```cpp
#include <hip/hip_runtime.h>
#include <cstdint>
#include <cstdio>

typedef unsigned short bf16;
typedef short bf16x8 __attribute__((ext_vector_type(8)));
typedef float f32x4 __attribute__((ext_vector_type(4)));
typedef float f32x16 __attribute__((ext_vector_type(16)));
typedef unsigned u32x4 __attribute__((ext_vector_type(4)));

constexpr int NB = 16, S = 2048, D = 1024, NMETA = 16, HD = 64, FF = 4096;
constexpr int M = NB * S, MR = M + NMETA;
constexpr int PRE = 64, KROWS = PRE + S;
constexpr int NWORDS = KROWS / 32;
constexpr int NPOS = S + NMETA;
constexpr int WIN_ROWS = 2048 + 96, WKV_ROWS = 2048 + 32;
constexpr float EPS = 1e-6f;
constexpr float LOG2E = 1.4426950408889634f;
constexpr float C2 = 0.125f * LOG2E;
constexpr int TOPK = 256;

constexpr size_t al4k(size_t x) { return (x + 4095) & ~size_t(4095); }
constexpr size_t OFF_CTL = 0, SZ_CTL = size_t(4) << 20;
constexpr size_t OFF_ROPE = OFF_CTL + SZ_CTL, SZ_ROPE = al4k(size_t(2) * NPOS * 32 * 4);
constexpr size_t OFF_SSQ = OFF_ROPE + SZ_ROPE, SZ_SSQ1 = al4k(size_t(MR) * 16 * 4);
constexpr size_t OFF_GT = OFF_SSQ + 2 * SZ_SSQ1, SZ_GT = 4096;
constexpr int GT_AQG = 0, GT_AKG = 128, GT_KFB = 256, GT_KKG = 272, GT_BQG = 336, GT_N = 464, GT_SKIP = 464;
constexpr size_t OFF_W1B = OFF_GT + SZ_GT;
constexpr size_t SZ_W1 = size_t(FF) * D * 2, SZ_W2 = SZ_W1, SZ_SQ = size_t(D) * D * 2;
constexpr size_t OFF_W2B = OFF_W1B + 2 * SZ_W1;
constexpr size_t OFF_WOB = OFF_W2B + 2 * SZ_W2;
constexpr size_t OFF_WQ1 = OFF_WOB + 2 * SZ_SQ;
constexpr size_t OFF_WQ0 = OFF_WQ1 + SZ_SQ;
constexpr size_t OFF_WKV = OFF_WQ0 + SZ_SQ, SZ_WKV = al4k(size_t(WKV_ROWS) * D * 2);
constexpr size_t OFF_H = OFF_WKV + SZ_WKV, SZ_H = al4k(size_t(MR) * D * 2);
constexpr size_t OFF_SCR = OFF_H + SZ_H;
constexpr size_t OFF_U = OFF_SCR, SZ_U = al4k(size_t(MR) * FF * 2);
constexpr size_t OFF_QO = OFF_SCR, SZ_QO = al4k(size_t(MR) * D * 2);
constexpr size_t OFF_KA = OFF_QO + SZ_QO, SZ_KA = al4k(size_t(NB) * KROWS * 256 * 2 + 65536);
constexpr size_t OFF_VA = OFF_KA + SZ_KA;
constexpr size_t OFF_KI = OFF_VA + SZ_KA, SZ_KI = al4k(size_t(NB) * KROWS * 64 * 2 + 65536);
constexpr size_t OFF_QI = OFF_KI + SZ_KI, SZ_QI = al4k(size_t(MR) * 512 * 2);
constexpr size_t OFF_WI = OFF_QI + SZ_QI, SZ_WI = al4k(size_t(MR) * 8 * 4);
constexpr size_t OFF_MASK = OFF_WI + SZ_WI, SZ_MASK = al4k(size_t(M) * NWORDS * 4);
constexpr size_t OFF_LF = OFF_MASK + SZ_MASK, SZ_LF = al4k(size_t(MR) * 16 * 4);
constexpr size_t OFF_UM = OFF_U + size_t(M) * FF * 2;
constexpr size_t OFF_W28 = OFF_W2B, SZ_W28 = size_t(D) * FF;
constexpr size_t OFF_W18 = OFF_W1B;
static_assert(OFF_LF + SZ_LF <= OFF_U + SZ_U && OFF_UM + size_t(16) * FF * 2 <= OFF_U + SZ_U && 4 * SZ_W28 <= 2 * SZ_W2, "mixer scratch / hidden / fp8 W2 fit");
constexpr size_t OFF_X = OFF_SCR + SZ_U;
constexpr size_t SZ_WIN = al4k(size_t(WIN_ROWS) * D * 2);
constexpr size_t OFF_WIN = OFF_X;
constexpr size_t OFF_WOA = OFF_WIN + 2 * SZ_WIN;
constexpr size_t OFF_W1A = OFF_WOA + 2 * SZ_SQ;
constexpr size_t OFF_W2A = OFF_W1A + 2 * SZ_W1;
constexpr size_t OFF_KB = OFF_X, SZ_KB = al4k(size_t(NB) * KROWS * D * 2 + 262144);
constexpr size_t OFF_VB = OFF_KB + SZ_KB;
constexpr size_t OFF_NB = OFF_VB + SZ_KB, SZ_NB = al4k(size_t(NB) * 16 * KROWS * 4);
constexpr size_t WS_END = OFF_NB + SZ_NB;
constexpr size_t SZ_H8 = size_t(M) * D, OFF_H8A = OFF_X + (size_t(48) << 20), OFF_H8B = OFF_SCR + (size_t(160) << 20);
constexpr size_t SZ_WIN8 = size_t(2048) * D, OFF_WIN8 = OFF_H8A + SZ_H8;
constexpr size_t OFF_WQKV8 = WS_END;
constexpr size_t OFF_HQ = OFF_SCR + (size_t(192) << 20);
constexpr int EPI_RS_OFF = 132 * 1024;
constexpr size_t OFF_O8 = OFF_SCR + (size_t(224) << 20);
constexpr float O_F8S = 16.f;
constexpr size_t OFF_WO8A = OFF_WIN8 + 2 * SZ_WIN8;
static_assert(OFF_WO8A + 2 * (SZ_SQ / 2) <= WS_END, "fp8 WoutA fits in region X");
static_assert(OFF_HQ + SZ_H8 <= OFF_O8 && OFF_O8 + SZ_H8 <= OFF_UM, "fp8 attention output fits");
constexpr int CW_CS = 12288;
constexpr float QA = 127.f / 4.25f, QW1 = 127.f * 32.f / 4.f, QU = 255.f / 20.f, QW2 = 127.f * 64.f / 4.f, SQRT_QU = 3.5707142143f;
constexpr float IN_F8S = 32.f;
static_assert(OFF_W2A + 2 * SZ_W2 <= OFF_H8A && OFF_WIN8 + 2 * SZ_WIN8 <= WS_END && OFF_LF + SZ_LF <= OFF_H8B && size_t(M) * FF <= (size_t(160) << 20) && OFF_H8B + SZ_H8 <= OFF_HQ && OFF_HQ + SZ_H8 <= OFF_UM && OFF_WQKV8 + size_t(4096) * D <= (size_t(512) << 20), "8-bit buffers fit");
static_assert(OFF_W2A + 2 * SZ_W2 <= WS_END, "A weights fit in region X");
static_assert(WS_END <= (size_t(512) << 20), "d_ws map fits 512 MiB");

#define GAS __attribute__((address_space(1)))
#define LAS __attribute__((address_space(3)))
__device__ __forceinline__ unsigned f2bf(float f) { unsigned u = __builtin_bit_cast(unsigned, f); return (u + 0x7fffu + ((u >> 16) & 1u)) >> 16; }
__device__ __forceinline__ float bf2f(unsigned h) { return __builtin_bit_cast(float, h << 16); }
__device__ __forceinline__ unsigned pk2(float lo, float hi) { return f2bf(lo) | (f2bf(hi) << 16); }
typedef unsigned u32x2 __attribute__((ext_vector_type(2)));
__device__ __forceinline__ size_t blk8(int R, int c, int rowlen) { return ((size_t)(R >> 4) * (rowlen / 32) + (c >> 5)) * 512 + (R & 15) * 32 + (c & 31); }
typedef int i32x4v __attribute__((ext_vector_type(4)));
__device__ __forceinline__ unsigned pk4_fp8(float a, float b, float c, float d) {
    a = fminf(fmaxf(a, -448.f), 448.f); b = fminf(fmaxf(b, -448.f), 448.f); c = fminf(fmaxf(c, -448.f), 448.f); d = fminf(fmaxf(d, -448.f), 448.f);
    int p = __builtin_amdgcn_cvt_pk_fp8_f32(a, b, 0, false); p = __builtin_amdgcn_cvt_pk_fp8_f32(c, d, p, true); return (unsigned)p; }
__device__ __forceinline__ unsigned pk4_i8(float a, float b, float c, float d) {
    a += 128.f; b += 128.f; c += 128.f; d += 128.f;
    int p = __builtin_amdgcn_cvt_pk_u8_f32(a, 0, 0); p = __builtin_amdgcn_cvt_pk_u8_f32(b, 1, p); p = __builtin_amdgcn_cvt_pk_u8_f32(c, 2, p); p = __builtin_amdgcn_cvt_pk_u8_f32(d, 3, p);
    return (unsigned)p ^ 0x80808080u; }
__device__ __forceinline__ float red16(float v) { v += __shfl_xor(v, 1); v += __shfl_xor(v, 2); v += __shfl_xor(v, 4); v += __shfl_xor(v, 8); return v; }
__device__ __forceinline__ float wave_sum(float v) {
#pragma unroll
    for (int o = 1; o < 64; o <<= 1) v += __shfl_xor(v, o);
    return v;
}
__device__ __forceinline__ float wave_max(float v) {
#pragma unroll
    for (int o = 1; o < 64; o <<= 1) v = fmaxf(v, __shfl_xor(v, o));
    return v;
}

struct Ptrs {
    const float* in[17]; float* out; unsigned char* ws;
};
#define WSP(T, off) ((T*)(P.ws + (off)))
__device__ __forceinline__ bf16* w1_t(const Ptrs& P, int l) { return l < 2 ? WSP(bf16, OFF_W1A + l * SZ_W1) : WSP(bf16, OFF_W1B + (l - 2) * SZ_W1); }
__device__ __forceinline__ bf16* w2_t(const Ptrs& P, int l) { return l < 2 ? WSP(bf16, OFF_W2A + l * SZ_W2) : WSP(bf16, OFF_W2B + (l - 2) * SZ_W2); }
__device__ __forceinline__ bf16* wo_t(const Ptrs& P, int l) { return l < 2 ? WSP(bf16, OFF_WOA + l * SZ_SQ) : WSP(bf16, OFF_WOB + (l - 2) * SZ_SQ); }
__device__ __forceinline__ float* ssq_p(const Ptrs& P, int k) { return WSP(float, OFF_SSQ + (size_t)(k & 1) * SZ_SSQ1); }

struct MatDesc { const float* W; int pitch, K, col0, ncols, nblk; const float* gain; bf16* WT; int dst0, perm; unsigned char* WT8; float s8; int q8; int* cs; };
__device__ __forceinline__ bool get_mat(const Ptrs& P, int id, MatDesc& d) {
    d.gain = nullptr; d.perm = 0; d.dst0 = 0; d.col0 = 0; d.WT8 = nullptr; d.s8 = IN_F8S; d.q8 = 0; d.cs = nullptr;
    if (id < 2) { d.W = P.in[6] + (size_t)id * D * 2120; d.pitch = 2120; d.K = D; d.ncols = 2048; d.nblk = 64; d.gain = P.in[2] + id * D; d.WT = WSP(bf16, OFF_WIN + id * SZ_WIN); d.perm = 1; d.WT8 = WSP(unsigned char, OFF_WIN8 + id * SZ_WIN8); d.s8 = QW1; d.q8 = 1; return true; }
    if (id < 4) { const int l = id - 2; d.W = P.in[6] + (size_t)l * D * 2120; d.pitch = 2120; d.K = D; d.col0 = 2048; d.ncols = 72; d.nblk = 3; d.gain = P.in[2] + l * D; d.WT = WSP(bf16, OFF_WIN + l * SZ_WIN); d.dst0 = 2048; return true; }
    if (id < 6) { const int l = id - 4; d.W = P.in[9] + (size_t)l * D * D; d.pitch = D; d.K = D; d.ncols = D; d.nblk = 32; d.WT = WSP(bf16, OFF_WOA + l * SZ_SQ); d.WT8 = WSP(unsigned char, OFF_WO8A + l * (SZ_SQ / 2)); return true; }
    if (id < 10) { const int l = id - 6; d.W = P.in[4] + (size_t)l * D * FF; d.pitch = FF; d.K = D; d.ncols = FF; d.nblk = 128; d.gain = P.in[3] + l * D; d.WT = l < 2 ? w1_t(P, l) : nullptr; d.WT8 = WSP(unsigned char, OFF_W18 + l * SZ_W28); d.s8 = QW1; d.q8 = 1; return true; }
    if (id < 14) { const int l = id - 10; d.W = P.in[5] + (size_t)l * FF * D; d.pitch = D; d.K = FF; d.ncols = D; d.nblk = 32; d.WT = l < 2 ? w2_t(P, l) : nullptr; d.WT8 = WSP(unsigned char, OFF_W28 + l * SZ_W28); d.s8 = QW2; d.q8 = 1; return true; }
    if (id == 14) { d.W = P.in[11]; d.pitch = 2064; d.K = D; d.col0 = 0; d.ncols = 1024; d.nblk = 32; d.gain = P.in[10]; d.WT = WSP(bf16, OFF_WKV); d.perm = 1; d.WT8 = WSP(unsigned char, OFF_WQKV8 + size_t(1024) * D); d.s8 = QW1; d.q8 = 1; return true; }
    if (id == 15) { d.W = P.in[11]; d.pitch = 2064; d.K = D; d.col0 = 1024; d.ncols = 1024; d.nblk = 32; d.gain = P.in[10]; d.WT = WSP(bf16, OFF_WKV); d.perm = 1; d.dst0 = 1024; d.WT8 = WSP(unsigned char, OFF_WQKV8 + size_t(1024) * D); d.s8 = QW1; d.q8 = 1; return true; }
    if (id == 16) { d.W = P.in[11]; d.pitch = 2064; d.K = D; d.col0 = 2048; d.ncols = 16; d.nblk = 1; d.gain = P.in[10]; d.WT = WSP(bf16, OFF_WKV); d.dst0 = 2048; return true; }
    if (id < 19) { const int j = id - 17; d.W = P.in[14] + (size_t)j * D * D; d.pitch = D; d.K = D; d.ncols = D; d.nblk = 32; d.gain = P.in[2] + (2 + j) * D; d.WT = WSP(bf16, j == 0 ? OFF_WQ0 : OFF_WQ1); d.perm = 1; d.WT8 = WSP(unsigned char, OFF_WQKV8 + (j == 0 ? 0 : size_t(3072) * D)); d.s8 = QW1; d.q8 = 1; return true; }
    if (id < 21) { const int j = id - 19; d.W = P.in[16] + (size_t)j * D * D; d.pitch = D; d.K = D; d.ncols = D; d.nblk = 32; d.WT = nullptr; d.WT8 = WSP(unsigned char, OFF_WOB + j * (SZ_SQ / 2)); return true; }
    return false;
}
constexpr int NMAT = 21;
__device__ __forceinline__ void transpose_block(const MatDesc& d, int item, float* scr, int lane) {
    const int nb64 = (d.nblk + 1) >> 1, kb = item / nb64, nb = item % nb64, k0 = 64 * kb, n0 = 64 * nb;
    const int c4 = lane & 15; const bool okc = (n0 + 4 * c4) < d.ncols;
#pragma unroll 8
    for (int i = 0; i < 16; ++i) { const int kk = 4 * i + (lane >> 4);
        f32x4 v = okc ? *(const f32x4*)(d.W + (size_t)(k0 + kk) * d.pitch + d.col0 + n0 + 4 * c4) : (f32x4){0.f, 0.f, 0.f, 0.f};
        if (d.gain) v = v * d.gain[k0 + kk];
        float* sp = scr + kk * 65 + 4 * c4; sp[0] = v[0]; sp[1] = v[1]; sp[2] = v[2]; sp[3] = v[3]; }
    __builtin_amdgcn_s_waitcnt(0xc07f); asm volatile("" ::: "memory");
    const int c = lane & 7;
#pragma unroll
    for (int hb = 0; hb < 2; ++hb) {
        const int nn0 = n0 + 32 * hb; if (nn0 >= 32 * d.nblk) break;
        int drow0;
        if (d.perm) { const int pn = nn0 >> 8, wc = (nn0 & 255) >> 6, bj = (nn0 & 63) >> 5; drow0 = d.dst0 + 256 * pn + 128 * bj + 32 * wc; }
        else drow0 = d.dst0 + nn0;
#pragma unroll
        for (int j = 0; j < 4; ++j) { const int n = (lane >> 3) + 8 * j; const float* sq = scr + (8 * c) * 65 + 32 * hb + n;
            u32x4 o; o.x = pk2(sq[0 * 65], sq[1 * 65]); o.y = pk2(sq[2 * 65], sq[3 * 65]); o.z = pk2(sq[4 * 65], sq[5 * 65]); o.w = pk2(sq[6 * 65], sq[7 * 65]);
            if (d.WT) *(u32x4*)(d.WT + (size_t)(drow0 + n) * d.K + k0 + 8 * c) = o;
            if (d.WT8) { u32x2 o8;
                if (d.q8) { o8.x = pk4_i8(sq[0 * 65] * d.s8, sq[1 * 65] * d.s8, sq[2 * 65] * d.s8, sq[3 * 65] * d.s8); o8.y = pk4_i8(sq[4 * 65] * d.s8, sq[5 * 65] * d.s8, sq[6 * 65] * d.s8, sq[7 * 65] * d.s8); }
                else { o8.x = pk4_fp8(sq[0 * 65] * d.s8, sq[1 * 65] * d.s8, sq[2 * 65] * d.s8, sq[3 * 65] * d.s8); o8.y = pk4_fp8(sq[4 * 65] * d.s8, sq[5 * 65] * d.s8, sq[6 * 65] * d.s8, sq[7 * 65] * d.s8); }
                *(u32x2*)(d.WT8 + (size_t)(drow0 + n) * d.K + k0 + 8 * c) = o8; } }
    }
    __builtin_amdgcn_s_waitcnt(0xc07f); asm volatile("" ::: "memory");
}
__device__ __forceinline__ void tb_load(const MatDesc& d, int item, int lane, f32x4 (&v)[16]) {
    const int nb64 = (d.nblk + 1) >> 1, kb = item / nb64, nb = item % nb64, k0 = 64 * kb, n0 = 64 * nb;
    const int c4 = lane & 15; const bool okc = (n0 + 4 * c4) < d.ncols;
#pragma unroll
    for (int i = 0; i < 16; ++i) { const int kk = 4 * i + (lane >> 4);
        v[i] = okc ? *(const f32x4*)(d.W + (size_t)(k0 + kk) * d.pitch + d.col0 + n0 + 4 * c4) : (f32x4){0.f, 0.f, 0.f, 0.f}; }
}
__device__ __forceinline__ void tb_stage(const MatDesc& d, int item, int lane, const f32x4 (&v)[16], float* scr) {
    const int nb64 = (d.nblk + 1) >> 1, kb = item / nb64, k0 = 64 * kb; const int c4 = lane & 15;
#pragma unroll
    for (int i = 0; i < 16; ++i) { const int kk = 4 * i + (lane >> 4); f32x4 x = v[i];
        if (d.gain) x = x * d.gain[k0 + kk];
        float* sp = scr + kk * 65 + 4 * c4; sp[0] = x[0]; sp[1] = x[1]; sp[2] = x[2]; sp[3] = x[3]; }
}
__device__ __forceinline__ void tb_store(const MatDesc& d, int item, float* scr, int lane) {
    const int nb64 = (d.nblk + 1) >> 1, kb = item / nb64, nb = item % nb64, k0 = 64 * kb, n0 = 64 * nb;
    const int c = lane & 7;
#pragma unroll
    for (int hb = 0; hb < 2; ++hb) {
        const int nn0 = n0 + 32 * hb; if (nn0 >= 32 * d.nblk) break;
        int drow0;
        if (d.perm) { const int pn = nn0 >> 8, wc = (nn0 & 255) >> 6, bj = (nn0 & 63) >> 5; drow0 = d.dst0 + 256 * pn + 128 * bj + 32 * wc; }
        else drow0 = d.dst0 + nn0;
#pragma unroll
        for (int j = 0; j < 4; ++j) { const int n = (lane >> 3) + 8 * j; const float* sq = scr + (8 * c) * 65 + 32 * hb + n;
            u32x4 o; o.x = pk2(sq[0 * 65], sq[1 * 65]); o.y = pk2(sq[2 * 65], sq[3 * 65]); o.z = pk2(sq[4 * 65], sq[5 * 65]); o.w = pk2(sq[6 * 65], sq[7 * 65]);
            if (d.WT) *(u32x4*)(d.WT + (size_t)(drow0 + n) * d.K + k0 + 8 * c) = o;
            if (d.WT8) { u32x2 o8;
                if (d.q8) { o8.x = pk4_i8(sq[0 * 65] * d.s8, sq[1 * 65] * d.s8, sq[2 * 65] * d.s8, sq[3 * 65] * d.s8); o8.y = pk4_i8(sq[4 * 65] * d.s8, sq[5 * 65] * d.s8, sq[6 * 65] * d.s8, sq[7 * 65] * d.s8); }
                else { o8.x = pk4_fp8(sq[0 * 65] * d.s8, sq[1 * 65] * d.s8, sq[2 * 65] * d.s8, sq[3 * 65] * d.s8); o8.y = pk4_fp8(sq[4 * 65] * d.s8, sq[5 * 65] * d.s8, sq[6 * 65] * d.s8, sq[7 * 65] * d.s8); }
                *(u32x2*)(d.WT8 + (size_t)(drow0 + n) * d.K + k0 + 8 * c) = o8; } }
    }
}
__device__ __forceinline__ bool tb_next(const Ptrs& P, int gw, int ngw, int& id, int& it, int& base, MatDesc& d) {
    if (id >= 0) { it += ngw; if (it < (d.K / 64) * ((d.nblk + 1) >> 1)) return true; base += (d.K / 64) * ((d.nblk + 1) >> 1); }
    for (;;) { ++id; if (id >= NMAT) return false; get_mat(P, id, d);
        const int nit = (d.K / 64) * ((d.nblk + 1) >> 1); it = (gw - base % ngw + ngw) % ngw; if (it < nit) return true; base += nit; }
}
__device__ __forceinline__ void prologue_work(const Ptrs& P, int gw, int ngw, float* scr, int lane) {
    { int id = -1, it = 0, base = 0; MatDesc dn; f32x4 v[16];
      bool have = tb_next(P, gw, ngw, id, it, base, dn);
      if (have) tb_load(dn, it, lane, v);
#pragma unroll 1
      while (have) {
          const MatDesc dc = dn; const int ic = it;
          tb_stage(dc, ic, lane, v, scr);
          have = tb_next(P, gw, ngw, id, it, base, dn);
          if (have) tb_load(dn, it, lane, v);
          __builtin_amdgcn_s_waitcnt(0xc07f); asm volatile("" ::: "memory");
          tb_store(dc, ic, scr, lane);
          __builtin_amdgcn_s_waitcnt(0xc07f); asm volatile("" ::: "memory");
      } }
    bf16* H = WSP(bf16, OFF_H); float* ssq0 = ssq_p(P, 0);
    { f32x4 nx[4];
      { const int r = gw < MR ? gw : MR - 1; const float* src = r < M ? P.in[0] + (size_t)r * D : P.in[1] + (size_t)(r - M) * D;
#pragma unroll
        for (int j = 0; j < 4; ++j) nx[j] = *(const f32x4*)(src + 256 * j + 4 * lane); }
    for (int r = gw; r < MR; r += ngw) {
        float s = 0.f; f32x4 vv[4];
#pragma unroll
        for (int j = 0; j < 4; ++j) vv[j] = nx[j];
        { const int rn = r + ngw < MR ? r + ngw : r; const float* srcn = rn < M ? P.in[0] + (size_t)rn * D : P.in[1] + (size_t)(rn - M) * D;
#pragma unroll
          for (int j = 0; j < 4; ++j) nx[j] = *(const f32x4*)(srcn + 256 * j + 4 * lane); }
#pragma unroll
        for (int j = 0; j < 4; ++j) { const f32x4 v = vv[j]; s += v.x * v.x + v.y * v.y + v.z * v.z + v.w * v.w;
            uint2 o; o.x = pk2(v.x, v.y); o.y = pk2(v.z, v.w); *(uint2*)(H + (size_t)r * D + 256 * j + 4 * lane) = o; }
        s = wave_sum(s); if (lane < 16) ssq0[(size_t)r * 16 + lane] = lane == 0 ? s : 0.f;
        if (r < M) { const float qs = rsqrtf(s * (1.0f / D) + EPS) * QA;
#pragma unroll
            for (int j = 0; j < 4; ++j) *(unsigned*)(WSP(unsigned char, OFF_H8A) + blk8(r, 256 * j + 4 * lane, D)) = pk4_i8(vv[j].x * qs, vv[j].y * qs, vv[j].z * qs, vv[j].w * qs); }
    } }
    if (gw == 0) { float* GT = WSP(float, OFF_GT);
        for (int e = lane; e < GT_N; e += 64) { float v;
            if (e < GT_AKG) v = P.in[7][e]; else if (e < GT_KFB) v = P.in[8][e - GT_AKG]; else if (e < GT_KKG) v = P.in[12][e - GT_KFB]; else if (e < GT_BQG) v = P.in[13][e - GT_KKG]; else v = P.in[15][e - GT_BQG];
            GT[e] = v; }
        { float gq = 0.f, gk = 0.f;
          for (int e = lane; e < 128; e += 64) gq = fmaxf(gq, fabsf(P.in[15][e]));
          gk = fabsf(P.in[13][lane]);
          gq = wave_max(gq); gk = wave_max(gk);
          if (lane == 0) GT[GT_SKIP] = 2.0f * 64.0f * C2 * gq * gk + 24.0f; } }
    float* COS = WSP(float, OFF_ROPE); float* SIN = COS + NPOS * 32;
    for (int e = gw * 64 + lane; e < NPOS * 32; e += ngw * 64) { const int pos = e >> 5, i = e & 31;
        const float inv = 1.0f / powf(10000.0f, (float)(2 * i) / 64.0f); const float ang = (float)pos * inv;
        COS[e] = (float)cos((double)ang); SIN[e] = (float)sin((double)ang); }
}
__device__ __forceinline__ void zero_pads(const Ptrs& P, int gw, int ngw, int lane) {
    bf16* KA = WSP(bf16, OFF_KA); bf16* VA = WSP(bf16, OFF_VA); bf16* KI = WSP(bf16, OFF_KI);
    unsigned zz = 0u; asm volatile("" : "+v"(zz));
    for (int e = gw * 64 + lane; e < NB * 48 * 32; e += ngw * 64) { const int b = e / (48 * 32), r = (e / 32) % 48 + 16, c = e % 32;
        const u32x4 z = {zz, zz, zz, zz};
        *(u32x4*)(KA + ((size_t)b * KROWS + r) * 256 + c * 8) = z; *(u32x4*)(VA + ((size_t)b * KROWS + r) * 256 + c * 8) = z;
        if (c < 8) *(u32x4*)(KI + ((size_t)b * KROWS + r) * 64 + c * 8) = z; }
}
__device__ __forceinline__ void colsum_job(const Ptrs& P, int j, int lane) {
    const u32x4* src = (const u32x4*)(WSP(unsigned char, OFF_W28) + (size_t)j * FF); int t = 0;
#pragma unroll
    for (int i = 0; i < 4; ++i) { const u32x4 v = src[i * 64 + lane];
        t = __builtin_amdgcn_sdot4((int)v.x, 0x01010101, t, false); t = __builtin_amdgcn_sdot4((int)v.y, 0x01010101, t, false); t = __builtin_amdgcn_sdot4((int)v.z, 0x01010101, t, false); t = __builtin_amdgcn_sdot4((int)v.w, 0x01010101, t, false); }
#pragma unroll
    for (int o = 1; o < 64; o <<= 1) t += __shfl_xor(t, o);
    if (lane == 0) ((int*)(P.ws + OFF_CTL) + CW_CS)[j] = t;
}
template <int NCT>
__device__ __forceinline__ bool strip_mma(const bf16* A, int lda, const bf16* Bt, const int* brow, int K, f32x4 (&acc)[NCT], int lane, int ks = 1, int wave = 0, float* red = nullptr) {
    const int fr = lane & 15, fq = lane >> 4;
    const int kb = ks == 1 ? 0 : wave * (K / 8), ke = ks == 1 ? K : kb + K / 8;
    const bf16* ap = A + (size_t)fr * lda + 8 * fq;
    const bf16* bp[NCT];
#pragma unroll
    for (int j = 0; j < NCT; ++j) { bp[j] = Bt + (size_t)(brow[j] + fr) * K + 8 * fq; acc[j] = (f32x4){0.f, 0.f, 0.f, 0.f}; }
    bf16x8 ca[2], cb[2][NCT], na[2], nb[2][NCT];
#define SM_LOAD(da, db, k0_) do { _Pragma("unroll") for (int h_ = 0; h_ < 2; ++h_) { da[h_] = *(const bf16x8*)(ap + (k0_) + 32 * h_); \
        _Pragma("unroll") for (int j_ = 0; j_ < NCT; ++j_) db[h_][j_] = *(const bf16x8*)(bp[j_] + (k0_) + 32 * h_); } } while (0)
    SM_LOAD(ca, cb, kb);
#pragma unroll 1
    for (int k0 = kb; k0 < ke; k0 += 64) {
        const int kn = k0 + 64 < ke ? k0 + 64 : k0;
        SM_LOAD(na, nb, kn);
#pragma unroll
        for (int h = 0; h < 2; ++h)
#pragma unroll
            for (int j = 0; j < NCT; ++j) acc[j] = __builtin_amdgcn_mfma_f32_16x16x32_bf16(ca[h], cb[h][j], acc[j], 0, 0, 0);
#pragma unroll
        for (int h = 0; h < 2; ++h) { ca[h] = na[h];
#pragma unroll
            for (int j = 0; j < NCT; ++j) cb[h][j] = nb[h][j]; }
    }
#undef SM_LOAD
    if (ks == 1) return true;
#pragma unroll
    for (int j = 0; j < NCT; ++j)
#pragma unroll
        for (int r = 0; r < 4; ++r) red[(wave * NCT * 4 + j * 4 + r) * 64 + lane] = acc[j][r];
    __syncthreads();
    if (wave == 0) {
#pragma unroll
        for (int j = 0; j < NCT; ++j)
#pragma unroll
            for (int r = 0; r < 4; ++r) { float t = 0.f;
#pragma unroll
                for (int w = 0; w < 8; ++w) t += red[(w * NCT * 4 + j * 4 + r) * 64 + lane];
                acc[j][r] = t; }
    }
    __syncthreads();
    return wave == 0;
}
__device__ __forceinline__ int row_pos(int R) { return R < M ? (R & (S - 1)) + NMETA : R - M; }
__device__ __forceinline__ float row_scale(const float* ssq, int R) {
    const f32x4* p = (const f32x4*)(ssq + (size_t)R * 16); const f32x4 a = p[0], b = p[1], c = p[2], d = p[3];
    const float t = ((a.x + a.y) + (a.z + a.w)) + ((b.x + b.y) + (b.z + b.w)) + ((c.x + c.y) + (c.z + c.w)) + ((d.x + d.y) + (d.z + d.w));
    return rsqrtf(t * (1.0f / D) + EPS);
}

__device__ __forceinline__ float in_qscale(const Ptrs& P, int lc, int R) {
    const f32x4* p = (const f32x4*)(ssq_p(P, lc == 0 ? 0 : 2 * lc - 1) + (size_t)(lc == 0 ? R : 0) * 16); const f32x4 a = p[0], b = p[1], c = p[2], d = p[3];
    const float t = ((a.x + a.y) + (a.z + a.w)) + ((b.x + b.y) + (b.z + b.w)) + ((c.x + c.y) + (c.z + c.w)) + ((d.x + d.y) + (d.z + d.w));
    return rsqrtf(t * (1.0f / D) + (lc == 0 ? 0.0f : 1.5f) + EPS);
}

__device__ __forceinline__ size_t ki_off(size_t grow, int d) { return (grow >> 4) * 1024 + (size_t)((d >> 5) * 512 + ((d >> 3) & 3) * 128 + (int)(grow & 15) * 8 + (d & 7)); }
__device__ __forceinline__ void store_ki(bf16* KI, int R, int d, unsigned v) {
    if (R < M) { const int b = R >> 11, i = R & (S - 1); KI[ki_off((size_t)b * KROWS + PRE + i, d)] = (bf16)v; }
    else { const int j = R - M;
#pragma unroll 4
        for (int b = 0; b < NB; ++b) KI[ki_off((size_t)b * KROWS + j, d)] = (bf16)v; }
}
struct HeadEpi { bf16* dst; int ldd, col0; const float* gain; int norm, rope, kvmap; float scale; const float* ssq; };
__device__ __forceinline__ void store_mapped(bf16* dst, int ldd, int R, int col, unsigned v, int kvmap) {
    if (!kvmap) { dst[(size_t)R * ldd + col] = (bf16)v; return; }
    if (R < M) { const int b = R >> 11, i = R & (S - 1); dst[((size_t)b * KROWS + PRE + i) * ldd + col] = (bf16)v; }
    else { const int j = R - M;
#pragma unroll 4
        for (int b = 0; b < NB; ++b) dst[((size_t)b * KROWS + j) * ldd + col] = (bf16)v; }
}
__device__ __forceinline__ void epi_head(const Ptrs& P, const HeadEpi& E, const f32x4 (&acc)[4], int R0, int lane) {
    const int fr = lane & 15, fq = lane >> 4;
    const float* COS = WSP(float, OFF_ROPE); const float* SIN = COS + NPOS * 32;
#pragma unroll
    for (int reg = 0; reg < 4; ++reg) {
        const int R = R0 + 4 * fq + reg; const float rr = row_scale(E.ssq, R);
        float x[4];
#pragma unroll
        for (int j = 0; j < 4; ++j) x[j] = acc[j][reg] * rr;
        if (E.norm) { float ss = x[0] * x[0] + x[1] * x[1] + x[2] * x[2] + x[3] * x[3]; ss = red16(ss); const float rn = rsqrtf(ss * (1.0f / 64.0f) + EPS);
#pragma unroll
            for (int j = 0; j < 4; ++j) x[j] *= rn * E.gain[16 * j + fr]; }
        if (E.rope) { const int pos = row_pos(R);
#pragma unroll
            for (int j = 0; j < 2; ++j) { const float c = COS[pos * 32 + 16 * j + fr], s = SIN[pos * 32 + 16 * j + fr]; const float a = x[j], b = x[j + 2]; x[j] = a * c - b * s; x[j + 2] = a * s + b * c; } }
#pragma unroll
        for (int j = 0; j < 4; ++j) store_mapped(E.dst, E.ldd, R, E.col0 + 16 * j + fr, f2bf(x[j] * E.scale), E.kvmap);
    }
}
enum { SP_INA = 0, SP_RES_O = 1, SP_MLP1 = 2, SP_RES_M = 3, SP_QKVB = 4, SP_QB = 5 };
__device__ __forceinline__ int strips_of(int ph) { return ph == SP_INA ? 33 : ph == SP_RES_O ? 16 : ph == SP_MLP1 ? 64 : ph == SP_RES_M ? 16 : ph == SP_QKVB ? 49 : 16; }
__device__ __forceinline__ void perm_rows(int base, int pn, int wc, int* brow) { const int b0 = base + 256 * pn + 32 * wc; brow[0] = b0; brow[1] = b0 + 16; brow[2] = b0 + 128; brow[3] = b0 + 144; }

__device__ __forceinline__ void strip_job(const Ptrs& P, int ph, int l, int rg, int s, int lane, int ks = 1, int wave = 0, float* red = nullptr) {
    asm volatile("" : "+s"(rg), "+s"(s), "+v"(lane));
    const int R0 = rg * 16; const int fr = lane & 15, fq = lane >> 4;
    bf16* H = WSP(bf16, OFF_H); bf16* QO = WSP(bf16, OFF_QO); bf16* UM = WSP(bf16, OFF_UM);
    int brow[5];
    if (ph == SP_INA) {
        const bf16* Bt = WSP(bf16, OFF_WIN + l * SZ_WIN); const float* ssq = ssq_p(P, 2 * l);
        if (s < 32) {
            f32x4 acc[4]; HeadEpi E; E.ssq = ssq; E.kvmap = 0; E.norm = 1; E.rope = 1; E.scale = 1.f; E.gain = nullptr;
            if (s < 16) { perm_rows(0, s >> 2, s & 3, brow); E.dst = QO; E.ldd = D; E.col0 = 64 * s; E.gain = WSP(float, OFF_GT) + GT_AQG + l * 64; E.scale = C2; }
            else if (s < 20) { const int kh = s - 16; perm_rows(0, 4, kh, brow); E.dst = WSP(bf16, OFF_KA); E.ldd = 256; E.col0 = 64 * kh; E.gain = WSP(float, OFF_GT) + GT_AKG + l * 64; E.kvmap = 1; }
            else if (s < 24) { const int vh = s - 20; perm_rows(0, 5, vh, brow); E.dst = WSP(bf16, OFF_VA); E.ldd = 256; E.col0 = 64 * vh; E.norm = 0; E.rope = 0; E.kvmap = 1; }
            else { const int qh = s - 24; perm_rows(0, 6 + (qh >> 2), qh & 3, brow); E.dst = WSP(bf16, OFF_QI); E.ldd = 512; E.col0 = 64 * qh; E.norm = 0; }
            if (strip_mma<4>(H + (size_t)R0 * D, D, Bt, brow, D, acc, lane, ks, wave, red))
            epi_head(P, E, acc, R0, lane);
        } else {
            f32x4 acc[5];
#pragma unroll
            for (int j = 0; j < 5; ++j) brow[j] = 2048 + 16 * j;
            if (!strip_mma<5>(H + (size_t)R0 * D, D, Bt, brow, D, acc, lane, ks, wave, red)) return;
            const float* COS = WSP(float, OFF_ROPE); const float* SIN = COS + NPOS * 32; bf16* KI = WSP(bf16, OFF_KI); float* WI = WSP(float, OFF_WI);
#pragma unroll
            for (int reg = 0; reg < 4; ++reg) { const int R = R0 + 4 * fq + reg; const float rr = row_scale(ssq, R); const int pos = row_pos(R);
                float x[4];
#pragma unroll
                for (int j = 0; j < 4; ++j) x[j] = acc[j][reg] * rr;
#pragma unroll
                for (int j = 0; j < 2; ++j) { const float c = COS[pos * 32 + 16 * j + fr], sn = SIN[pos * 32 + 16 * j + fr]; const float a = x[j], b = x[j + 2]; x[j] = a * c - b * sn; x[j + 2] = a * sn + b * c; }
#pragma unroll
                for (int j = 0; j < 4; ++j) store_ki(KI, R, 16 * j + fr, f2bf(x[j]));
                if (fr < 8) WI[(size_t)R * 8 + fr] = acc[4][reg] * rr * 0.044194173824159216f; }
        }
    } else if (ph == SP_RES_O || ph == SP_RES_M) {
        const bool mlp = ph == SP_RES_M; const int K = mlp ? FF : D;
        const bf16* A = mlp ? UM + (size_t)(R0 - M) * FF : QO + (size_t)R0 * D; const bf16* Bt = mlp ? w2_t(P, l) : wo_t(P, l);
        float* ssqn = ssq_p(P, 2 * l + (mlp ? 2 : 1)); const bool last = mlp && l == 3; const float* ssqm = ssq_p(P, 2 * l + 1);
        f32x4 acc[4];
#pragma unroll
        for (int j = 0; j < 4; ++j) brow[j] = 64 * s + 16 * j;
        if (!strip_mma<4>(A, K, Bt, brow, K, acc, lane, ks, wave, red)) return;
#pragma unroll
        for (int reg = 0; reg < 4; ++reg) { const int R = R0 + 4 * fq + reg; float sq = 0.f; float r2 = 1.f; if (mlp) { const float rr = row_scale(ssqm, R); r2 = rr * rr; }
#pragma unroll
            for (int j = 0; j < 4; ++j) { const int col = 64 * s + 16 * j + fr; const float hv = bf2f(H[(size_t)R * D + col]) + acc[j][reg] * r2; H[(size_t)R * D + col] = (bf16)f2bf(hv); sq += hv * hv;
                if (last && R < M) P.out[(size_t)R * D + col] = hv; }
            sq = red16(sq); if (fr == 0) ssqn[(size_t)R * 16 + s] = sq; }
    } else if (ph == SP_MLP1) {
        f32x4 acc[4];
#pragma unroll
        for (int j = 0; j < 4; ++j) brow[j] = 64 * s + 16 * j;
        if (!strip_mma<4>(H + (size_t)R0 * D, D, w1_t(P, l), brow, D, acc, lane, ks, wave, red)) return;
#pragma unroll
        for (int reg = 0; reg < 4; ++reg) { const int R = R0 + 4 * fq + reg;
#pragma unroll
            for (int j = 0; j < 4; ++j) { const float v = fmaxf(acc[j][reg], 0.f); UM[(size_t)(R - M) * FF + 64 * s + 16 * j + fr] = (bf16)f2bf(v * v); } }
    } else {
        const int jb = l - 2; const float* ssq = ssq_p(P, 2 * l);
        if (s < 48) {
            f32x4 acc[4]; HeadEpi E; E.ssq = ssq; E.rope = 0; E.norm = 1; E.kvmap = 0; E.scale = 1.f; const bf16* Bt;
            if (s < 16) { Bt = WSP(bf16, jb == 0 ? OFF_WQ0 : OFF_WQ1); perm_rows(0, s >> 2, s & 3, brow); E.dst = QO; E.ldd = D; E.col0 = 64 * s; E.gain = WSP(float, OFF_GT) + GT_BQG + jb * 64; E.scale = C2; }
            else if (s < 32) { const int kh = s - 16; Bt = WSP(bf16, OFF_WKV); perm_rows(0, kh >> 2, kh & 3, brow); E.dst = WSP(bf16, OFF_KB); E.ldd = D; E.col0 = 64 * kh; E.gain = WSP(float, OFF_GT) + GT_KKG; E.kvmap = 1; }
            else { const int vh = s - 32; Bt = WSP(bf16, OFF_WKV); perm_rows(1024, vh >> 2, vh & 3, brow); E.dst = WSP(bf16, OFF_VB); E.ldd = D; E.col0 = 64 * vh; E.norm = 0; E.gain = nullptr; E.kvmap = 1; }
            if (strip_mma<4>(H + (size_t)R0 * D, D, Bt, brow, D, acc, lane, ks, wave, red))
            epi_head(P, E, acc, R0, lane);
        } else {
            f32x4 acc[1]; brow[0] = 2048;
            if (!strip_mma<1>(H + (size_t)R0 * D, D, WSP(bf16, OFF_WKV), brow, D, acc, lane, ks, wave, red)) return;
            float* LF = WSP(float, OFF_LF); const float bias = WSP(float, OFF_GT)[GT_KFB + fr];
#pragma unroll
            for (int reg = 0; reg < 4; ++reg) { const int R = R0 + 4 * fq + reg; const float z = acc[0][reg] * row_scale(ssq, R) + bias;
                LF[(size_t)R * 16 + fr] = fminf(z, 0.f) - log1pf(expf(-fabsf(z))); }
        }
    }
}
__device__ __forceinline__ unsigned okey(float f) { const unsigned u = __builtin_bit_cast(unsigned, f); return (u & 0x80000000u) ? ~u : (u | 0x80000000u); }
__device__ __forceinline__ unsigned half_sum(unsigned v) {
    v += __shfl_xor(v, 1); v += __shfl_xor(v, 2); v += __shfl_xor(v, 4); v += __shfl_xor(v, 8); v += __shfl_xor(v, 16); return v;
}
constexpr int NKT = 65;
constexpr int IDX_LDS_PER_WAVE = NKT * 64 * 4;
__device__ __forceinline__ float swap16_sum(float x) {
    auto s2 = __builtin_amdgcn_permlane16_swap(__float_as_uint(x), __float_as_uint(x), false, false);
    return __uint_as_float(s2[0]) + __uint_as_float(s2[1]);
}
template <int CTRL> __device__ __forceinline__ unsigned dppu(unsigned x) { return (unsigned)__builtin_amdgcn_mov_dpp((int)x, CTRL, 0xf, 0xf, true); }
__device__ __forceinline__ unsigned half_sum_dpp(unsigned v) {
    v += dppu<0xB1>(v); v += dppu<0x4E>(v); v += dppu<0x141>(v); v += dppu<0x128>(v);
    auto s2 = __builtin_amdgcn_permlane16_swap(v, v, false, false);
    return s2[0] + s2[1];
}
constexpr int TW_PITCH = 272, TW_BUF = 80 * TW_PITCH;
__device__ __forceinline__ void thin_wg_job(const Ptrs& P, int l, int bx, int tid, LAS unsigned char* lds) {
    asm volatile("" : "+v"(tid));
    const int lane = tid & 63, wave = __builtin_amdgcn_readfirstlane(tid >> 6), fr = lane & 15, fq = lane >> 4;
    const int R0 = (bx * 8 + wave) * 16;
    const bf16* H = WSP(bf16, OFF_H); const bf16* Wt = WSP(bf16, OFF_WIN + l * SZ_WIN) + (size_t)2048 * D; const float* ssq = ssq_p(P, 2 * l);
    const int p2 = tid + 1024; const bool has2 = p2 < 1280;
    const bf16* g0 = Wt + (size_t)(tid >> 4) * D + (tid & 15) * 8; const bf16* g1 = Wt + (size_t)((tid + 512) >> 4) * D + (tid & 15) * 8; const bf16* g2 = Wt + (size_t)((has2 ? p2 : tid) >> 4) * D + (tid & 15) * 8;
    const int l0 = (tid >> 4) * TW_PITCH + (tid & 15) * 16, l1 = ((tid + 512) >> 4) * TW_PITCH + (tid & 15) * 16, l2 = ((has2 ? p2 : tid) >> 4) * TW_PITCH + (tid & 15) * 16;
    const bf16* ap = H + (size_t)(R0 + fr) * D + 8 * fq;
    f32x4 acc[5];
#pragma unroll
    for (int j = 0; j < 5; ++j) acc[j] = (f32x4){0.f, 0.f, 0.f, 0.f};
    u32x4 w0 = *(const u32x4*)g0, w1 = *(const u32x4*)g1, w2 = *(const u32x4*)g2;
    bf16x8 a[4];
#pragma unroll
    for (int h = 0; h < 4; ++h) a[h] = *(const bf16x8*)(ap + 32 * h);
    *(LAS u32x4*)(lds + l0) = w0; *(LAS u32x4*)(lds + l1) = w1; if (has2) *(LAS u32x4*)(lds + l2) = w2;
    __syncthreads();
#pragma unroll 1
    for (int c = 0; c < 8; ++c) {
        const int cn = c < 7 ? c + 1 : 7;
        w0 = *(const u32x4*)(g0 + 128 * cn); w1 = *(const u32x4*)(g1 + 128 * cn); w2 = *(const u32x4*)(g2 + 128 * cn);
        bf16x8 an[4];
#pragma unroll
        for (int h = 0; h < 4; ++h) an[h] = *(const bf16x8*)(ap + 128 * cn + 32 * h);
        const LAS unsigned char* bb = lds + (c & 1) * TW_BUF + fr * TW_PITCH + fq * 16;
#pragma unroll
        for (int h = 0; h < 4; ++h)
#pragma unroll
            for (int j = 0; j < 5; ++j) acc[j] = __builtin_amdgcn_mfma_f32_16x16x32_bf16(a[h], *(const LAS bf16x8*)(bb + j * 16 * TW_PITCH + h * 64), acc[j], 0, 0, 0);
        if (c < 7) { LAS unsigned char* nb = lds + ((c + 1) & 1) * TW_BUF; *(LAS u32x4*)(nb + l0) = w0; *(LAS u32x4*)(nb + l1) = w1; if (has2) *(LAS u32x4*)(nb + l2) = w2; }
#pragma unroll
        for (int h = 0; h < 4; ++h) a[h] = an[h];
        __syncthreads();
    }
    const float* COS = WSP(float, OFF_ROPE); const float* SIN = COS + NPOS * 32; bf16* KI = WSP(bf16, OFF_KI); float* WI = WSP(float, OFF_WI);
#pragma unroll
    for (int reg = 0; reg < 4; ++reg) { const int R = R0 + 4 * fq + reg; const float rr = row_scale(ssq, R); const int pos = row_pos(R);
        float x[4];
#pragma unroll
        for (int j = 0; j < 4; ++j) x[j] = acc[j][reg] * rr;
#pragma unroll
        for (int j = 0; j < 2; ++j) { const float cc = COS[pos * 32 + 16 * j + fr], sn = SIN[pos * 32 + 16 * j + fr]; const float xa = x[j], xb = x[j + 2]; x[j] = xa * cc - xb * sn; x[j + 2] = xa * sn + xb * cc; }
#pragma unroll
        for (int j = 0; j < 4; ++j) store_ki(KI, R, 16 * j + fr, f2bf(x[j]));
        if (fr < 8) WI[(size_t)R * 8 + fr] = acc[4][reg] * rr * 0.044194173824159216f; }
}
__device__ __forceinline__ void count4_ge(unsigned& cnt, unsigned a, unsigned b, unsigned c4, unsigned d, unsigned c) {
    asm volatile("v_cmp_ge_u32_e64 s[20:21], %1, %5\n\tv_cmp_ge_u32_e64 s[22:23], %2, %5\n\tv_cmp_ge_u32_e64 s[24:25], %3, %5\n\tv_cmp_ge_u32_e64 s[26:27], %4, %5\n\t"
                 "v_addc_co_u32_e64 %0, s[20:21], %0, 0, s[20:21]\n\tv_addc_co_u32_e64 %0, s[22:23], %0, 0, s[22:23]\n\tv_addc_co_u32_e64 %0, s[24:25], %0, 0, s[24:25]\n\tv_addc_co_u32_e64 %0, s[26:27], %0, 0, s[26:27]"
                 : "+v"(cnt) : "v"(a), "v"(b), "v"(c4), "v"(d), "v"(c) : "s20", "s21", "s22", "s23", "s24", "s25", "s26", "s27");
}
__device__ __forceinline__ void indexer_pass(const Ptrs& P, int b, int g2, int lane, LAS unsigned* stg  , int dry = 0  ) {
    const bf16* QI = WSP(bf16, OFF_QI); const bf16* KI = WSP(bf16, OFF_KI) + (size_t)b * KROWS * 64; const float* WI = WSP(float, OFF_WI);
    unsigned* MASK = WSP(unsigned, OFF_MASK);
    const int i0 = 2 * g2, n = lane & 31, gg = lane >> 5, fr = lane & 15, fq = lane >> 4;
    const size_t row0 = (size_t)b * S + i0;
    const int ntile = 2 + ((i0 + 1) >> 5);
    const unsigned lt = (1u << n) - 1u;
    const __amdgpu_buffer_rsrc_t krs = __builtin_amdgcn_make_buffer_rsrc((void*)KI, 0, KROWS * 128, 0x00020000);
    const int iq = i0 + gg;
    bf16x8 af[2];
    { const bf16* qp = QI + (row0 + (fr >> 3)) * 512 + (fr & 7) * 64 + 8 * fq;
      af[0] = *(const bf16x8*)(qp); af[1] = *(const bf16x8*)(qp + 32); }
    const f32x4 w4 = *(const f32x4*)(WI + (row0 + (fq >> 1)) * 8 + 4 * (fq & 1));
    const unsigned loff = (unsigned)(16 * lane);
    bf16x8 b0[2][2], b1[2][2], b2[2][2], b3[2][2];
#define IDX_TBASE(t_) (((t_) == 0 ? 0 : PRE + 32 * ((t_) - 1)) * 128)
#define IDX_LOADB(dst, t_) do { const int tt_ = (t_) < ntile ? (t_) : ntile - 1; const int bo_ = IDX_TBASE(tt_); _Pragma("unroll") for (int u_ = 0; u_ < 2; ++u_) _Pragma("unroll") for (int ks_ = 0; ks_ < 2; ++ks_) \
        dst[u_][ks_] = __builtin_bit_cast(bf16x8, __builtin_amdgcn_raw_buffer_load_b128(krs, loff + 2048 * u_ + 1024 * ks_, bo_, 0)); } while (0)
#define IDX_TILE(bb, t_) do { float pu_[2]; \
        _Pragma("unroll") for (int u_ = 0; u_ < 2; ++u_) { f32x4 acc_ = {0.f, 0.f, 0.f, 0.f}; \
            acc_ = __builtin_amdgcn_mfma_f32_16x16x32_bf16(af[0], bb[u_][0], acc_, 0, 0, 0); acc_ = __builtin_amdgcn_mfma_f32_16x16x32_bf16(af[1], bb[u_][1], acc_, 0, 0, 0); \
            float x_ = w4[0] * __builtin_amdgcn_fmed3f(acc_[0], 0.f, 3.0e38f); x_ += w4[1] * __builtin_amdgcn_fmed3f(acc_[1], 0.f, 3.0e38f); \
            x_ += w4[2] * __builtin_amdgcn_fmed3f(acc_[2], 0.f, 3.0e38f); x_ += w4[3] * __builtin_amdgcn_fmed3f(acc_[3], 0.f, 3.0e38f); pu_[u_] = swap16_sum(x_); } \
        const float sc_ = (fq & 1) ? pu_[1] : pu_[0]; \
        const bool v_ = (t_) == 0 ? (n < NMETA) : ((32 * ((t_) - 1) + n) <= iq); \
        stg[(t_) * 64 + lane] = v_ ? okey(sc_) : 0x007FFFFFu; } while (0)
    IDX_LOADB(b0, 0); IDX_LOADB(b1, 1); IDX_LOADB(b2, 2); IDX_LOADB(b3, 3);
#pragma unroll 1
    for (int t = 0; t < ntile; t += 4) {
        const int t1 = t + 1 < ntile ? t + 1 : ntile - 1, t2 = t + 2 < ntile ? t + 2 : ntile - 1, t3 = t + 3 < ntile ? t + 3 : ntile - 1;
        IDX_TILE(b0, t); IDX_LOADB(b0, t + 4);
        IDX_TILE(b1, t1); IDX_LOADB(b1, t + 5);
        IDX_TILE(b2, t2); IDX_LOADB(b2, t + 6);
        IDX_TILE(b3, t3); IDX_LOADB(b3, t + 7);
    }
#undef IDX_LOADB
#undef IDX_TILE
#undef IDX_TBASE
    if (dry) return;
#pragma unroll 1
    for (int t = ntile; t < NKT; ++t) stg[t * 64 + lane] = 0x007FFFFFu;
    unsigned k[NKT];
#pragma unroll
    for (int T = 0; T < NKT; ++T) k[T] = stg[T * 64 + lane];
    unsigned thr = 0u; bool done = (NMETA + iq + 1) <= TOPK;
    if (done) thr = 0x00800000u;
#pragma unroll 1
    for (int bit = 31; bit >= 0; --bit) {
        if (__all(done)) break;
        const unsigned c = thr | (1u << bit);
        unsigned cnt = (k[NKT - 1] >= c) ? 1u : 0u;
#pragma unroll
        for (int T = 0; T + 3 < NKT; T += 4) count4_ge(cnt, k[T], k[T + 1], k[T + 2], k[T + 3], c);
        cnt = half_sum_dpp(cnt);
        if (!done && cnt >= (unsigned)TOPK) { thr = c; if (cnt == (unsigned)TOPK) done = true; }
    }
    const bool slow = !__all(done);
    unsigned* mp = MASK + row0 * NWORDS;
    unsigned m0 = 0u, m1 = 0u, m2 = 0u, m3 = 0u;
#define IDX_PUT(bs_, widx_) do { const unsigned lo_ = (unsigned)(bs_), hi_ = (unsigned)((bs_) >> 32);   \
        if ((widx_) < 64) asm volatile("s_nop 1\n\tv_writelane_b32 %0, %2, %4\n\tv_writelane_b32 %1, %3, %4" : "+v"(m0), "+v"(m2) : "s"(lo_), "s"(hi_), "n"((widx_) & 63)); \
        else asm volatile("s_nop 1\n\tv_writelane_b32 %0, %2, %4\n\tv_writelane_b32 %1, %3, %4" : "+v"(m1), "+v"(m3) : "s"(lo_), "s"(hi_), "n"((widx_) & 63)); } while (0)
    if (!slow) {
#pragma unroll
        for (int T = 0; T < NKT; ++T) { const unsigned long long bs = __ballot(k[T] >= thr); IDX_PUT(bs, T == 0 ? 0 : T + 1); }
    } else {
        unsigned gcnt = 0;
#pragma unroll
        for (int T = 0; T < NKT; ++T) gcnt += (k[T] > thr) ? 1u : 0u;
        gcnt = half_sum_dpp(gcnt);
        const unsigned need = done ? 0x7fffffffu : (unsigned)TOPK - gcnt;
        unsigned base = 0;
#pragma unroll
        for (int T = 0; T < NKT; ++T) {
            const bool eq = k[T] == thr;
            const unsigned long long be = __ballot(eq);
            const unsigned hh = gg ? (unsigned)(be >> 32) : (unsigned)be;
            const bool sel = (k[T] > thr) || (eq && (base + (unsigned)__builtin_popcount(hh & lt)) < need);
            base += (unsigned)__builtin_popcount(hh);
            const unsigned long long bs = __ballot(sel); IDX_PUT(bs, T == 0 ? 0 : T + 1);
            __builtin_amdgcn_sched_barrier(0);
        }
    }
#undef IDX_PUT
    mp[lane] = m0; mp[NWORDS + lane] = m2;
    if (lane < NWORDS - 64) { mp[64 + lane] = m1; mp[NWORDS + 64 + lane] = m3; }
}

template <int MODE>
__device__ __forceinline__ void attn_naive_work(const Ptrs& P, int gw, int ngw, float* sc, int lane, int row_lo, int row_hi) {
    bf16* QO = WSP(bf16, OFF_QO);
    for (int job = gw; job < (row_hi - row_lo) * 16; job += ngw) {
        const int R = row_lo + (job >> 4), h = job & 15;
        const bool meta = R >= M; const int b = meta ? 0 : R >> 11, i = R & (S - 1);
        const int kmax = meta ? (R - M) : PRE + i;
        const bf16* Kb; const bf16* Vb; int ldk;
        if (MODE == 0) { Kb = WSP(bf16, OFF_KA) + (size_t)b * KROWS * 256 + 64 * (h >> 2); Vb = WSP(bf16, OFF_VA) + (size_t)b * KROWS * 256 + 64 * (h >> 2); ldk = 256; }
        else { Kb = WSP(bf16, OFF_KB) + (size_t)b * KROWS * D + 64 * h; Vb = WSP(bf16, OFF_VB) + (size_t)b * KROWS * D + 64 * h; ldk = D; }
        const unsigned* mrow = WSP(unsigned, OFF_MASK) + (size_t)(meta ? 0 : R) * NWORDS;
        const float* nb = WSP(float, OFF_NB) + ((size_t)b * 16 + h) * KROWS;
        float q[64];
        { const bf16* qp = QO + (size_t)R * D + 64 * h;
#pragma unroll
          for (int c = 0; c < 8; ++c) { const u32x4 v = *(const u32x4*)(qp + 8 * c);
              q[8 * c + 0] = bf2f(v.x & 0xffffu); q[8 * c + 1] = bf2f(v.x >> 16); q[8 * c + 2] = bf2f(v.y & 0xffffu); q[8 * c + 3] = bf2f(v.y >> 16);
              q[8 * c + 4] = bf2f(v.z & 0xffffu); q[8 * c + 5] = bf2f(v.z >> 16); q[8 * c + 6] = bf2f(v.w & 0xffffu); q[8 * c + 7] = bf2f(v.w >> 16); } }
        float mx = -INFINITY;
        for (int kr = lane; kr <= kmax; kr += 64) {
            bool sel;
            if (MODE == 0) sel = meta ? true : ((mrow[kr >> 5] >> (kr & 31)) & 1u) != 0u;
            else sel = (kr < NMETA) || (kr >= PRE);
            float s = -INFINITY;
            if (sel) { const bf16* kp = Kb + (size_t)kr * ldk; float a = 0.f;
#pragma unroll
                for (int c = 0; c < 8; ++c) { const u32x4 v = *(const u32x4*)(kp + 8 * c);
                    a += q[8 * c + 0] * bf2f(v.x & 0xffffu) + q[8 * c + 1] * bf2f(v.x >> 16) + q[8 * c + 2] * bf2f(v.y & 0xffffu) + q[8 * c + 3] * bf2f(v.y >> 16)
                       + q[8 * c + 4] * bf2f(v.z & 0xffffu) + q[8 * c + 5] * bf2f(v.z >> 16) + q[8 * c + 6] * bf2f(v.w & 0xffffu) + q[8 * c + 7] * bf2f(v.w >> 16); }
                s = a; if (MODE == 1) s += nb[kr]; }
            sc[kr] = s; mx = fmaxf(mx, s);
        }
        mx = wave_max(mx);
        float ls = 0.f;
        for (int kr = lane; kr <= kmax; kr += 64) { const float p = exp2f(sc[kr] - mx); sc[kr] = p; ls += p; }
        ls = wave_sum(ls);
        __builtin_amdgcn_s_waitcnt(0xc07f); asm volatile("" ::: "memory");
        float o = 0.f;
        for (int kr = 0; kr <= kmax; ++kr) { const float p = sc[kr]; if (p != 0.f) o += p * bf2f(Vb[(size_t)kr * ldk + lane]); }
        QO[(size_t)R * D + 64 * h + lane] = (bf16)f2bf(o / ls);
        __builtin_amdgcn_s_waitcnt(0xc07f); asm volatile("" ::: "memory");
    }
}

__device__ __forceinline__ void scan_work(const Ptrs& P, int bh, float* part  , int t) {
    const int b = bh >> 4, h = bh & 15; const bool act = t < 256;
    const float* LF = WSP(float, OFF_LF); float* NBp = WSP(float, OFF_NB) + ((size_t)b * 16 + h) * KROWS;
    float cm = 0.f;
    for (int j = 0; j < NMETA; ++j) { cm += LF[(size_t)(M + j) * 16 + h]; if (t == 0) NBp[j] = -cm * LOG2E; }
    if (t >= NMETA && t < PRE) NBp[t] = -INFINITY;
    float v[8]; float run = 0.f;
    if (act) {
#pragma unroll
        for (int e = 0; e < 8; ++e) { run += LF[((size_t)b * S + 8 * t + e) * 16 + h]; v[e] = run; }
        part[t] = run; }
    __syncthreads();
    for (int o = 1; o < 256; o <<= 1) { float x = 0.f; if (act && t >= o) x = part[t - o]; __syncthreads(); if (act) part[t] += x; __syncthreads(); }
    if (act) { const float off = cm + (t ? part[t - 1] : 0.f);
#pragma unroll
        for (int e = 0; e < 8; ++e) NBp[PRE + 8 * t + e] = -(off + v[e]) * LOG2E; }
    bf16* KB = WSP(bf16, OFF_KB); bf16* VB = WSP(bf16, OFF_VB);
    for (int e = t; e < 48 * 8; e += 512) { const int r = 16 + e / 8, c = e % 8; const u32x4 z = {0u, 0u, 0u, 0u};
        *(u32x4*)(KB + ((size_t)b * KROWS + r) * D + 64 * h + 8 * c) = z; *(u32x4*)(VB + ((size_t)b * KROWS + r) * D + 64 * h + 8 * c) = z; }
    __syncthreads();
}


namespace pg8 {
#define PG8_LAS __attribute__((address_space(3)))
typedef unsigned short bf16_t;
typedef short bf16x8 __attribute__((ext_vector_type(8)));
typedef float f32x4 __attribute__((ext_vector_type(4)));
typedef unsigned u32x4 __attribute__((ext_vector_type(4)));
constexpr int BM = 256, BK = 64, HALF = 128, HTB = HALF * BK * 2  , STAGE_BYTES = 8 * HTB, NXCD = 8, WGM = 4;

__host__ __device__ __forceinline__ int lds_byte(int r, int c) { const int st = (r >> 4) * 2 + (c >> 5), rr = r & 15, cc = c & 31, ob = rr * 64 + cc * 2; return st * 1024 + (ob ^ (((ob >> 9) & 1) << 5)); }
__host__ __device__ __forceinline__ void stage_rc(int b, int& R, int& C) { const int st = b / 1024, sb = b % 1024, swz = sb ^ (((sb >> 9) & 1) << 5); R = (st >> 1) * 16 + swz / 64; C = (st & 1) * 32 + (swz % 64) / 2; }
__host__ __device__ __forceinline__ int perm32(int rho) { const int n = rho >> 4, i = rho & 15; return 8 * (i >> 2) + 4 * n + (i & 3); }

struct Unit { int pm, pn; };
struct Gemm { const bf16_t* A; const bf16_t* Bt; int M, N, K; };

struct StaticOrder {
    int nM, nN, nwg, G, c;
    __host__ __device__ void init(int M, int N, int G_, int c_) { nM = M / BM; nN = N / BM; nwg = nM * nN; G = G_; c = c_; }
    __host__ __device__ bool next(int i, Unit& u) const {
        const long L = (long)i * G + c; if (L >= nwg) return false;
        int wgid = (int)L; { const int q = nwg / NXCD, r = nwg % NXCD, xcd = wgid % NXCD, off = wgid / NXCD; wgid = (xcd < r ? xcd * (q + 1) : r * (q + 1) + (xcd - r) * q) + off; }
        const int nig = WGM * nN, gid = wgid / nig, fm = gid * WGM, gsz = (nM - fm) < WGM ? (nM - fm) : WGM;
        u.pm = fm + ((wgid % nig) % gsz); u.pn = (wgid % nig) / gsz; return true;
    }
    __device__ __forceinline__ void a_ready(const Unit&) const {}
    __device__ __forceinline__ void done(const Unit&) const {}
};

__device__ __forceinline__ unsigned cvt_pk_bf16(float lo, float hi) { unsigned r; asm volatile("v_cvt_pk_bf16_f32 %0, %1, %2" : "=v"(r) : "v"(lo), "v"(hi)); return r; }
typedef float f32x2 __attribute__((ext_vector_type(2)));
typedef int i32x4 __attribute__((ext_vector_type(4)));
template <class Epi, class Sched, bool ALIGN_EPI = false, bool SP2 = false, int QM = 0, bool ABLK = false>
__device__ __forceinline__ void gemm_phase(PG8_LAS unsigned char* lds, const Gemm g, const Sched& S, const Epi& E) {
    int tid = threadIdx.x; asm volatile("" : "+v"(tid));
    const int wid = __builtin_amdgcn_readfirstlane(tid >> 6), lane = tid & 63, wr = wid >> 2, wc = wid & 3, fr = lane & 15, fq = lane >> 4;
    constexpr bool F8 = QM == 1, I8 = QM == 2;
    const int K = g.K, nt = K / BK;
    unsigned voffA[2], voffB[2];
#pragma unroll
    for (int i = 0; i < 2; ++i) { int R, C; stage_rc(tid * 16 + i * 8192, R, C); const int Rb = Epi::PERM ? ((R & ~31) + perm32(R & 31)) : R;
        voffA[i] = ABLK ? (unsigned)(((R >> 4) * (K * 2 / 32) + (C * 2 >> 5)) * 512 + (R & 15) * 32 + (C * 2 & 31)) : (unsigned)(R * K + C) * 2u; voffB[i] = (unsigned)(Rb * K + C) * 2u; }
    const size_t kstepA = ABLK ? (size_t)2048 : (size_t)(BK * 2);
    const size_t kstep = (size_t)(BK * 2);
    const size_t hstep = (size_t)HALF * K * 2;
    const size_t tstep = 2 * hstep;
    const unsigned ldsw = (unsigned)wid * 1024u;
    const int aoff = lds_byte(wr * 64 + fr, fq * 8), boff = lds_byte(wc * 32 + fr, fq * 8);
#define PG8_SA(b, h) (((b) * 2 + (h)) * HTB)
#define PG8_SB(b, h) ((4 + (b) * 2 + (h)) * HTB)
#define PG8_STAGE(bufoff, gbase, voff) do { _Pragma("unroll") for (int _i = 0; _i < 2; ++_i) \
        __builtin_amdgcn_global_load_lds((const unsigned*)((const char*)(gbase) + (voff)[_i]), (PG8_LAS unsigned*)(lds + (bufoff) + ldsw + _i * 8192), 16, 0, 0); } while (0)
#define PG8_LDA(dst, b, h) do { _Pragma("unroll") for (int m = 0; m < 4; ++m) _Pragma("unroll") for (int k = 0; k < 2; ++k) dst[m][k] = *(const PG8_LAS bf16x8*)(lds + PG8_SA(b, h) + aoff + m * 2048 + k * 1024); } while (0)
#define PG8_LDB(dst, b, h) do { _Pragma("unroll") for (int n = 0; n < 2; ++n) _Pragma("unroll") for (int k = 0; k < 2; ++k) dst[n][k] = *(const PG8_LAS bf16x8*)(lds + PG8_SB(b, h) + boff + n * 2048 + k * 1024); } while (0)
#define PG8_CAT8(x) __builtin_shufflevector(__builtin_bit_cast(i32x4, (x)[0]), __builtin_bit_cast(i32x4, (x)[1]), 0, 1, 2, 3, 4, 5, 6, 7)
#define PG8_MMA(ai, bj, At, Bt) do { __builtin_amdgcn_s_setprio(1); _Pragma("unroll") for (int m = 0; m < 4; ++m) _Pragma("unroll") for (int n = 0; n < 2; ++n) { \
        if constexpr (F8) asm volatile("v_mfma_f32_16x16x128_f8f6f4 %0, %1, %2, %0" : "+v"(acc[ai][bj][m][n]) : "v"(PG8_CAT8(Bt[n])), "v"(PG8_CAT8(At[m])));   \
        else if constexpr (I8) { _Pragma("unroll") for (int k = 0; k < 2; ++k) acc[ai][bj][m][n] = __builtin_bit_cast(f32x4, __builtin_amdgcn_mfma_i32_16x16x64_i8(__builtin_bit_cast(i32x4, Bt[n][k]), __builtin_bit_cast(i32x4, At[m][k]), __builtin_bit_cast(i32x4, acc[ai][bj][m][n]), 0, 0, 0)); } \
        else { _Pragma("unroll") for (int k = 0; k < 2; ++k) acc[ai][bj][m][n] = __builtin_amdgcn_mfma_f32_16x16x32_bf16(Bt[n][k], At[m][k], acc[ai][bj][m][n], 0, 0, 0); } } __builtin_amdgcn_s_setprio(0); } while (0)
#define PG8_WAIT_V(n) asm volatile("s_waitcnt vmcnt(" #n ")" ::: "memory")
#define PG8_WAIT_L(n) asm volatile("s_waitcnt lgkmcnt(" #n ")" ::: "memory")
#define PG8_BAR __builtin_amdgcn_s_barrier()
#define PG8_SCHED __builtin_amdgcn_sched_barrier(0)
    Unit cur, nxt; int ui = 0;
    if (!S.next(0, cur)) return;
    f32x4 acc[2][2][4][2];
    float zf = 0.f; asm volatile("" : "+v"(zf));
#pragma unroll
    for (int a = 0; a < 2; ++a)
#pragma unroll
        for (int b = 0; b < 2; ++b)
#pragma unroll
            for (int m = 0; m < 4; ++m)
#pragma unroll
                for (int n = 0; n < 2; ++n) acc[a][b][m][n] = (f32x4){zf, zf, zf, zf};
    bf16x8 At[4][2], B0[2][2], B1[2][2];
    const char* cA = (const char*)g.A + (size_t)cur.pm * tstep; const char* cB = (const char*)g.Bt + (size_t)cur.pn * tstep;
    S.a_ready(cur);
    if constexpr (SP2) {
        PG8_STAGE(PG8_SB(0, 0), cB, voffB); PG8_STAGE(PG8_SB(0, 1), cB + hstep, voffB); PG8_STAGE(PG8_SA(0, 0), cA, voffA); PG8_STAGE(PG8_SA(0, 1), cA + hstep, voffA);
        if (wr == 1) PG8_BAR;
        PG8_WAIT_V(2); PG8_BAR;
        PG8_STAGE(PG8_SB(1, 0), cB + kstep, voffB); PG8_STAGE(PG8_SA(1, 0), cA + kstepA, voffA); PG8_STAGE(PG8_SB(1, 1), cB + hstep + kstep, voffB);
        PG8_WAIT_V(6); PG8_BAR;
    } else {
        PG8_STAGE(PG8_SB(0, 0), cB, voffB); PG8_STAGE(PG8_SA(0, 0), cA, voffA); PG8_STAGE(PG8_SB(0, 1), cB + hstep, voffB); PG8_STAGE(PG8_SA(0, 1), cA + hstep, voffA);
        if (wr == 1) PG8_BAR;
        PG8_WAIT_V(4); PG8_BAR;
        PG8_STAGE(PG8_SB(1, 0), cB + kstep, voffB); PG8_STAGE(PG8_SA(1, 0), cA + kstepA, voffA); PG8_STAGE(PG8_SB(1, 1), cB + hstep + kstep, voffB);
        PG8_WAIT_V(6); PG8_BAR;
    }
    for (;;) {
        const bool has_next = S.next(ui + 1, nxt);
        const char* nA = has_next ? (const char*)g.A + (size_t)nxt.pm * tstep : cA; const char* nB = has_next ? (const char*)g.Bt + (size_t)nxt.pn * tstep : cB;
        for (int t = 0; t < nt; t += 2) {
            const bool last = (t == nt - 2);
            const char* a1 = cA + (size_t)(t + 1) * kstepA;
            const char* a2 = last ? nA : cA + (size_t)(t + 2) * kstepA; const char* b2 = last ? nB : cB + (size_t)(t + 2) * kstep;
            const char* a3 = a2 + kstepA; const char* b3 = b2 + kstep;
            if (last && has_next) S.a_ready(nxt);
            if constexpr (SP2) {
            PG8_LDB(B0, 0, 0); PG8_LDB(B1, 0, 1); PG8_SCHED; PG8_LDA(At, 0, 0); PG8_STAGE(PG8_SA(1, 1), a1 + hstep, voffA);
            PG8_WAIT_V(8); PG8_WAIT_L(0); PG8_BAR; PG8_MMA(0, 0, At, B0); PG8_MMA(0, 1, At, B1); PG8_BAR; PG8_SCHED;
            PG8_LDA(At, 0, 1); PG8_STAGE(PG8_SB(0, 0), b2, voffB); PG8_STAGE(PG8_SB(0, 1), b2 + hstep, voffB); PG8_STAGE(PG8_SA(0, 0), a2, voffA);
            PG8_WAIT_V(8); PG8_WAIT_L(0); PG8_BAR; PG8_MMA(1, 0, At, B0); PG8_MMA(1, 1, At, B1); PG8_BAR; PG8_SCHED;
            PG8_LDB(B0, 1, 0); PG8_LDB(B1, 1, 1); PG8_SCHED; PG8_LDA(At, 1, 0); PG8_STAGE(PG8_SA(0, 1), a2 + hstep, voffA);
            PG8_WAIT_V(8); PG8_WAIT_L(0); PG8_BAR; PG8_MMA(0, 0, At, B0); PG8_MMA(0, 1, At, B1); PG8_BAR; PG8_SCHED;
            PG8_LDA(At, 1, 1); PG8_STAGE(PG8_SB(1, 0), b3, voffB); PG8_STAGE(PG8_SB(1, 1), b3 + hstep, voffB); PG8_STAGE(PG8_SA(1, 0), a3, voffA);
            PG8_WAIT_V(8); PG8_WAIT_L(0); PG8_BAR; PG8_MMA(1, 0, At, B0); PG8_MMA(1, 1, At, B1); PG8_BAR; PG8_SCHED;
            } else {
            PG8_LDB(B0, 0, 0); PG8_SCHED; PG8_LDA(At, 0, 0); PG8_STAGE(PG8_SA(1, 1), a1 + hstep, voffA);
            PG8_WAIT_L(8); PG8_BAR; PG8_WAIT_L(0); PG8_MMA(0, 0, At, B0); PG8_BAR; PG8_SCHED;
            PG8_LDB(B1, 0, 1); PG8_STAGE(PG8_SB(0, 0), b2, voffB);
            PG8_BAR; PG8_WAIT_L(0); PG8_MMA(0, 1, At, B1); PG8_BAR;
            PG8_LDA(At, 0, 1); PG8_STAGE(PG8_SA(0, 0), a2, voffA);
            PG8_BAR; PG8_WAIT_L(0); PG8_MMA(1, 0, At, B0); PG8_BAR; PG8_SCHED;
            PG8_STAGE(PG8_SB(0, 1), b2 + hstep, voffB);
            PG8_WAIT_V(6); PG8_BAR; PG8_MMA(1, 1, At, B1); PG8_BAR;
            PG8_LDB(B0, 1, 0); PG8_SCHED; PG8_LDA(At, 1, 0); PG8_STAGE(PG8_SA(0, 1), a2 + hstep, voffA);
            PG8_WAIT_L(8); PG8_BAR; PG8_WAIT_L(0); PG8_MMA(0, 0, At, B0); PG8_BAR; PG8_SCHED;
            PG8_LDB(B1, 1, 1); PG8_STAGE(PG8_SB(1, 0), b3, voffB);
            PG8_BAR; PG8_WAIT_L(0); PG8_MMA(0, 1, At, B1); PG8_BAR;
            PG8_LDA(At, 1, 1); PG8_STAGE(PG8_SA(1, 0), a3, voffA);
            PG8_BAR; PG8_WAIT_L(0); PG8_MMA(1, 0, At, B0); PG8_BAR; PG8_SCHED;
            PG8_STAGE(PG8_SB(1, 1), b3 + hstep, voffB);
            PG8_WAIT_V(6); PG8_BAR; PG8_MMA(1, 1, At, B1); PG8_BAR;
            }
        }
        if constexpr (ALIGN_EPI) { if (wr == 0) PG8_BAR; }
        if constexpr (F8) asm volatile("s_nop 15\n\ts_nop 7" ::: "memory");
        if constexpr (!Epi::AFTER_DRAIN) { E(acc, cur, wr, wc, fr, fq); S.done(cur); }
        if (!has_next) break;
#pragma unroll
        for (int a = 0; a < 2; ++a)
#pragma unroll
            for (int b = 0; b < 2; ++b)
#pragma unroll
                for (int m = 0; m < 4; ++m)
#pragma unroll
                    for (int n = 0; n < 2; ++n) acc[a][b][m][n] = (f32x4){0.f, 0.f, 0.f, 0.f};
        cur = nxt; cA = nA; cB = nB; ++ui;
        if constexpr (ALIGN_EPI) { if (wr == 1) PG8_BAR; }
    }
    PG8_WAIT_V(0);
    if constexpr (!ALIGN_EPI) { if (wr == 0) PG8_BAR; }
    PG8_BAR;
    if constexpr (Epi::AFTER_DRAIN) { E.fused(acc, cur, wr, wc, fr, fq, lds, wid, lane); S.done(cur); }
#undef PG8_SA
#undef PG8_SB
#undef PG8_STAGE
#undef PG8_LDA
#undef PG8_LDB
#undef PG8_MMA
#undef PG8_WAIT_V
#undef PG8_WAIT_L
#undef PG8_BAR
#undef PG8_SCHED
}
}

__device__ __forceinline__ u32x4 pack8(const f32x4& a, const f32x4& b) { u32x4 w; w.x = pg8::cvt_pk_bf16(a[0], a[1]); w.y = pg8::cvt_pk_bf16(a[2], a[3]); w.z = pg8::cvt_pk_bf16(b[0], b[1]); w.w = pg8::cvt_pk_bf16(b[2], b[3]); return w; }
__device__ __forceinline__ float hsum4(const f32x4& a) { return (a[0] + a[1]) + (a[2] + a[3]); }

__device__ __forceinline__ f32x4 i2f4(const f32x4& v) { f32x4 r; r[0] = (float)__float_as_int(v[0]); r[1] = (float)__float_as_int(v[1]); r[2] = (float)__float_as_int(v[2]); r[3] = (float)__float_as_int(v[3]); return r; }
struct HeadTile { bf16* dst; int ldd, col0, mode; const float* gain; float scale; int lc; };
template <bool I8>
__device__ __forceinline__ void epi_heads(const Ptrs& P, const HeadTile& T, const float* ssq, const f32x4 (&acc)[2][2][4][2], const pg8::Unit& u, int wr, int wc, int fr, int fq) {
    const float* COS = WSP(float, OFF_ROPE); const float* SIN = COS + NPOS * 32;
    f32x4 g[2][2];
#pragma unroll
    for (int bj = 0; bj < 2; ++bj)
#pragma unroll
        for (int n = 0; n < 2; ++n) g[bj][n] = (T.mode & 1) ? *(const f32x4*)(T.gain + 32 * bj + 8 * fq + 4 * n) : (f32x4){1.f, 1.f, 1.f, 1.f};
    extern __shared__ __attribute__((aligned(16))) unsigned char dyn_lds_epi[];
    float* rs = (float*)(dyn_lds_epi + EPI_RS_OFF) + (wr * 4 + wc) * 128;
    { const int lane = fq * 16 + fr;
#pragma unroll
      for (int h = 0; h < 2; ++h) { const int j = lane + 64 * h, Rj = u.pm * 256 + (j >> 6) * 128 + wr * 64 + (j & 63); rs[j] = I8 ? row_scale(ssq, Rj) / (in_qscale(P, T.lc, Rj) * (QA * QW1)) : row_scale(ssq, Rj); } }
    f32x4 cN[2], sN[2];
    { const int pos0 = ((u.pm * 256 + wr * 64 + fr) & (S - 1)) + NMETA;
#pragma unroll
      for (int n = 0; n < 2; ++n) { cN[n] = *(const f32x4*)(COS + pos0 * 32 + 8 * fq + 4 * n); sN[n] = *(const f32x4*)(SIN + pos0 * 32 + 8 * fq + 4 * n); } }
#pragma unroll
    for (int ai = 0; ai < 2; ++ai)
#pragma unroll
        for (int m = 0; m < 4; ++m) {
            const int R = u.pm * 256 + ai * 128 + wr * 64 + m * 16 + fr;
            const float rr = rs[ai * 64 + m * 16 + fr];
            const f32x4 cC[2] = {cN[0], cN[1]}, sC[2] = {sN[0], sN[1]};
            if (ai * 4 + m < 7) { const int in = ai * 4 + m + 1, posn = ((u.pm * 256 + (in >> 2) * 128 + wr * 64 + (in & 3) * 16 + fr) & (S - 1)) + NMETA;
#pragma unroll
                for (int n = 0; n < 2; ++n) { cN[n] = *(const f32x4*)(COS + posn * 32 + 8 * fq + 4 * n); sN[n] = *(const f32x4*)(SIN + posn * 32 + 8 * fq + 4 * n); } }
            f32x4 x[2][2];
#pragma unroll
            for (int bj = 0; bj < 2; ++bj)
#pragma unroll
                for (int n = 0; n < 2; ++n) x[bj][n] = (I8 ? i2f4(acc[ai][bj][m][n]) : acc[ai][bj][m][n]) * rr;
            if (T.mode & 1) {
                float ss = (hsum4(x[0][0] * x[0][0]) + hsum4(x[0][1] * x[0][1])) + (hsum4(x[1][0] * x[1][0]) + hsum4(x[1][1] * x[1][1]));
                ss += __shfl_xor(ss, 16); ss += __shfl_xor(ss, 32);
                const float rn = rsqrtf(ss * (1.0f / 64.0f) + EPS);
#pragma unroll
                for (int bj = 0; bj < 2; ++bj)
#pragma unroll
                    for (int n = 0; n < 2; ++n) x[bj][n] = x[bj][n] * (g[bj][n] * rn);
            }
            if (T.mode & 2) {
#pragma unroll
                for (int n = 0; n < 2; ++n) { const f32x4 c = cC[n], sn = sC[n];
                    const f32x4 lo = x[0][n], hi = x[1][n]; x[0][n] = lo * c - hi * sn; x[1][n] = lo * sn + hi * c; }
            }
            const size_t drow = (T.mode & 4) ? (size_t)(R >> 11) * KROWS + PRE + (R & (S - 1)) : (size_t)R;
            bf16* dp = T.dst + drow * T.ldd + T.col0 + 8 * fq;
            *(u32x4*)(dp) = pack8(x[0][0] * T.scale, x[0][1] * T.scale);
            *(u32x4*)(dp + 32) = pack8(x[1][0] * T.scale, x[1][1] * T.scale);
        }
}
struct EpiInA {
    static constexpr bool PERM = true, AFTER_DRAIN = false;
    const Ptrs& P; int l; int i8, pn0;
    __device__ __forceinline__ void operator()(const f32x4 (&acc)[2][2][4][2], const pg8::Unit& u, int wr, int wc, int fr, int fq) const {
        HeadTile T; const int pn = u.pn + pn0; T.lc = l;
        if (pn < 4) { T.dst = WSP(bf16, OFF_QO); T.ldd = D; T.col0 = 64 * (4 * pn + wc); T.mode = 3; T.gain = WSP(float, OFF_GT) + GT_AQG + l * 64; T.scale = C2; }
        else if (pn == 4) { T.dst = WSP(bf16, OFF_KA); T.ldd = 256; T.col0 = 64 * wc; T.mode = 7; T.gain = WSP(float, OFF_GT) + GT_AKG + l * 64; T.scale = 1.f; }
        else if (pn == 5) { T.dst = WSP(bf16, OFF_VA); T.ldd = 256; T.col0 = 64 * wc; T.mode = 4; T.gain = nullptr; T.scale = 1.f; }
        else { T.dst = WSP(bf16, OFF_QI); T.ldd = 512; T.col0 = 64 * (4 * (pn - 6) + wc); T.mode = 2; T.gain = nullptr; T.scale = 1.f; }
        if (i8) epi_heads<true>(P, T, ssq_p(P, 2 * l), acc, u, wr, wc, fr, fq); else epi_heads<false>(P, T, ssq_p(P, 2 * l), acc, u, wr, wc, fr, fq);
    }
};
struct EpiInB {
    static constexpr bool PERM = true, AFTER_DRAIN = false;
    const Ptrs& P; int l;
    __device__ __forceinline__ void operator()(const f32x4 (&acc)[2][2][4][2], const pg8::Unit& u, int wr, int wc, int fr, int fq) const {
        HeadTile T; const int pn = u.pn; T.lc = l;
        if (pn < 4) { T.dst = WSP(bf16, OFF_QO); T.ldd = D; T.col0 = 64 * (4 * pn + wc); T.mode = 1; T.gain = WSP(float, OFF_GT) + GT_BQG + (l - 2) * 64; T.scale = C2; }
        else if (pn < 8) { T.dst = WSP(bf16, OFF_KB); T.ldd = D; T.col0 = 64 * (4 * (pn - 4) + wc); T.mode = 5; T.gain = WSP(float, OFF_GT) + GT_KKG; T.scale = 1.f; }
        else { T.dst = WSP(bf16, OFF_VB); T.ldd = D; T.col0 = 64 * (4 * (pn - 8) + wc); T.mode = 4; T.gain = nullptr; T.scale = 1.f; }
        epi_heads<true>(P, T, ssq_p(P, 2 * l), acc, u, wr, wc, fr, fq);
    }
};
template <bool MLP>
struct EpiRes {
    static constexpr bool PERM = true, AFTER_DRAIN = false;
    const Ptrs& P; int l, dry; float ascale = 1.0f;
    __device__ __forceinline__ void operator()(const f32x4 (&acc)[2][2][4][2], const pg8::Unit& u, int wr, int wc, int fr, int fq) const {
        constexpr int mlp = MLP ? 1 : 0;
        const bf16* H = WSP(bf16, OFF_H); bf16* Hw = dry ? (bf16*)P.out : WSP(bf16, OFF_H); float* ssqn = dry ? P.out + (size_t)20 * 1024 * 1024 : ssq_p(P, 2 * l + (mlp ? 2 : 1)); const bool last = mlp && l == 3 && !dry;
        f32x4 csa[2], csb[2];
        float qn = 0.f; if constexpr (MLP) { if (l < 3) qn = in_qscale(P, l + 1, 0) * QA; }
        if constexpr (MLP) { const int* cs = (const int*)(P.ws + OFF_CTL) + CW_CS + l * D;
#pragma unroll
            for (int bj = 0; bj < 2; ++bj) { const int col = u.pn * 256 + bj * 128 + wc * 32 + 8 * fq; const i32x4v c0 = *(const i32x4v*)(cs + col), c1 = *(const i32x4v*)(cs + col + 4);
#pragma unroll
                for (int j = 0; j < 4; ++j) { csa[bj][j] = 128.f * (float)c0[j]; csb[bj][j] = 128.f * (float)c1[j]; } } }
        u32x4 hvv[2][4][2];
#pragma unroll
        for (int ai = 0; ai < 2; ++ai)
#pragma unroll
            for (int m = 0; m < 4; ++m)
#pragma unroll
                for (int bj = 0; bj < 2; ++bj) hvv[ai][m][bj] = *(const u32x4*)(H + (size_t)(u.pm * 256 + ai * 128 + wr * 64 + m * 16 + fr) * D + u.pn * 256 + bj * 128 + wc * 32 + 8 * fq);
        extern __shared__ __attribute__((aligned(16))) unsigned char dyn_lds_epi[];
        float* rs = (float*)(dyn_lds_epi + EPI_RS_OFF) + (wr * 4 + wc) * 128;
        if constexpr (!MLP) { const int lane = fq * 16 + fr;
#pragma unroll
            for (int h = 0; h < 2; ++h) { const int j = lane + 64 * h; rs[j] = row_scale(ssq_p(P, 2 * l), u.pm * 256 + (j >> 6) * 128 + wr * 64 + (j & 63)) * QA; } }
#pragma unroll
        for (int ai = 0; ai < 2; ++ai)
#pragma unroll
            for (int m = 0; m < 4; ++m) {
                const int R = u.pm * 256 + ai * 128 + wr * 64 + m * 16 + fr; float sq = 0.f;
                float qs = 0.f; if constexpr (!MLP) qs = rs[ai * 64 + m * 16 + fr];
#pragma unroll
                for (int bj = 0; bj < 2; ++bj) {
                    const int col = u.pn * 256 + bj * 128 + wc * 32 + 8 * fq;
                    const u32x4 hv = hvv[ai][m][bj];
                    f32x4 a, b;
                    if constexpr (MLP) { a = (i2f4(acc[ai][bj][m][0]) + csa[bj]) * (1.0f / (QU * QW2)); b = (i2f4(acc[ai][bj][m][1]) + csb[bj]) * (1.0f / (QU * QW2)); }
                    else { a = acc[ai][bj][m][0] * ascale; b = acc[ai][bj][m][1] * ascale; }
                    a[0] += bf2f(hv.x & 0xffffu); a[1] += bf2f(hv.x >> 16); a[2] += bf2f(hv.y & 0xffffu); a[3] += bf2f(hv.y >> 16);
                    b[0] += bf2f(hv.z & 0xffffu); b[1] += bf2f(hv.z >> 16); b[2] += bf2f(hv.w & 0xffffu); b[3] += bf2f(hv.w >> 16);
                    sq += hsum4(a * a) + hsum4(b * b);
                    if (!last) *(u32x4*)(Hw + (size_t)R * D + col) = pack8(a, b);
                    if constexpr (MLP) { if (!last && !dry) { u32x2 o8; o8.x = pk4_i8(a[0] * qn, a[1] * qn, a[2] * qn, a[3] * qn); o8.y = pk4_i8(b[0] * qn, b[1] * qn, b[2] * qn, b[3] * qn);
                        *(u32x2*)(WSP(unsigned char, l == 0 ? OFF_H8A : OFF_H8B) + blk8(R, col, D)) = o8; } }
                    else { if (!dry) { u32x2 o8; o8.x = pk4_i8(a[0] * qs, a[1] * qs, a[2] * qs, a[3] * qs); o8.y = pk4_i8(b[0] * qs, b[1] * qs, b[2] * qs, b[3] * qs);
                        *(u32x2*)(WSP(unsigned char, OFF_HQ) + blk8(R, col, D)) = o8; } }
                    if (last) { float* op = P.out + (size_t)R * D + col; *(f32x4*)op = a; *(f32x4*)(op + 4) = b; }
                }
                sq += __shfl_xor(sq, 16); sq += __shfl_xor(sq, 32);
                if (fq == 0 && !last) ssqn[(size_t)R * 16 + 4 * u.pn + wc] = sq;
            }
    }
};
struct EpiRelu2 {
    static constexpr bool PERM = true, AFTER_DRAIN = false;
    const Ptrs& P; int l, blk;
    __device__ __forceinline__ void operator()(const f32x4 (&acc)[2][2][4][2], const pg8::Unit& u, int wr, int wc, int fr, int fq) const {
        unsigned char* U8 = WSP(unsigned char, OFF_U);
        extern __shared__ __attribute__((aligned(16))) unsigned char dyn_lds_epi[];
        float* rs = (float*)(dyn_lds_epi + EPI_RS_OFF) + (wr * 4 + wc) * 128;
        { const int lane = fq * 16 + fr; float v[2];
#pragma unroll
          for (int h = 0; h < 2; ++h) { const int j = lane + 64 * h, Rj = u.pm * 256 + (j >> 6) * 128 + wr * 64 + (j & 63);
              v[h] = row_scale(ssq_p(P, 2 * l + 1), Rj) * SQRT_QU / (row_scale(ssq_p(P, 2 * l), Rj) * (QA * QW1)); }
          rs[lane] = v[0]; rs[lane + 64] = v[1]; }
#pragma unroll
        for (int ai = 0; ai < 2; ++ai)
#pragma unroll
            for (int m = 0; m < 4; ++m) {
                const int R = u.pm * 256 + ai * 128 + wr * 64 + m * 16 + fr;
                const float sc = rs[ai * 64 + m * 16 + fr];
#pragma unroll
                for (int bj = 0; bj < 2; ++bj) {
                    const f32x4 sc4 = {sc, sc, sc, sc};
                    f32x4 a = i2f4(acc[ai][bj][m][0]) * sc4, b = i2f4(acc[ai][bj][m][1]) * sc4;
#pragma unroll
                    for (int j = 0; j < 4; ++j) { a[j] = a[j] * fabsf(a[j]); b[j] = b[j] * fabsf(b[j]); }

                    const int col = u.pn * 256 + bj * 128 + wc * 32 + 8 * fq;
                    int p0 = __builtin_amdgcn_cvt_pk_u8_f32(a[0], 0, 0); p0 = __builtin_amdgcn_cvt_pk_u8_f32(a[1], 1, p0); p0 = __builtin_amdgcn_cvt_pk_u8_f32(a[2], 2, p0); p0 = __builtin_amdgcn_cvt_pk_u8_f32(a[3], 3, p0);
                    int p1 = __builtin_amdgcn_cvt_pk_u8_f32(b[0], 0, 0); p1 = __builtin_amdgcn_cvt_pk_u8_f32(b[1], 1, p1); p1 = __builtin_amdgcn_cvt_pk_u8_f32(b[2], 2, p1); p1 = __builtin_amdgcn_cvt_pk_u8_f32(b[3], 3, p1);
                    u32x2 o; o.x = (unsigned)p0 ^ 0x80808080u; o.y = (unsigned)p1 ^ 0x80808080u;
                    __builtin_nontemporal_store(o, (u32x2*)(U8 + ((size_t)(R >> 4) * (FF / 32) + (col >> 5)) * 512 + (R & 15) * 32 + (col & 31)));
                }
            }
    }
};

#include <hip/hip_bf16.h>
#include <cmath>
namespace attn_body {
typedef unsigned u32x2_t __attribute__((ext_vector_type(2)));
constexpr int KVROWS=64+2048;
constexpr int LDS_AUX_BYTES=33*32*8;
using bf16=__hip_bfloat16;
using bf16x8=__attribute__((ext_vector_type(8)))short;
using s16x4=__attribute__((ext_vector_type(4)))short;
using f32x16=__attribute__((ext_vector_type(16)))float;
using u32x4=__attribute__((ext_vector_type(4)))unsigned;
constexpr int BATCH=16,NHEAD=16,SEQ=2048,D=64,DM=NHEAD*D;
constexpr int NW=8,QBLK=32,QB=QBLK*NW,KVBLK=64,NQB=SEQ/QB;
constexpr int ATTN_PITCH=DM, ATTN_UNIT_ROWS=QB;
__device__ __forceinline__ int crow(int r,int hi){return (r&3)+8*(r>>2)+4*hi;}
#define SBAR() __builtin_amdgcn_sched_barrier(0)
__device__ __forceinline__ void cmask(f32x16&p0,f32x16&p1,int jb,int qrel,int hi){
  const float NEG=-INFINITY; int kb=64*jb+4*hi;
  #pragma unroll
  for(int r=0;r<16;++r){int kv=kb+(r&3)+8*(r>>2); if(kv>qrel)p0[r]=NEG; if(kv+32>qrel)p1[r]=NEG;}
}

constexpr int NSLOT=3, SLOTB=8192;
constexpr int LDS_K=0, LDS_V=NSLOT*SLOTB, LDS_WS=2*NSLOT*SLOTB, LDS_OST=LDS_WS+NW*64*4, LDS_CORE=LDS_OST+NW*4096, LDS_AUX=LDS_CORE, LDS_BYTES=LDS_AUX+NW*LDS_AUX_BYTES;
constexpr float O_F8SC=16.f;
constexpr float C2=0.125f*1.4426950408889634f;
__device__ __forceinline__ void glds16(const void*gsrc,unsigned lds_dst){unsigned keep;
  asm volatile("s_mov_b32 %0, m0\n\ts_mov_b32 m0, %2\n\ts_nop 0\n\tglobal_load_lds_dwordx4 %1, off\n\ts_mov_b32 m0, %0":"=&s"(keep):"v"(gsrc),"s"(lds_dst):"memory");}
__device__ __forceinline__ float max3f(float a,float b,float c){float r;asm("v_max3_f32 %0, %1, %2, %3":"=v"(r):"v"(a),"v"(b),"v"(c));return r;}
__device__ __forceinline__ float max2f(float a,float b){float r;asm("v_max_f32_e32 %0, %1, %2":"=v"(r):"v"(a),"v"(b));return r;}
__device__ __forceinline__ float fadd_s(float a,float b){float r;asm("v_add_f32_e32 %0, %1, %2":"=v"(r):"v"(a),"v"(b));return r;}
__device__ __forceinline__ float fsub_s(float a,float b){float r;asm("v_sub_f32_e32 %0, %1, %2":"=v"(r):"v"(a),"v"(b));return r;}
typedef float f32x2_t __attribute__((ext_vector_type(2))); typedef float f32x4_t __attribute__((ext_vector_type(4))); typedef __bf16 bf16x2_t __attribute__((ext_vector_type(2)));
__device__ __forceinline__ unsigned cvtpk_s(float lo,float hi){f32x2_t v={lo,hi};bf16x2_t b=__builtin_convertvector(v,bf16x2_t);return __builtin_bit_cast(unsigned,b);}
#define WAIT_BAR(N) asm volatile("s_waitcnt vmcnt(" #N ") lgkmcnt(0)\n\ts_barrier":::"memory")

__device__ __forceinline__ void qkt(f32x16&p0,f32x16&p1,const char*Kslot,const bf16x8*qr,const f32x16&negm,int r32,int hi){
  const char*kb=Kslot+hi*1024+r32*16;
  #pragma unroll
  for(int d0=0;d0<4;++d0){
    const bf16x8 b0=*reinterpret_cast<const bf16x8*>(kb+d0*2048);
    const bf16x8 b1=*reinterpret_cast<const bf16x8*>(kb+d0*2048+512);
    if(d0==0){p0=__builtin_amdgcn_mfma_f32_32x32x16_bf16(b0,qr[0],negm,0,0,0);p1=__builtin_amdgcn_mfma_f32_32x32x16_bf16(b1,qr[0],negm,0,0,0);}
    else{p0=__builtin_amdgcn_mfma_f32_32x32x16_bf16(b0,qr[d0],p0,0,0,0);p1=__builtin_amdgcn_mfma_f32_32x32x16_bf16(b1,qr[d0],p1,0,0,0);}}
}
typedef __attribute__((address_space(3))) const char* lds_cptr;
typedef __attribute__((address_space(3))) char* lds_cptr_w;
typedef short v4i16_t __attribute__((ext_vector_type(4)));
__device__ __forceinline__ void kload8(bf16x8*kf,lds_cptr kp){
  kf[0]=*(const __attribute__((address_space(3))) bf16x8*)(kp);      kf[1]=*(const __attribute__((address_space(3))) bf16x8*)(kp+512);
  kf[2]=*(const __attribute__((address_space(3))) bf16x8*)(kp+2048); kf[3]=*(const __attribute__((address_space(3))) bf16x8*)(kp+2560);
  kf[4]=*(const __attribute__((address_space(3))) bf16x8*)(kp+4096); kf[5]=*(const __attribute__((address_space(3))) bf16x8*)(kp+4608);
  kf[6]=*(const __attribute__((address_space(3))) bf16x8*)(kp+6144); kf[7]=*(const __attribute__((address_space(3))) bf16x8*)(kp+6656);
}
__device__ __forceinline__ void kload2(bf16x8*kf,lds_cptr kp,int j){ kf[2*j]=*(const __attribute__((address_space(3))) bf16x8*)(kp+j*2048); kf[2*j+1]=*(const __attribute__((address_space(3))) bf16x8*)(kp+j*2048+512); }
__device__ __forceinline__ s16x4 vtr(lds_cptr p){ return __builtin_bit_cast(s16x4,__builtin_amdgcn_ds_read_tr16_b64_v4i16((__attribute__((address_space(3))) v4i16_t*)p)); }
__device__ __forceinline__ float rowmax(const f32x16&p0,const f32x16&p1){
  float a=max3f(p0[0],p0[1],p1[0]),b=max3f(p0[2],p0[3],p1[1]);a=max3f(a,p1[2],p1[3]);
  #pragma unroll
  for(int r=4;r<16;r+=4){a=max3f(a,p0[r],p0[r+1]);b=max3f(b,p0[r+2],p0[r+3]);a=max3f(a,p1[r],p1[r+1]);b=max3f(b,p1[r+2],p1[r+3]);}
  const float m=max2f(a,b);
  auto rr=__builtin_amdgcn_permlane32_swap(__float_as_uint(m),__float_as_uint(m),false,false);
  return max2f(__uint_as_float(rr[0]),__uint_as_float(rr[1]));
}
__device__ __forceinline__ void pv(f32x16*o,int vb,bf16x8 pa0,bf16x8 pa1,bf16x8 pa2,bf16x8 pa3){
  #pragma unroll
  for(int d0=0;d0<2;++d0){s16x4 lo[4],hi[4];
    #pragma unroll
    for(int ks=0;ks<4;++ks){
      asm volatile("ds_read_b64_tr_b16 %0,%1 offset:%c2":"=&v"(lo[ks]):"v"(vb),"i"(d0*4096+ks*1024):"memory");
      asm volatile("ds_read_b64_tr_b16 %0,%1 offset:%c2":"=&v"(hi[ks]):"v"(vb),"i"(d0*4096+ks*1024+512):"memory");}
    asm volatile("s_waitcnt lgkmcnt(0)":::"memory");SBAR();
    #define PK(k) (bf16x8){lo[k][0],lo[k][1],lo[k][2],lo[k][3],hi[k][0],hi[k][1],hi[k][2],hi[k][3]}
    o[d0]=__builtin_amdgcn_mfma_f32_32x32x16_bf16(pa0,PK(0),o[d0],0,0,0);
    o[d0]=__builtin_amdgcn_mfma_f32_32x32x16_bf16(pa1,PK(1),o[d0],0,0,0);
    o[d0]=__builtin_amdgcn_mfma_f32_32x32x16_bf16(pa2,PK(2),o[d0],0,0,0);
    o[d0]=__builtin_amdgcn_mfma_f32_32x32x16_bf16(pa3,PK(3),o[d0],0,0,0);
    #undef PK
  }
}

#ifndef ATTN_STORE16
#define ATTN_STORE16(p,v) (*(u32x4*)(p)=(v))
#endif
template<int THRL,int MODE,int KVP> __device__ __forceinline__ void attn_unit(int b,int h,int hk,int qb,const bf16*Q,const bf16*__restrict__ K,const bf16*__restrict__ V,bf16*O,char*shm,const unsigned*maskg,const float*biasg,int t0  ){
  int tid_=threadIdx.x; asm volatile("":"+v"(tid_));
  const int tid=tid_,lane=tid&63,r32=lane&31,hi=lane>>5; const int wid=__builtin_amdgcn_readfirstlane(tid>>6);
  const long rowbase=(long)b*SEQ; const int q0=qb*QB;
  const bf16*Qw=Q+(rowbase+q0+wid*QBLK)*DM+h*D;
  const long kvbase=(long)b*KVROWS+(long)t0*64;
  const bf16*Kh=K+kvbase*KVP+hk*D,*Vh=V+kvbase*KVP+hk*D;
  const unsigned lds0=(unsigned)(uintptr_t)shm;
  float*wsf=(float*)(shm+LDS_WS)+wid*64;
  const bf16*ksrc=Kh+(long)lane*KVP+wid*8;
  const bf16*vsrc=Vh+(long)(16*(wid&3)+(lane>>2))*KVP+(wid>>2)*32+(lane&3)*8;
  const unsigned kdst=lds0+LDS_K+wid*1024, vdst=lds0+LDS_V+wid*1024;
  #define DMA_K(t,slot) glds16(ksrc+(long)(t)*KVBLK*KVP,(unsigned)__builtin_amdgcn_readfirstlane(kdst+(slot)))
  #define DMA_V(t,slot) glds16(vsrc+(long)(t)*KVBLK*KVP,(unsigned)__builtin_amdgcn_readfirstlane(vdst+(slot)))
  const int vb0=(int)(lds0+LDS_V)+((lane>>4)&1)*32+(lane&3)*8+(4*hi+((lane&15)>>2))*64;
  const char*Kbase=shm+LDS_K; bf16x8 kf[8];
  const lds_cptr shm3=(lds_cptr)shm; const lds_cptr kp0=shm3+LDS_K+hi*1024+r32*16; const lds_cptr vp0=shm3+LDS_V+((lane>>4)&1)*32+(lane&3)*8+(4*hi+((lane&15)>>2))*64;
  const int NT=(q0+QB)/KVBLK+1-t0;
  float nbq=0.f; if(MODE==1) nbq=biasg[64+q0+wid*QBLK+r32];
  if(MODE==2){} else if(MODE==0){
    const unsigned*mrow=maskg+((long)(rowbase+q0+wid*QBLK+r32))*66;
    __attribute__((address_space(3))) u32x2_t*mdst=(__attribute__((address_space(3))) u32x2_t*)((lds_cptr_w)shm+LDS_AUX+wid*LDS_AUX_BYTES);
    for(int t=hi;t<NT;t+=2){ const u32x2_t w=*reinterpret_cast<const u32x2_t*>(mrow+2*t); mdst[t*32+r32]=w; }
  } else {
    __attribute__((address_space(3))) float*bdst=(__attribute__((address_space(3))) float*)((lds_cptr_w)shm+LDS_AUX);
    for(int i=tid;i<NT*64;i+=NW*64)bdst[i]=biasg[t0*64+i];
  }
  asm volatile("s_waitcnt vmcnt(0) lgkmcnt(0)":::"memory");
  DMA_K(0,0);DMA_V(0,0);DMA_K(1,SLOTB);
  bf16x8 qr[4];
  #pragma unroll
  for(int d0=0;d0<4;++d0)qr[d0]=*reinterpret_cast<const bf16x8*>(&Qw[(long)r32*DM+d0*16+hi*8]);
  float mhat=0.f,l_reg=0.f;f32x16 o[2];o[0]=f32x16{};o[1]=f32x16{};const f32x16 negm=f32x16{};
  const int qrel=wid*QBLK+r32;
  if(MODE==1) mhat=nbq;
  #define CMASK(P0,P1,t) do{ if(MODE==2){ _Pragma("unroll") for(int r=0;r<16;++r){P0[r]-=mhat;P1[r]-=mhat;} int jb_=(t)-(NT-4); if(jb_>=0)cmask(P0,P1,jb_,qrel,hi); } else if(MODE==0){ const u32x2_t mw_=*((const __attribute__((address_space(3))) u32x2_t*)(shm3+LDS_AUX+wid*LDS_AUX_BYTES)+(t)*32+r32); mkx=mw_.x>>(4*hi); mky=mw_.y>>(4*hi); } \
      else { const __attribute__((address_space(3))) float*bp_=(const __attribute__((address_space(3))) float*)(shm3+LDS_AUX)+64*(t)+4*hi; \
        _Pragma("unroll") for(int g_=0;g_<4;++g_){ const f32x4_t b0_=*(const __attribute__((address_space(3))) f32x4_t*)(bp_+8*g_)-mhat, b1_=*(const __attribute__((address_space(3))) f32x4_t*)(bp_+32+8*g_)-mhat; \
          _Pragma("unroll") for(int j_=0;j_<4;++j_){ P0[4*g_+j_]+=b0_[j_]; P1[4*g_+j_]+=b1_[j_]; } SBAR(); } \
        int jb_=(t)-(NT-4); if(jb_>=0)cmask(P0,P1,jb_,qrel,hi); } }while(0)
  bool resc=false; unsigned mkx=0u,mky=0u;
  #define MSK(X,i,W) do{ float xv_=X[i]; unsigned mt_;   \
      asm volatile("v_bfe_i32 %1, %2, %3, 1\n\tv_and_b32 %0, %0, %1":"+v"(xv_),"=&v"(mt_):"v"(W),"n"(((i)&3)+8*((i)>>2))); X[i]=xv_; }while(0)
  #define START(P0,P1) do{ resc=false; \
    if(MODE==2){ const float rm=rowmax(P0,P1); const float dl=rm; mhat=fadd_s(mhat,dl); \
      _Pragma("unroll") for(int r=0;r<16;++r){P0[r]=fsub_s(P0[r],dl);P1[r]=fsub_s(P1[r],dl);} \
      } \
    _Pragma("unroll") for(int r=0;r<16;++r){P0[r]=__builtin_amdgcn_exp2f(P0[r]); if(MODE==0){MSK(P0,r,mkx);}} }while(0)
  #define RESC() do{ if(resc){ asm volatile("s_waitcnt lgkmcnt(0)":::"memory"); \
      _Pragma("unroll") for(int d_=0;d_<2;++d_) _Pragma("unroll") for(int r=0;r<16;++r)o[d_][r]*=wsf[crow(r,hi)]; } }while(0)
  f32x16 pA0,pA1,pB0,pB1;
  int sl_prev=0,sl_cur=0,sl_next=SLOTB;
  #define ROT() do{sl_prev=sl_cur;sl_cur=sl_next;sl_next=(sl_next==(NSLOT-1)*SLOTB)?0:sl_next+SLOTB;}while(0)
  DMA_K(2,2*SLOTB);
  WAIT_BAR(3);
  qkt(pA0,pA1,Kbase,qr,negm,r32,hi);asm volatile("s_nop 15\n\ts_nop 7":"+v"(pA0),"+v"(pA1));CMASK(pA0,pA1,0);
  START(pA0,pA1);
  _Pragma("unroll") for(int r=0;r<16;++r){pA1[r]=__builtin_amdgcn_exp2f(pA1[r]); if(MODE==0){MSK(pA1,r,mky);}}
  WAIT_BAR(0);
  DMA_K(3,0);DMA_V(1,SLOTB);
  ROT();
  kload8(kf,kp0+sl_cur);
  WAIT_BAR(2);
  s16x4 vlo[8],vhi[8]; u32x4 pw0,pw1,pw2,pw3;
  #define PKW(P,B) cvtpk_s(P[B],P[B+1])
  #define PAF(k) __builtin_bit_cast(bf16x8,pw##k)
  #define VFR(i) (bf16x8){vlo[i][0],vlo[i][1],vlo[i][2],vlo[i][3],vhi[i][0],vhi[i][1],vhi[i][2],vhi[i][3]}
  #define PIN(x) asm volatile("":"+v"(x))
  #define MX3(a,b,c) __builtin_fmaxf(__builtin_fmaxf((a),(b)),(c))
  #define GAPA(MF,A0,A1,A2,A3,W0,W1,PW) do{ MF; sacc+=A0; sacc+=A1; sacc+=A2; sacc+=A3; PIN(sacc); W0; W1; PIN(PW); SBAR(); }while(0)
  #define EX(v) __builtin_amdgcn_exp2f(v)
  #define GAPB(MF,X,B,W) do{ MF; X[B]=EX(X[B]); X[B+1]=EX(X[B+1]); X[B+2]=EX(X[B+2]); X[B+3]=EX(X[B+3]); if(MODE==0){MSK(X,B,W);MSK(X,(B)+1,W);MSK(X,(B)+2,W);MSK(X,(B)+3,W);} PIN(X); SBAR(); }while(0)
  #define VRD(i) do{ vlo[i]=vtr(vp_+(((i)>>2)*4096+((i)&3)*1024)); vhi[i]=vtr(vp_+(((i)>>2)*4096+((i)&3)*1024+512)); }while(0)
  #define KRD(G,j) do{ if(G){ kload2(kf,kp0+sl_next,j); SBAR(); } }while(0)
  #define STEP(C0,C1,P0,P1,t,GK,GV,GL) do{ SBAR(); \
    const lds_cptr vp_=vp0+sl_prev; \
    VRD(0); SBAR(); float sacc=(P0[0]+P0[1]); \
    GAPA(C0=__builtin_amdgcn_mfma_f32_32x32x16_bf16(kf[0],qr[0],negm,0,0,0), P0[2],P0[3],P0[4],P0[5],     pw0[0]=PKW(P0,0), pw0[1]=PKW(P0,2), pw0); \
    VRD(4); SBAR(); GAPA(C1=__builtin_amdgcn_mfma_f32_32x32x16_bf16(kf[1],qr[0],negm,0,0,0), P0[6],P0[7],P0[8],P0[9],     pw0[2]=PKW(P0,4), pw0[3]=PKW(P0,6), pw0); \
    VRD(1); SBAR(); GAPA(C0=__builtin_amdgcn_mfma_f32_32x32x16_bf16(kf[2],qr[1],C0,0,0,0),   P0[10],P0[11],P0[12],P0[13], pw1[0]=PKW(P0,8), pw1[1]=PKW(P0,10), pw1); \
    VRD(5); SBAR(); GAPA(C1=__builtin_amdgcn_mfma_f32_32x32x16_bf16(kf[3],qr[1],C1,0,0,0),   P0[14],P0[15],P1[0],P1[1],   pw1[2]=PKW(P0,12),pw1[3]=PKW(P0,14), pw1); \
    VRD(2); SBAR(); GAPA(C0=__builtin_amdgcn_mfma_f32_32x32x16_bf16(kf[4],qr[2],C0,0,0,0),   P1[2],P1[3],P1[4],P1[5],     pw2[0]=PKW(P1,0), pw2[1]=PKW(P1,2), pw2); \
    VRD(6); SBAR(); GAPA(C1=__builtin_amdgcn_mfma_f32_32x32x16_bf16(kf[5],qr[2],C1,0,0,0),   P1[6],P1[7],P1[8],P1[9],     pw2[2]=PKW(P1,4), pw2[3]=PKW(P1,6), pw2); \
    VRD(3); SBAR(); GAPA(C0=__builtin_amdgcn_mfma_f32_32x32x16_bf16(kf[6],qr[3],C0,0,0,0),   P1[10],P1[11],P1[12],P1[13], pw3[0]=PKW(P1,8), pw3[1]=PKW(P1,10), pw3); \
    VRD(7); SBAR(); GAPA(C1=__builtin_amdgcn_mfma_f32_32x32x16_bf16(kf[7],qr[3],C1,0,0,0),   P1[14],P1[15],0.f,0.f,       pw3[2]=PKW(P1,12),pw3[3]=PKW(P1,14), pw3); \
    l_reg+=sacc; \
    if(GK){DMA_K((t)+3,sl_cur);} if(GV){DMA_V((t)+1,sl_next);} \
    CMASK(C0,C1,t); \
    if(MODE==2){ float a=MX3(C0[0],C0[1],C1[0]),b=MX3(C0[2],C0[3],C1[1]); a=MX3(a,C1[2],C1[3]); \
      _Pragma("unroll") for(int r=4;r<16;r+=4){a=MX3(a,C0[r],C0[r+1]);b=MX3(b,C0[r+2],C0[r+3]);a=MX3(a,C1[r],C1[r+1]);b=MX3(b,C1[r+2],C1[r+3]);} \
      float rm=__builtin_fmaxf(a,b); { auto rr=__builtin_amdgcn_permlane32_swap(__float_as_uint(rm),__float_as_uint(rm),false,false); rm=__builtin_fmaxf(__uint_as_float(rr[0]),__uint_as_float(rr[1])); } \
      resc=false; \
      if(__builtin_expect(__any(rm>(float)THRL),0)){ const float dl=__builtin_fmaxf(rm,0.f); mhat+=dl; \
        _Pragma("unroll") for(int r=0;r<16;++r){C0[r]-=dl;C1[r]-=dl;} \
        \
        const float f=__builtin_amdgcn_exp2f(-dl); l_reg*=f; if(hi==0)wsf[r32]=f; resc=true; } } \
    SBAR(); \
    GAPB(o[0]=__builtin_amdgcn_mfma_f32_32x32x16_bf16(PAF(0),VFR(0),o[0],0,0,0), C0,0,mkx); \
    GAPB(o[1]=__builtin_amdgcn_mfma_f32_32x32x16_bf16(PAF(0),VFR(4),o[1],0,0,0), C0,4,mkx); \
    KRD(GL,0); GAPB(o[0]=__builtin_amdgcn_mfma_f32_32x32x16_bf16(PAF(1),VFR(1),o[0],0,0,0), C0,8,mkx); \
    KRD(GL,1); GAPB(o[1]=__builtin_amdgcn_mfma_f32_32x32x16_bf16(PAF(1),VFR(5),o[1],0,0,0), C0,12,mkx); \
    KRD(GL,2); GAPB(o[0]=__builtin_amdgcn_mfma_f32_32x32x16_bf16(PAF(2),VFR(2),o[0],0,0,0), C1,0,mky); \
    KRD(GL,3); GAPB(o[1]=__builtin_amdgcn_mfma_f32_32x32x16_bf16(PAF(2),VFR(6),o[1],0,0,0), C1,4,mky); \
    GAPB(o[0]=__builtin_amdgcn_mfma_f32_32x32x16_bf16(PAF(3),VFR(3),o[0],0,0,0), C1,8,mky); \
    GAPB(o[1]=__builtin_amdgcn_mfma_f32_32x32x16_bf16(PAF(3),VFR(7),o[1],0,0,0), C1,12,mky); \
    }while(0)
  int t=1;
  for(;t+5<NT;t+=2){
    STEP(pB0,pB1,pA0,pA1,t,true,true,true);     WAIT_BAR(2); RESC(); ROT();
    STEP(pA0,pA1,pB0,pB1,t+1,true,true,true);   WAIT_BAR(2); RESC(); ROT();
  }
  #define ENDW(tt) do{ if((tt)+3<NT){WAIT_BAR(2);} else if((tt)+2<NT){WAIT_BAR(1);} else {WAIT_BAR(0);} }while(0)
  for(;t+1<NT;t+=2){
    const bool fin_=!(t+2<NT);
    STEP(pB0,pB1,pA0,pA1,t,(t+3<NT),(t+1<NT),(t+1<NT));
    ENDW(t);   RESC(); ROT();
    if(!(MODE<=1&&fin_&&wid<4)){ STEP(pA0,pA1,pB0,pB1,t+1,(t+4<NT),(t+2<NT),(t+2<NT)); }
    if(t+2<NT){ ENDW(t+1); RESC(); ROT(); } else { RESC(); }
  }
  if(!(MODE<=1&&wid<6)){ float sacc=pA0[0]+pA0[1]; _Pragma("unroll") for(int r=2;r<16;++r)sacc+=pA0[r]; _Pragma("unroll") for(int r=0;r<16;++r)sacc+=pA1[r]; l_reg+=sacc;
    pw0=(u32x4){PKW(pA0,0),PKW(pA0,2),PKW(pA0,4),PKW(pA0,6)};pw1=(u32x4){PKW(pA0,8),PKW(pA0,10),PKW(pA0,12),PKW(pA0,14)};pw2=(u32x4){PKW(pA1,0),PKW(pA1,2),PKW(pA1,4),PKW(pA1,6)};pw3=(u32x4){PKW(pA1,8),PKW(pA1,10),PKW(pA1,12),PKW(pA1,14)};
    SBAR(); pv(o,vb0+sl_cur,PAF(0),PAF(1),PAF(2),PAF(3)); }
  #undef PKW
  #undef PAF
  #undef VFR
  #undef PIN
  #undef MX3
  #undef GAPA
  #undef GAPB
  #undef MSK
  #undef EX
  #undef VRD
  #undef KRD
  #undef STEP
  #undef ENDW
  {auto rr=__builtin_amdgcn_permlane32_swap(__float_as_uint(l_reg),__float_as_uint(l_reg),false,false);l_reg=__uint_as_float(rr[0])+__uint_as_float(rr[1]);}
  if(hi==0)wsf[32+r32]=l_reg;asm volatile("s_waitcnt lgkmcnt(0)":::"memory");
  float rli[16];
  #pragma unroll
  for(int r=0;r<16;++r)rli[r]=__builtin_amdgcn_rcpf(wsf[32+crow(r,hi)]);
  if constexpr (MODE<=1) {
    unsigned char*stg=(unsigned char*)(shm+LDS_OST)+wid*4096;
    #pragma unroll
    for(int r=0;r<16;++r){const int orow=crow(r,hi); const float sc=rli[r]*O_F8SC;
      #pragma unroll
      for(int d0=0;d0<2;++d0){ const float x=__builtin_amdgcn_fmed3f(o[d0][r]*sc,-448.f,448.f); stg[orow*64+d0*32+r32]=(unsigned char)__builtin_amdgcn_cvt_pk_fp8_f32(x,x,0,false); } }
    asm volatile("s_waitcnt lgkmcnt(0)":::"memory");
    const long R0=rowbase+q0+wid*QBLK;
    #pragma unroll
    for(int i=0;i<2;++i){const int idx=i*64+lane,blk=idx>>5,p=idx&31,row=(blk>>1)*16+(p>>1),ch=(blk&1)*2+(p&1);
      const u32x4 v=*(const u32x4*)(stg+row*64+ch*16);
      ATTN_STORE16((unsigned char*)O+(((R0>>4)+(blk>>1))*(DM/32)+2*h+(blk&1))*512+p*16,v);} }
  else {
  bf16*Ow=O+(rowbase+q0+wid*QBLK)*DM+h*D;
  { bf16*stg=(bf16*)(shm+LDS_OST)+wid*2048;
    #pragma unroll
    for(int r=0;r<16;++r){const int orow=crow(r,hi);
      #pragma unroll
      for(int d0=0;d0<2;++d0)stg[orow*64+d0*32+r32]=__float2bfloat16(o[d0][r]*rli[r]);}
    asm volatile("s_waitcnt lgkmcnt(0)":::"memory");
    #pragma unroll
    for(int i=0;i<4;++i){const int row=i*8+(lane>>3),ch=lane&7; const u32x4 v=*(const u32x4*)(stg+row*64+ch*8); ATTN_STORE16(Ow+(long)row*DM+ch*8,v);} }
  }
  asm volatile("s_waitcnt lgkmcnt(0)\n\ts_barrier":::"memory");
  #undef DMA_K
  #undef DMA_V
  #undef CMASK
  #undef START
  #undef RESC
  #undef ROT
}
constexpr int ATTN_LDS_BYTES=LDS_BYTES;
#undef SBAR
#undef WAIT_BAR
}

constexpr int SCHED_OFF = 156 * 1024;
constexpr int CW_ATTQ = 8192;
template <int MODE> __device__ __forceinline__ void attn_phase_fa(const Ptrs& P, char* lds, int G, int bx, bf16* Oout, int lyr) {
    typedef attn_body::bf16 abf;
    if (MODE != 1) {
#pragma unroll 1
        for (int u = bx; u < 2048; u += G) {
            const int bh = (G == 256) ? ((u & 7) * 32 + ((u & 255) >> 3)) : (u & 255), qb = 7 - (u >> 8), b = bh >> 4, h = bh & 15;
            if (MODE == 2) attn_body::attn_unit<8, 2, 1024>(b, h, h, qb, (const abf*)WSP(bf16, OFF_QO), (const abf*)WSP(bf16, OFF_QO), (const abf*)WSP(bf16, OFF_QO), (abf*)Oout, lds, nullptr, nullptr, 0);
            else attn_body::attn_unit<8, 0, 256>(b, h, h >> 2, qb, (const abf*)WSP(bf16, OFF_QO), (const abf*)WSP(bf16, OFF_KA), (const abf*)WSP(bf16, OFF_VA), (abf*)Oout, lds, WSP(unsigned, OFF_MASK), nullptr, 0);
        }
    } else {
        volatile LAS unsigned* sch = (volatile LAS unsigned*)((LAS unsigned char*)lds + SCHED_OFF);
        unsigned* qhead = (unsigned*)(P.ws + OFF_CTL) + CW_ATTQ + 64 * (lyr & 1) + 128 * (Oout != WSP(bf16, OFF_O8));
#pragma unroll 1
        for (;;) {
            int tid_q = threadIdx.x; asm volatile("" : "+v"(tid_q));
            const int lane = tid_q & 63, wave = __builtin_amdgcn_readfirstlane(tid_q >> 6);
            if (wave == 0) {
                unsigned u = 0;
                if (lane == 0) u = __hip_atomic_fetch_add(qhead, 1u, __ATOMIC_RELAXED, __HIP_MEMORY_SCOPE_AGENT);
                u = (unsigned)__builtin_amdgcn_readfirstlane((int)u);
                unsigned t0 = 0;
                if (u < 2048u) {
                    const int bh = u & 255, qb = 7 - (int)(u >> 8);
                    const float* nb = WSP(float, OFF_NB) + (size_t)bh * KROWS;
                    const float lim = nb[PRE + 256 * qb] - WSP(float, OFF_GT)[GT_SKIP];
                    const int cand = 2 * lane;
                    const bool ok = cand <= 4 * qb && (cand == 0 || nb[64 * cand - 1] <= lim);
                    const unsigned long long m = __ballot(ok);
                    t0 = 2u * (unsigned)(63 - __builtin_clzll(m));
                }
                if (lane == 0) { sch[0] = u; sch[1] = t0; }
            }
            asm volatile("s_waitcnt vmcnt(0) lgkmcnt(0)\n\ts_barrier" ::: "memory");
            const unsigned u = sch[0], t0 = sch[1];
            if (u >= 2048u) break;
            const int bh = u & 255, qb = 7 - (int)(u >> 8), b = bh >> 4, h = bh & 15;
            attn_body::attn_unit<8, 1, 1024>(b, h, h, qb, (const abf*)WSP(bf16, OFF_QO), (const abf*)WSP(bf16, OFF_KB), (const abf*)WSP(bf16, OFF_VB), (abf*)Oout, lds, nullptr, WSP(float, OFF_NB) + (size_t)bh * KROWS, (int)t0);
        }
    }
}

typedef GAS unsigned gu32;
#define RLX_AGENT __ATOMIC_RELAXED, __HIP_MEMORY_SCOPE_AGENT
#define XB_TMO      128
#define XB_XCNT(j)  (256  + 64 * (j))
#define XB_XSUB(j)  (1280 + 64 * (j))
#define XB_XGEN(j)  (2304 + 64 * (j))
#define XB_TOP      3328
#define XB_TOPGEN   3392
#define XCD_BAR_WORDS 3456
#define XB_SPIN_CAP (1u << 18)

__device__ __forceinline__ unsigned xb_ld(unsigned* p)              { return __hip_atomic_load(p, __ATOMIC_RELAXED, __HIP_MEMORY_SCOPE_AGENT); }
__device__ __forceinline__ unsigned xb_add(unsigned* p, unsigned v) { return __hip_atomic_fetch_add(p, v, __ATOMIC_RELAXED, __HIP_MEMORY_SCOPE_AGENT); }
__device__ __forceinline__ unsigned xb_xcc_id() { return (unsigned)__builtin_amdgcn_s_getreg((3 << 11) | 20) & 0xFu; }
#define XB_SPIN(cond, bar) do { unsigned _sp = 0; while (cond) { __builtin_amdgcn_s_sleep(1); \
    if ((++_sp & 255u) == 0u) { if (xb_ld(&(bar)[XB_TMO])) break; if (_sp > XB_SPIN_CAP) { atomicAdd(&(bar)[XB_TMO], 1u); break; } } } } while (0)

struct XcdBarrier {
    unsigned* bar; unsigned x;
    volatile LAS unsigned* st;
};

__device__ __forceinline__ XcdBarrier xcd_barrier_post(unsigned* bar, volatile LAS unsigned* st) {
    XcdBarrier b; b.bar = bar; b.x = xb_xcc_id(); b.st = st;
    if (threadIdx.x == 0) (void)xb_add(&bar[XB_XCNT(b.x)], 1u);
    return b;
}
__device__ __forceinline__ void xcd_barrier_complete(unsigned* bar, unsigned x, unsigned& nloc, unsigned& nx) {
    const unsigned G = gridDim.x * gridDim.y * gridDim.z;
    unsigned sum, cnt, mine, sp = 0u;
    for (;;) {
        sum = 0u; cnt = 0u; mine = 0u;
#pragma unroll
        for (unsigned j = 0; j < 16; ++j) { const unsigned c = xb_ld(&bar[XB_XCNT(j)]); sum += c; cnt += (c > 0u) ? 1u : 0u; mine = (j == x) ? c : mine; }
        if (sum == G) break;
        __builtin_amdgcn_s_sleep(1);
        if ((++sp & 255u) == 0u) { if (xb_ld(&bar[XB_TMO])) break; if (sp > XB_SPIN_CAP) { atomicAdd(&bar[XB_TMO], 1u); break; } }
    }
    nloc = mine > 0u ? mine : 1u; nx = cnt > 0u ? cnt : 1u;
}

__device__ __forceinline__ void xcd_barrier(const XcdBarrier& b) {
    asm volatile("s_waitcnt vmcnt(0)" ::: "memory");
    __syncthreads();
    if (threadIdx.x == 0) {
        unsigned* bar = b.bar;
        __builtin_amdgcn_s_waitcnt(0);
        unsigned nloc = b.st[0], nx = b.st[1];
        if (nloc == 0u) { xcd_barrier_complete(bar, b.x, nloc, nx); b.st[0] = nloc; b.st[1] = nx; }
        const unsigned old = xb_add(&bar[XB_XSUB(b.x)], 1u);
        const unsigned gen = old / nloc;
        if (old + 1u == (gen + 1u) * nloc) {
            __builtin_amdgcn_fence(__ATOMIC_RELEASE, "agent");
            asm volatile("s_waitcnt vmcnt(0)" ::: "memory");
            const unsigned og = xb_add(&bar[XB_TOP], 1u);
            const unsigned tg = og / nx;
            if (og + 1u == (tg + 1u) * nx) xb_add(&bar[XB_TOPGEN], 1u);
            else XB_SPIN(xb_ld(&bar[XB_TOPGEN]) == tg, bar);
            __builtin_amdgcn_fence(__ATOMIC_ACQUIRE, "agent");
            xb_add(&bar[XB_XGEN(b.x)], 1u);
            asm volatile("s_waitcnt vmcnt(0)" ::: "memory");
        } else {
            XB_SPIN(xb_ld(&bar[XB_XGEN(b.x)]) == gen, bar);
            __builtin_amdgcn_fence(__ATOMIC_ACQUIRE, "agent");
            asm volatile("s_waitcnt vmcnt(0)" ::: "memory");
        }
    }
    __syncthreads();
}


constexpr int NWAVES = 8;
constexpr int LDS_BYTES = 160 * 1024;
constexpr int MISC_OFF = LDS_BYTES - 256;
constexpr int CW_BAR = 4096;

struct Args { Ptrs P; int ph_lo, ph_hi; };
constexpr int N_PHASES = 1 + 8 * 4;
#ifndef PROBE_ID
#define PROBE_ID 0
#endif
#ifndef PROBE_DRY
#define PROBE_DRY 0
#endif
#ifndef PROBE_REPS
#define PROBE_REPS 3
#endif

#define SITE_IDS() int tid_s = threadIdx.x; asm volatile("" : "+v"(tid_s)); const int lane = tid_s & 63; const int wave = __builtin_amdgcn_readfirstlane(tid_s >> 6); \
    const int gw = bx * NWAVES + wave; (void)gw; (void)lane
__global__ void __launch_bounds__(NWAVES * 64, 2) mega_fwd(Args args) {
    extern __shared__ __attribute__((aligned(16))) unsigned char lds[];
    const Ptrs& P = args.P;
    const int G = gridDim.x, bx = blockIdx.x, ngw = G * NWAVES;
    volatile LAS unsigned* MISC = (volatile LAS unsigned*)((LAS unsigned char*)lds + MISC_OFF);
    for (int u = threadIdx.x; u < 64; u += NWAVES * 64) MISC[u] = 0u;
    __syncthreads();
    XcdBarrier bar = xcd_barrier_post((unsigned*)(P.ws + OFF_CTL) + CW_BAR, MISC + 8);
    const int lo = args.ph_lo, hi = args.ph_hi;
#define IN(k) (lo <= (k) && (k) < hi)
#define SEAM(k) do { if (IN(k) && IN((k) + 1)) xcd_barrier(bar); } while (0)
#define WSCR() ((float*)lds + wave * (64 * 65))

#define REPS(id) ((PROBE_ID == (id)) ? PROBE_REPS : 1)
#pragma unroll 1
    for (int rp = REPS(9); rp > 0; --rp) { if (IN(0)) { SITE_IDS(); prologue_work(P, gw, ngw, WSCR(), lane); } SEAM(0); }
#pragma unroll 1
    for (int l = 0; l < 4; ++l) {
        const int pb = 1 + 8 * l;
        if (l < 2) {
#pragma unroll 1
            for (int rp = REPS(1); rp > 0; --rp) {
            if (IN(pb + 0)) {
                { SITE_IDS(); if (l == 0 && rp == 1) for (int j = gw; j < 4 * D; j += ngw) colsum_job(P, j, lane);
                  for (int j = bx; j < 33; j += G) strip_job(P, SP_INA, l, M / 16, j, lane, 8, wave, (float*)lds);
                  if (G == 256) thin_wg_job(P, l, bx, tid_s, (LAS unsigned char*)lds); else for (int j = gw; j < M / 16; j += ngw) strip_job(P, SP_INA, l, j, 32, lane); }
                { pg8::Gemm g{WSP(bf16, OFF_H8A), WSP(bf16, OFF_WIN8 + l * SZ_WIN8), M, 2048, D / 2}; pg8::StaticOrder So; So.init(M, 2048, G, bx);
                  EpiInA E{P, l, 1, 0};
                  pg8::gemm_phase<EpiInA, pg8::StaticOrder, true, true, 2, true>((LAS unsigned char*)lds, g, So, E); }
                { SITE_IDS(); zero_pads(P, gw, ngw, lane); }
            }
            SEAM(pb + 0); }
#pragma unroll 1
            for (int rp = REPS(2); rp > 0; --rp) {
            if (IN(pb + 1)) { SITE_IDS();
                const int itv = (G == 256) ? ((bx & 7) * 256 + (bx >> 3) * 8 + wave) : gw;
                for (int it = itv; it < NB * 128; it += ngw) { const int b = it >> 7, w = it & 127;
#pragma unroll 1
                    for (int j = 0; j < 8; ++j) { const int g2 = 128 * j + ((j & 1) ? 127 - w : w); indexer_pass(P, b, g2, lane, (LAS unsigned*)lds + wave * (IDX_LDS_PER_WAVE / 4), rp > 1 ? PROBE_DRY : 0); } } }
            SEAM(pb + 1); }
#pragma unroll 1
            for (int rp = REPS(3); rp > 0; --rp) {
            if (IN(pb + 2)) {
                { SITE_IDS(); attn_naive_work<0>(P, gw, ngw, WSCR(), lane, M, MR); }
                __syncthreads();
                if (PROBE_DRY && rp > 1) attn_phase_fa<2>(P, (char*)lds, G, bx, (bf16*)P.out, l); else
                attn_phase_fa<0>(P, (char*)lds, G, bx, rp > 1 ? (bf16*)P.out : WSP(bf16, OFF_O8), l);
            }
            SEAM(pb + 2); }
        } else {
#pragma unroll 1
            for (int rp = REPS(7); rp > 0; --rp) {
            if (IN(pb + 0)) {
                if (l == 2) { SITE_IDS(); for (int j = bx; j < 33; j += G) strip_job(P, SP_QKVB, l, M / 16, 16 + j, lane, 8, wave, (float*)lds);
                  for (int j = gw; j < M / 16; j += ngw) strip_job(P, SP_QKVB, l, j, 48, lane); }
                pg8::Gemm g{WSP(bf16, OFF_H8B), WSP(bf16, OFF_WQKV8 + (l == 2 ? 0 : size_t(3072) * D)), M, l == 2 ? 3072 : 1024, D / 2}; pg8::StaticOrder So; So.init(M, g.N, G, bx);
                EpiInB E{P, l};
                pg8::gemm_phase<EpiInB, pg8::StaticOrder, true, true, 2, true>((LAS unsigned char*)lds, g, So, E);
            }
            SEAM(pb + 0); }
            if (IN(pb + 1) && l == 2) { SITE_IDS(); for (int bh = bx; bh < 256; bh += G) scan_work(P, bh, (float*)lds, tid_s); }
            if (l == 2) SEAM(pb + 1);
#pragma unroll 1
            for (int rp = REPS(8); rp > 0; --rp) {
            if (IN(pb + 2)) attn_phase_fa<1>(P, (char*)lds, G, bx, rp > 1 ? (bf16*)P.out : WSP(bf16, OFF_O8), l);
            SEAM(pb + 2); }
        }
#pragma unroll 1
        for (int rp = REPS(4); rp > 0; --rp) {
        if (IN(pb + 3)) {
            if (l < 2 && rp == 1) { SITE_IDS(); for (int j = bx; j < 16; j += G) strip_job(P, SP_RES_O, l, M / 16, j, lane, 8, wave, (float*)lds); }
            pg8::StaticOrder So; So.init(M, D, G, bx);
            { pg8::Gemm g{WSP(bf16, OFF_O8), WSP(bf16, l < 2 ? OFF_WO8A + l * (SZ_SQ / 2) : OFF_WOB + (l - 2) * (SZ_SQ / 2)), M, D, D / 2}; EpiRes<false> E{P, l, rp > 1, 1.0f / (IN_F8S * O_F8S)};
                pg8::gemm_phase<EpiRes<false>, pg8::StaticOrder, true, true, 1, true>((LAS unsigned char*)lds, g, So, E); }
        }
        SEAM(pb + 3); }
#pragma unroll 1
        for (int rp = REPS(5); rp > 0; --rp) {
        if (IN(pb + 4)) {
            if (l < 2) { SITE_IDS(); for (int j = bx; j < 64; j += G) strip_job(P, SP_MLP1, l, M / 16, j, lane, 8, wave, (float*)lds); }
            pg8::Gemm g{WSP(bf16, OFF_HQ), WSP(bf16, OFF_W18 + l * SZ_W28), M, FF, D / 2}; pg8::StaticOrder So; So.init(M, FF, G, bx);
            EpiRelu2 E{P, l, (PROBE_DRY && rp > 1) ? 1 : 0};
            pg8::gemm_phase<EpiRelu2, pg8::StaticOrder, true, true, 2, true>((LAS unsigned char*)lds, g, So, E);
        }
        SEAM(pb + 4); }
#pragma unroll 1
        for (int rp = REPS(6); rp > 0; --rp) {
        if (IN(pb + 5)) {
            if (l < 2 && rp == 1) { SITE_IDS(); for (int j = bx; j < 16; j += G) strip_job(P, SP_RES_M, l, M / 16, j, lane, 8, wave, (float*)lds); }
            pg8::StaticOrder So; So.init(M, D, G, bx); EpiRes<true> E{P, l, rp > 1};
            pg8::Gemm g{WSP(bf16, OFF_U), WSP(bf16, OFF_W28 + l * SZ_W28), M, D, FF / 2};
            pg8::gemm_phase<EpiRes<true>, pg8::StaticOrder, true, true, 2, true>((LAS unsigned char*)lds, g, So, E);
        }
        if (rp > 1 || (l < 3 && IN(pb + 5) && IN(pb + 8))) xcd_barrier(bar); }
    }
#undef IN
#undef SEAM
}

#ifndef MK_ONE_LAUNCH
#define MK_ONE_LAUNCH 1
#endif
extern "C" void kernel_launch(void* const* d_in, const int* in_sizes, int n_in, void* d_out, int out_size, void* d_ws, size_t ws_size, hipStream_t stream) {
    static int grid = 0;
    if (grid == 0) {
        if (n_in != 17 || in_sizes[0] != M * D || out_size != M * D || ws_size < WS_END) {
            fprintf(stderr, "kernel_launch: unexpected shapes (n_in %d, in0 %d, out %d, ws %zu, need %zu)\n", n_in, n_in > 0 ? in_sizes[0] : -1, out_size, ws_size, (size_t)WS_END); grid = -1; return; }
        int dev = 0, cus = 0, per_cu = 0;
        if (hipGetDevice(&dev) != hipSuccess || hipDeviceGetAttribute(&cus, hipDeviceAttributeMultiprocessorCount, dev) != hipSuccess) { grid = -1; return; }
        if (hipFuncSetAttribute((const void*)mega_fwd, hipFuncAttributeMaxDynamicSharedMemorySize, LDS_BYTES) != hipSuccess) { fprintf(stderr, "kernel_launch: hipFuncSetAttribute failed\n"); grid = -1; return; }
        if (hipOccupancyMaxActiveBlocksPerMultiprocessor(&per_cu, (const void*)mega_fwd, NWAVES * 64, LDS_BYTES) != hipSuccess || per_cu < 1)
            fprintf(stderr, "kernel_launch: note: occupancy query reports %d workgroups per CU\n", per_cu);
        (void)hipGetLastError();
        grid = cus;
    }
    if (grid < 0) return;
    (void)hipMemsetAsync((char*)d_ws + OFF_CTL, 0, 65536, stream);
    Args a{};
    for (int i = 0; i < 17; ++i) a.P.in[i] = (const float*)d_in[i];
    a.P.out = (float*)d_out; a.P.ws = (unsigned char*)d_ws;
#if MK_ONE_LAUNCH
    a.ph_lo = 0; a.ph_hi = N_PHASES;
    hipLaunchKernelGGL(mega_fwd, dim3(grid), dim3(NWAVES * 64), LDS_BYTES, stream, a);
#else
    for (int ph = 0; ph < N_PHASES; ++ph) { a.ph_lo = ph; a.ph_hi = ph + 1; hipLaunchKernelGGL(mega_fwd, dim3(grid), dim3(NWAVES * 64), LDS_BYTES, stream, a); }
#endif
}
```
